# Optimizing an MI355X kernel written in HIP

```python
import jax
import jax.numpy as jnp
from jax import lax
import numpy as np

D_MODEL = 1024
BATCH = 4
SEQ = 4096
DEPTH = 1

CHUNK = 64
NORM_EPS = 1e-6
ROPE_THETA = 500000.0

HEAD_DIM = 64
ATT_HEADS = (D_MODEL // 2) // HEAD_DIM
ATT_KV_HEADS = ATT_HEADS // 4
Q_PER_KV = ATT_HEADS // ATT_KV_HEADS
ATT_ROT_DIM = HEAD_DIM // 4
IDX_HEADS = 8
IDX_DIM = 32
IDX_ROT_DIM = IDX_DIM // 4
TOPK_MAX = 256
Q_BLOCK = 128
ATT_WIDTH = ATT_HEADS * HEAD_DIM

MLSTM_HEAD_DIM = 128
MLSTM_HEADS = (D_MODEL // 2) // MLSTM_HEAD_DIM
MLSTM_WIDTH = MLSTM_HEADS * MLSTM_HEAD_DIM
CONV_WIDTH = 4

MIX_WIDTH = ATT_WIDTH + MLSTM_WIDTH

PROJ_SIZES = (
    ATT_WIDTH,
    ATT_KV_HEADS * HEAD_DIM,
    ATT_KV_HEADS * HEAD_DIM,
    IDX_HEADS * IDX_DIM,
    IDX_DIM,
    IDX_HEADS,
    MLSTM_WIDTH,
    MLSTM_WIDTH,
    MLSTM_WIDTH,
    MLSTM_HEADS,
    MLSTM_HEADS,
    MLSTM_WIDTH,
)
PROJ_WIDTH = sum(PROJ_SIZES)

N_EXPERTS = 32
TOP_K = 4
EXPERT_DIM = D_MODEL
SWIGLU_ALPHA = 1.702
SWIGLU_LIMIT = 7.0
EXPERT_BLOCK = 128

kernel_name = 'hybrid_dsa_mlstm_moe_block'


def rms_norm(x, w):
    xf = x.astype(jnp.float32)
    y = xf * lax.rsqrt(jnp.mean(xf * xf, axis=-1, keepdims=True) + NORM_EPS)
    return (y * w.astype(jnp.float32)).astype(x.dtype)


def partial_rope(x, rot_dim):
    seq = x.shape[1]
    pos = jnp.arange(seq, dtype=jnp.float32)
    inv_freq = ROPE_THETA ** (-jnp.arange(0, rot_dim, 2, dtype=jnp.float32) / rot_dim)
    ang = pos[:, None] * inv_freq[None, :]
    cos = jnp.cos(ang)[None, :, None, :]
    sin = jnp.sin(ang)[None, :, None, :]
    xr = x[..., :rot_dim].astype(jnp.float32)
    x1, x2 = jnp.split(xr, 2, axis=-1)
    rot = jnp.concatenate([x1 * cos - x2 * sin, x2 * cos + x1 * sin], axis=-1)
    return jnp.concatenate([rot.astype(x.dtype), x[..., rot_dim:]], axis=-1)


def dsa_attention(q, k, v, qi, ki, wi):
    bsz, seq = q.shape[0], q.shape[1]
    k_sel = min(TOPK_MAX, seq // 4)
    n_blk = seq // Q_BLOCK
    key_chunk = jnp.arange(seq) // CHUNK
    qg = q.reshape(bsz, seq, ATT_KV_HEADS, Q_PER_KV, HEAD_DIM)
    scale = HEAD_DIM ** -0.5

    def block(i):
        s0 = i * Q_BLOCK
        qb = lax.dynamic_slice_in_dim(qg, s0, Q_BLOCK, axis=1)
        qib = lax.dynamic_slice_in_dim(qi, s0, Q_BLOCK, axis=1)
        wib = lax.dynamic_slice_in_dim(wi, s0, Q_BLOCK, axis=1)
        q_chunk = (s0 + jnp.arange(Q_BLOCK)) // CHUNK
        admissible = key_chunk[None, :] <= q_chunk[:, None]
        idx_score = jnp.einsum('bqh,bqhs->bqs', wib,
                               jax.nn.relu(jnp.einsum('bqhd,bsd->bqhs', qib, ki)))
        idx_score = jnp.where(admissible[None], idx_score.astype(jnp.float32), -jnp.inf)
        _, sel = lax.top_k(idx_score, k_sel)
        valid = key_chunk[sel] <= q_chunk[None, :, None]
        ks = jax.vmap(lambda kb, ib: kb[ib])(k, sel)
        vs = jax.vmap(lambda vb, ib: vb[ib])(v, sel)
        logits = jnp.einsum('bqgrd,bqkgd->bqgrk', qb, ks).astype(jnp.float32) * scale
        logits = jnp.where(valid[:, :, None, None, :], logits, -jnp.inf)
        p = jax.nn.softmax(logits, axis=-1).astype(v.dtype)
        return jnp.einsum('bqgrk,bqkgd->bqgrd', p, vs)

    out = lax.map(block, jnp.arange(n_blk))
    return out.transpose(1, 0, 2, 3, 4, 5).reshape(bsz, seq, ATT_WIDTH)


def causal_depthwise_conv(x, w, b):
    c = x.shape[-1]
    y = lax.conv_general_dilated(x, w.reshape(CONV_WIDTH, 1, c), window_strides=(1,),
                                 padding=[(CONV_WIDTH - 1, 0)],
                                 dimension_numbers=('NWC', 'WIO', 'NWC'),
                                 feature_group_count=c)
    return y + b


def mlstm_chunkwise(q, k, v, i_pre, log_f):
    bsz, nh, seq, dh = q.shape
    nc = seq // CHUNK

    def to_chunks(t):
        t = t.reshape(t.shape[:2] + (nc, CHUNK) + t.shape[3:])
        return jnp.moveaxis(t, 2, 0)

    qc, kc, vc, ic, fc = (to_chunks(t) for t in (q, k * dh ** -0.5, v, i_pre, log_f))
    causal = jnp.tril(jnp.ones((CHUNK, CHUNK), dtype=bool))

    def step(carry, inp):
        c_mat, n_vec, m_prev = carry
        qb, kb, vb, ib, fb = inp
        b = jnp.cumsum(fb, axis=-1)
        d_log = jnp.where(causal, b[..., :, None] - b[..., None, :] + ib[..., None, :], -jnp.inf)
        inter_log = b + m_prev[..., None]
        m_t = jnp.maximum(inter_log, jnp.max(d_log, axis=-1))
        d_w = jnp.exp(d_log - m_t[..., None])
        inter_w = jnp.exp(inter_log - m_t)
        s = jnp.einsum('bhtd,bhsd->bhts', qb, kb) * d_w
        num = (jnp.einsum('bhts,bhse->bhte', s, vb)
               + inter_w[..., None] * jnp.einsum('bhtd,bhde->bhte', qb, c_mat))
        den = jnp.sum(s, axis=-1) + inter_w * jnp.einsum('bhtd,bhd->bht', qb, n_vec)
        h = num / jnp.maximum(jnp.abs(den), jnp.exp(-m_t))[..., None]
        b_last = b[..., -1]
        w_log = b_last[..., None] - b + ib
        m_new = jnp.maximum(b_last + m_prev, jnp.max(w_log, axis=-1))
        decay = jnp.exp(b_last + m_prev - m_new)
        w_s = jnp.exp(w_log - m_new[..., None])
        c_new = decay[..., None, None] * c_mat + jnp.einsum('bhsd,bhse->bhde', kb * w_s[..., None], vb)
        n_new = decay[..., None] * n_vec + jnp.einsum('bhs,bhsd->bhd', w_s, kb)
        return (c_new, n_new, m_new), h

    init = (jnp.zeros((bsz, nh, dh, dh), jnp.float32),
            jnp.zeros((bsz, nh, dh), jnp.float32),
            jnp.zeros((bsz, nh), jnp.float32))
    _, hs = lax.scan(step, init, (qc, kc, vc, ic, fc))
    return jnp.moveaxis(hs, 0, 2).reshape(bsz, nh, seq, dh)


def mlstm_mixer(mq, mk, mv, mi, mf, mo, conv_w, conv_b, igate_b, fgate_b, norm_w):
    bsz, seq = mq.shape[0], mq.shape[1]
    qk = jax.nn.silu(causal_depthwise_conv(jnp.concatenate([mq, mk], axis=-1), conv_w, conv_b))
    q, k = jnp.split(qk, 2, axis=-1)

    def heads(t):
        return t.reshape(bsz, seq, MLSTM_HEADS, MLSTM_HEAD_DIM).transpose(0, 2, 1, 3).astype(jnp.float32)

    i_pre = (mi + igate_b).astype(jnp.float32).transpose(0, 2, 1)
    log_f = jax.nn.log_sigmoid((mf + fgate_b).astype(jnp.float32)).transpose(0, 2, 1)
    h = mlstm_chunkwise(heads(q), heads(k), heads(mv), i_pre, log_f)
    h = h * lax.rsqrt(jnp.mean(h * h, axis=-1, keepdims=True) + NORM_EPS)
    h = h.transpose(0, 2, 1, 3).reshape(bsz, seq, MLSTM_WIDTH) * norm_w.astype(jnp.float32)
    return (h * jax.nn.sigmoid(mo.astype(jnp.float32))).astype(mq.dtype)


def moe_ffn(h, router_w, router_b, w_gu, b_gu, w_dn, b_dn):
    bsz, seq, d = h.shape
    t = bsz * seq
    xf = h.reshape(t, d)
    logits = (xf @ router_w + router_b).astype(jnp.float32)
    top_vals, top_idx = lax.top_k(logits, TOP_K)
    gates = jax.nn.softmax(top_vals, axis=-1).astype(h.dtype)
    a = t * TOP_K
    e_flat = top_idx.reshape(a)
    tok_flat = jnp.repeat(jnp.arange(t), TOP_K)
    g_flat = gates.reshape(a)
    order = jnp.argsort(e_flat)
    e_sorted, tok_sorted, g_sorted = e_flat[order], tok_flat[order], g_flat[order]
    counts = jnp.bincount(e_flat, length=N_EXPERTS)
    start = jnp.cumsum(counts) - counts
    padded = (counts + EXPERT_BLOCK - 1) // EXPERT_BLOCK * EXPERT_BLOCK
    pad_end = jnp.cumsum(padded)
    pad_start = pad_end - padded
    dest = pad_start[e_sorted] + (jnp.arange(a) - start[e_sorted])
    n_rows = -(-a // EXPERT_BLOCK) * EXPERT_BLOCK + N_EXPERTS * EXPERT_BLOCK
    n_blocks = n_rows // EXPERT_BLOCK
    x_buf = jnp.zeros((n_rows, d), h.dtype).at[dest].set(xf[tok_sorted])
    blk_expert = jnp.minimum(
        jnp.searchsorted(pad_end, jnp.arange(n_blocks) * EXPERT_BLOCK, side='right'), N_EXPERTS - 1)

    def expert_block(args):
        xb, e = args
        gu = xb @ w_gu[e] + b_gu[e]
        glu = jnp.minimum(gu[:, :EXPERT_DIM], SWIGLU_LIMIT)
        lin = jnp.clip(gu[:, EXPERT_DIM:], -SWIGLU_LIMIT, SWIGLU_LIMIT)
        act = glu * jax.nn.sigmoid(SWIGLU_ALPHA * glu) * (lin + 1.0)
        return act @ w_dn[e] + b_dn[e]

    y_buf = lax.map(expert_block, (x_buf.reshape(n_blocks, EXPERT_BLOCK, d), blk_expert))
    y = y_buf.reshape(n_rows, d)[dest] * g_sorted[:, None]
    return jax.ops.segment_sum(y, tok_sorted, num_segments=t).reshape(bsz, seq, d)


def setup_inputs(seed: int = 0) -> dict:
    key = jax.random.key(seed)
    ks = jax.random.split(key, 20)

    def nrm(k, shape, scale):
        return jax.random.normal(k, shape, jnp.float32) * scale

    return {
        'x': nrm(ks[0], (BATCH, SEQ, D_MODEL), 1.0),
        'mix_norm_w': 1.0 + nrm(ks[1], (DEPTH, D_MODEL), 0.02),
        'w_in': nrm(ks[2], (DEPTH, D_MODEL, PROJ_WIDTH), D_MODEL ** -0.5),
        'conv_w': nrm(ks[3], (DEPTH, CONV_WIDTH, 2 * MLSTM_WIDTH), CONV_WIDTH ** -0.5),
        'conv_b': nrm(ks[4], (DEPTH, 2 * MLSTM_WIDTH), 0.02),
        'igate_b': nrm(ks[5], (DEPTH, MLSTM_HEADS), 0.1),
        'fgate_b': 3.0 + nrm(ks[6], (DEPTH, MLSTM_HEADS), 0.5),
        'mlstm_norm_w': 1.0 + nrm(ks[7], (DEPTH, MLSTM_WIDTH), 0.02),
        'w_out': nrm(ks[8], (DEPTH, MIX_WIDTH, D_MODEL), MIX_WIDTH ** -0.5),
        'ffn_norm_w': 1.0 + nrm(ks[9], (DEPTH, D_MODEL), 0.02),
        'router_w': nrm(ks[10], (DEPTH, D_MODEL, N_EXPERTS), D_MODEL ** -0.5),
        'router_b': nrm(ks[11], (DEPTH, N_EXPERTS), 0.01),
        'w_gate_up': nrm(ks[12], (DEPTH, N_EXPERTS, D_MODEL, 2 * EXPERT_DIM), D_MODEL ** -0.5),
        'b_gate_up': nrm(ks[13], (DEPTH, N_EXPERTS, 2 * EXPERT_DIM), 0.02),
        'w_down': nrm(ks[14], (DEPTH, N_EXPERTS, EXPERT_DIM, D_MODEL), EXPERT_DIM ** -0.5),
        'b_down': nrm(ks[15], (DEPTH, N_EXPERTS, D_MODEL), 0.02),
        'final_norm_w': 1.0 + nrm(ks[16], (D_MODEL,), 0.02),
    }


def reference(x, mix_norm_w, w_in, conv_w, conv_b, igate_b, fgate_b, mlstm_norm_w, w_out,
              ffn_norm_w, router_w, router_b, w_gate_up, b_gate_up, w_down, b_down, final_norm_w):
    bsz, seq = x.shape[0], x.shape[1]
    split_points = [int(p) for p in np.cumsum(PROJ_SIZES)[:-1]]
    idx_w_scale = (IDX_HEADS ** -0.5) * (IDX_DIM ** -0.5)
    for layer in range(DEPTH):
        h = rms_norm(x, mix_norm_w[layer])
        proj = h @ w_in[layer]
        aq, ak, av, iq, ik, iw, mq, mk, mv, mi, mf, mo = jnp.split(proj, split_points, axis=-1)
        aq = partial_rope(aq.reshape(bsz, seq, ATT_HEADS, HEAD_DIM), ATT_ROT_DIM)
        ak = partial_rope(ak.reshape(bsz, seq, ATT_KV_HEADS, HEAD_DIM), ATT_ROT_DIM)
        av = av.reshape(bsz, seq, ATT_KV_HEADS, HEAD_DIM)
        iq = partial_rope(iq.reshape(bsz, seq, IDX_HEADS, IDX_DIM), IDX_ROT_DIM)
        ik = partial_rope(ik.reshape(bsz, seq, 1, IDX_DIM), IDX_ROT_DIM)[:, :, 0, :]
        att_out = dsa_attention(aq, ak, av, iq, ik, iw * idx_w_scale)
        mem_out = mlstm_mixer(mq, mk, mv, mi, mf, mo, conv_w[layer], conv_b[layer],
                              igate_b[layer], fgate_b[layer], mlstm_norm_w[layer])
        x = x + jnp.concatenate([att_out, mem_out], axis=-1) @ w_out[layer]
        x = x + moe_ffn(rms_norm(x, ffn_norm_w[layer]), router_w[layer], router_b[layer],
                        w_gate_up[layer], b_gate_up[layer], w_down[layer], b_down[layer])
    return rms_norm(x, final_norm_w)
```

```cpp
#include <hip/hip_runtime.h>
#include <hip/hip_cooperative_groups.h>
#include <cstdio>
#include <cstdint>
namespace cg = cooperative_groups;
__device__ __forceinline__ int tid_opaque() { int t = threadIdx.x; asm volatile("" : "+v"(t)); return t; }
namespace pg8 {
#define PG8_LAS __attribute__((address_space(3)))
typedef unsigned short bf16_t;
typedef short bf16x8 __attribute__((ext_vector_type(8)));
typedef float f32x4 __attribute__((ext_vector_type(4)));
typedef unsigned u32x4 __attribute__((ext_vector_type(4)));
constexpr int BM = 256, BK = 64, HALF = 128, HTB = HALF * BK * 2  , STAGE_BYTES = 8 * HTB, NXCD = 8, WGM = 8;

__host__ __device__ __forceinline__ int lds_byte(int r, int c) { const int st = (r >> 4) * 2 + (c >> 5), rr = r & 15, cc = c & 31, ob = rr * 64 + cc * 2; return st * 1024 + (ob ^ (((ob >> 9) & 1) << 5)); }
__host__ __device__ __forceinline__ void stage_rc(int b, int& R, int& C) { const int st = b / 1024, sb = b % 1024, swz = sb ^ (((sb >> 9) & 1) << 5); R = (st >> 1) * 16 + swz / 64; C = (st & 1) * 32 + (swz % 64) / 2; }
__host__ __device__ __forceinline__ int perm32(int rho) { const int n = rho >> 4, i = rho & 15; return 8 * (i >> 2) + 4 * n + (i & 3); }

struct Unit { int pm, pn, pb, ex; };
struct Gemm { const bf16_t* A; const bf16_t* Bt; int M, N, K; };

struct StaticOrder {
    int nM, nN, nwg, G, c;
    __host__ __device__ void init(int M, int N, int G_, int c_) { nM = M / BM; nN = N / BM; nwg = nM * nN; G = G_; c = c_; }
    __host__ __device__ bool next(int i, Unit& u) const {
        const long L = (long)i * G + c; if (L >= nwg) return false;
        int wgid = (int)L; { const int q = nwg / NXCD, r = nwg % NXCD, xcd = wgid % NXCD, off = wgid / NXCD; wgid = (xcd < r ? xcd * (q + 1) : r * (q + 1) + (xcd - r) * q) + off; }
        const int nig = WGM * nN, gid = wgid / nig, fm = gid * WGM, gsz = (nM - fm) < WGM ? (nM - fm) : WGM;
        u.pm = fm + ((wgid % nig) % gsz); u.pn = (wgid % nig) / gsz; u.pb = u.pn; u.ex = 0; return true;
    }
    __device__ __forceinline__ void a_ready(const Unit&) const {}
    __device__ __forceinline__ void done(const Unit&) const {}
};

__device__ __forceinline__ unsigned cvt_pk_bf16(float lo, float hi) { unsigned r; asm volatile("v_cvt_pk_bf16_f32 %0, %1, %2" : "=v"(r) : "v"(lo), "v"(hi)); return r; }
template <class Epi, class Sched, bool ALIGN_EPI = false, bool SP2 = false>
__device__ __forceinline__ void gemm_phase(PG8_LAS unsigned char* lds, const Gemm g, const Sched& S, const Epi& E) {
    const int tid = tid_opaque(), wid = __builtin_amdgcn_readfirstlane(tid >> 6), lane = tid & 63, wr = wid >> 2, wc = wid & 3, fr = lane & 15, fq = lane >> 4;
    const int K = g.K, nt = K / BK;
    unsigned voffA[2], voffB[2];
#pragma unroll
    for (int i = 0; i < 2; ++i) { int R, C; stage_rc(tid * 16 + i * 8192, R, C); const int Rb = Epi::PERM ? ((R & ~31) + perm32(R & 31)) : R;
        voffA[i] = (unsigned)(R * K + C) * 2u; voffB[i] = (unsigned)(Rb * K + C) * 2u; }
    const size_t kstep = (size_t)(BK * 2);
    const size_t hstep = (size_t)HALF * K * 2;
    const size_t tstep = 2 * hstep;
    const unsigned ldsw = (unsigned)wid * 1024u;
    const int aoff = lds_byte(wr * 64 + fr, fq * 8), boff = lds_byte(wc * 32 + fr, fq * 8);
#define PG8_SA(b, h) (((b) * 2 + (h)) * HTB)
#define PG8_SB(b, h) ((4 + (b) * 2 + (h)) * HTB)
#define PG8_STAGE(bufoff, gbase, voff) do { _Pragma("unroll") for (int _i = 0; _i < 2; ++_i) \
        __builtin_amdgcn_global_load_lds((const unsigned*)((const char*)(gbase) + (voff)[_i]), (PG8_LAS unsigned*)(lds + (bufoff) + ldsw + _i * 8192), 16, 0, 0); } while (0)
#define PG8_LDA(dst, b, h) do { _Pragma("unroll") for (int m = 0; m < 4; ++m) _Pragma("unroll") for (int k = 0; k < 2; ++k) dst[m][k] = *(const PG8_LAS bf16x8*)(lds + PG8_SA(b, h) + aoff + m * 2048 + k * 1024); } while (0)
#define PG8_LDB(dst, b, h) do { _Pragma("unroll") for (int n = 0; n < 2; ++n) _Pragma("unroll") for (int k = 0; k < 2; ++k) dst[n][k] = *(const PG8_LAS bf16x8*)(lds + PG8_SB(b, h) + boff + n * 2048 + k * 1024); } while (0)
#define PG8_MMA(ai, bj, At, Bt) do { __builtin_amdgcn_s_setprio(1); _Pragma("unroll") for (int m = 0; m < 4; ++m) _Pragma("unroll") for (int n = 0; n < 2; ++n) _Pragma("unroll") for (int k = 0; k < 2; ++k) \
        acc[ai][bj][m][n] = __builtin_amdgcn_mfma_f32_16x16x32_bf16(Bt[n][k], At[m][k], acc[ai][bj][m][n], 0, 0, 0); __builtin_amdgcn_s_setprio(0); } while (0)
#define PG8_WAIT_V(n) asm volatile("s_waitcnt vmcnt(" #n ")" ::: "memory")
#define PG8_WAIT_L(n) asm volatile("s_waitcnt lgkmcnt(" #n ")" ::: "memory")
#define PG8_BAR __builtin_amdgcn_s_barrier()
#define PG8_SCHED __builtin_amdgcn_sched_barrier(0)
    Unit cur, nxt; int ui = 0;
    if (!S.next(0, cur)) return;
    f32x4 acc[2][2][4][2];
#pragma unroll
    for (int a = 0; a < 2; ++a)
#pragma unroll
        for (int b = 0; b < 2; ++b)
#pragma unroll
            for (int m = 0; m < 4; ++m)
#pragma unroll
                for (int n = 0; n < 2; ++n) acc[a][b][m][n] = (f32x4){0.f, 0.f, 0.f, 0.f};
    bf16x8 At[4][2], B0[2][2], B1[2][2];
    const char* cA = (const char*)g.A + (size_t)cur.pm * tstep; const char* cB = (const char*)g.Bt + (size_t)cur.pb * tstep;
    S.a_ready(cur);
    if constexpr (SP2) {
        PG8_STAGE(PG8_SB(0, 0), cB, voffB); PG8_STAGE(PG8_SB(0, 1), cB + hstep, voffB); PG8_STAGE(PG8_SA(0, 0), cA, voffA); PG8_STAGE(PG8_SA(0, 1), cA + hstep, voffA);
        if (wr == 1) PG8_BAR;
        PG8_WAIT_V(2); PG8_BAR;
        PG8_STAGE(PG8_SB(1, 0), cB + kstep, voffB); PG8_STAGE(PG8_SA(1, 0), cA + kstep, voffA); PG8_STAGE(PG8_SB(1, 1), cB + hstep + kstep, voffB);
        PG8_WAIT_V(6); PG8_BAR;
    } else {
        PG8_STAGE(PG8_SB(0, 0), cB, voffB); PG8_STAGE(PG8_SA(0, 0), cA, voffA); PG8_STAGE(PG8_SB(0, 1), cB + hstep, voffB); PG8_STAGE(PG8_SA(0, 1), cA + hstep, voffA);
        if (wr == 1) PG8_BAR;
        PG8_WAIT_V(4); PG8_BAR;
        PG8_STAGE(PG8_SB(1, 0), cB + kstep, voffB); PG8_STAGE(PG8_SA(1, 0), cA + kstep, voffA); PG8_STAGE(PG8_SB(1, 1), cB + hstep + kstep, voffB);
        PG8_WAIT_V(6); PG8_BAR;
    }
    for (;;) {
        const bool has_next = S.next(ui + 1, nxt);
        const char* nA = has_next ? (const char*)g.A + (size_t)nxt.pm * tstep : cA; const char* nB = has_next ? (const char*)g.Bt + (size_t)nxt.pb * tstep : cB;
        for (int t = 0; t < nt; t += 2) {
            const bool last = (t == nt - 2);
            const char* a1 = cA + (size_t)(t + 1) * kstep;
            const char* a2 = last ? nA : cA + (size_t)(t + 2) * kstep; const char* b2 = last ? nB : cB + (size_t)(t + 2) * kstep;
            const char* a3 = a2 + kstep; const char* b3 = b2 + kstep;
            if (last && has_next) S.a_ready(nxt);
            if constexpr (SP2) {
            PG8_LDB(B0, 0, 0); PG8_LDB(B1, 0, 1); PG8_SCHED; PG8_LDA(At, 0, 0); PG8_STAGE(PG8_SA(1, 1), a1 + hstep, voffA);
            PG8_WAIT_V(8); PG8_WAIT_L(0); PG8_BAR; PG8_MMA(0, 0, At, B0); PG8_MMA(0, 1, At, B1); PG8_BAR; PG8_SCHED;
            PG8_LDA(At, 0, 1); PG8_STAGE(PG8_SB(0, 0), b2, voffB); PG8_STAGE(PG8_SB(0, 1), b2 + hstep, voffB); PG8_STAGE(PG8_SA(0, 0), a2, voffA);
            PG8_WAIT_V(8); PG8_WAIT_L(0); PG8_BAR; PG8_MMA(1, 0, At, B0); PG8_MMA(1, 1, At, B1); PG8_BAR; PG8_SCHED;
            PG8_LDB(B0, 1, 0); PG8_LDB(B1, 1, 1); PG8_SCHED; PG8_LDA(At, 1, 0); PG8_STAGE(PG8_SA(0, 1), a2 + hstep, voffA);
            PG8_WAIT_V(8); PG8_WAIT_L(0); PG8_BAR; PG8_MMA(0, 0, At, B0); PG8_MMA(0, 1, At, B1); PG8_BAR; PG8_SCHED;
            PG8_LDA(At, 1, 1); PG8_STAGE(PG8_SB(1, 0), b3, voffB); PG8_STAGE(PG8_SB(1, 1), b3 + hstep, voffB); PG8_STAGE(PG8_SA(1, 0), a3, voffA);
            PG8_WAIT_V(8); PG8_WAIT_L(0); PG8_BAR; PG8_MMA(1, 0, At, B0); PG8_MMA(1, 1, At, B1); PG8_BAR; PG8_SCHED;
            } else {
            PG8_LDB(B0, 0, 0); PG8_SCHED; PG8_LDA(At, 0, 0); PG8_STAGE(PG8_SA(1, 1), a1 + hstep, voffA);
            PG8_WAIT_L(8); PG8_BAR; PG8_WAIT_L(0); PG8_MMA(0, 0, At, B0); PG8_BAR; PG8_SCHED;
            PG8_LDB(B1, 0, 1); PG8_STAGE(PG8_SB(0, 0), b2, voffB);
            PG8_BAR; PG8_WAIT_L(0); PG8_MMA(0, 1, At, B1); PG8_BAR;
            PG8_LDA(At, 0, 1); PG8_STAGE(PG8_SA(0, 0), a2, voffA);
            PG8_BAR; PG8_WAIT_L(0); PG8_MMA(1, 0, At, B0); PG8_BAR; PG8_SCHED;
            PG8_STAGE(PG8_SB(0, 1), b2 + hstep, voffB);
            PG8_WAIT_V(6); PG8_BAR; PG8_MMA(1, 1, At, B1); PG8_BAR;
            PG8_LDB(B0, 1, 0); PG8_SCHED; PG8_LDA(At, 1, 0); PG8_STAGE(PG8_SA(0, 1), a2 + hstep, voffA);
            PG8_WAIT_L(8); PG8_BAR; PG8_WAIT_L(0); PG8_MMA(0, 0, At, B0); PG8_BAR; PG8_SCHED;
            PG8_LDB(B1, 1, 1); PG8_STAGE(PG8_SB(1, 0), b3, voffB);
            PG8_BAR; PG8_WAIT_L(0); PG8_MMA(0, 1, At, B1); PG8_BAR;
            PG8_LDA(At, 1, 1); PG8_STAGE(PG8_SA(1, 0), a3, voffA);
            PG8_BAR; PG8_WAIT_L(0); PG8_MMA(1, 0, At, B0); PG8_BAR; PG8_SCHED;
            PG8_STAGE(PG8_SB(1, 1), b3 + hstep, voffB);
            PG8_WAIT_V(6); PG8_BAR; PG8_MMA(1, 1, At, B1); PG8_BAR;
            }
        }
        if constexpr (ALIGN_EPI) { if (wr == 0) PG8_BAR; }
        if constexpr (!Epi::AFTER_DRAIN) { E(acc, cur, wr, wc, fr, fq); S.done(cur); }
        if (!has_next) break;
#pragma unroll
        for (int a = 0; a < 2; ++a)
#pragma unroll
            for (int b = 0; b < 2; ++b)
#pragma unroll
                for (int m = 0; m < 4; ++m)
#pragma unroll
                    for (int n = 0; n < 2; ++n) acc[a][b][m][n] = (f32x4){0.f, 0.f, 0.f, 0.f};
        cur = nxt; cA = nA; cB = nB; ++ui;
        if constexpr (ALIGN_EPI) { if (wr == 1) PG8_BAR; }
    }
    PG8_WAIT_V(0);
    if constexpr (!ALIGN_EPI) { if (wr == 0) PG8_BAR; }
    PG8_BAR;
    if constexpr (Epi::AFTER_DRAIN) { E.fused(acc, cur, wr, wc, fr, fq, lds, wid, lane); S.done(cur); }
#undef PG8_SA
#undef PG8_SB
#undef PG8_STAGE
#undef PG8_LDA
#undef PG8_LDB
#undef PG8_MMA
#undef PG8_WAIT_V
#undef PG8_WAIT_L
#undef PG8_BAR
#undef PG8_SCHED
}
}

using pg8::bf16_t; using pg8::bf16x8; using pg8::f32x4; using pg8::u32x4; using pg8::Unit; using pg8::Gemm;
typedef float f32x16 __attribute__((ext_vector_type(16)));
typedef unsigned u32x2 __attribute__((ext_vector_type(2)));

constexpr int T_TOK = 16384, SEQ = 4096, DM = 1024;
constexpr int NPW = 3328;
constexpr int PW_SRC = 3120;
constexpr int PP = 3072;
constexpr int C_AQ = 0, C_AK = 512, C_AV = 640, C_IQ = 768, C_MQ = 1024, C_MK = 1536, C_MV = 2048, C_MO = 2560;
constexpr int NEXP = 32, XROWS = 65536 + 32 * 256;
constexpr int NTHREADS = 512;
constexpr int LDS_BYTES = 160 * 1024;
constexpr float NORM_EPS = 1e-6f;

struct Params {
    const float *x, *mix_norm_w, *w_in, *conv_w, *conv_b, *igate_b, *fgate_b, *mlstm_norm_w, *w_out, *ffn_norm_w, *router_w, *router_b, *w_gu, *b_gu, *w_dn,
        *b_dn, *final_norm_w;
    float* out;
    bf16_t *wt_in, *wt_out, *wt_gu, *wt_dn, *xn, *proj, *ikb, *vt, *cq, *ck, *cst, *mix, *xbuf, *act;
    float *iw, *mi, *mf, *cb, *ropea, *ropei, *ut, *nu, *bl, *mloc, *ns, *ms, *x1, *topg;
    unsigned long long* mask;
    int *tope, *topp, *cnt;
};

__device__ __forceinline__ float bf2f(unsigned short h) { return __uint_as_float(((unsigned)h) << 16); }
__device__ __forceinline__ unsigned pk2(float lo, float hi) { return pg8::cvt_pk_bf16(lo, hi); }
__device__ __forceinline__ unsigned short f2bf(float f) { return (unsigned short)(pk2(f, 0.f) & 0xffffu); }
__device__ __forceinline__ f32x4 mfma16(bf16x8 a, bf16x8 b, f32x4 c) { return __builtin_amdgcn_mfma_f32_16x16x32_bf16(a, b, c, 0, 0, 0); }
__device__ __forceinline__ f32x16 mfma32(bf16x8 a, bf16x8 b, f32x16 c) { return __builtin_amdgcn_mfma_f32_32x32x16_bf16(a, b, c, 0, 0, 0); }
__device__ __forceinline__ float wave_sum(float v) {
#pragma unroll
    for (int o = 32; o > 0; o >>= 1) v += __shfl_xor(v, o);
    return v;
}
__device__ __forceinline__ float wave_max(float v) {
#pragma unroll
    for (int o = 32; o > 0; o >>= 1) v = fmaxf(v, __shfl_xor(v, o));
    return v;
}
__device__ __forceinline__ u32x4 pack8(const float* f) { u32x4 w; w.x = pk2(f[0], f[1]); w.y = pk2(f[2], f[3]); w.z = pk2(f[4], f[5]); w.w = pk2(f[6], f[7]); return w; }
__device__ __forceinline__ void unpack8(u32x4 w, float* f) {
    f[0] = __uint_as_float(w.x << 16); f[1] = __uint_as_float(w.x & 0xffff0000u); f[2] = __uint_as_float(w.y << 16); f[3] = __uint_as_float(w.y & 0xffff0000u);
    f[4] = __uint_as_float(w.z << 16); f[5] = __uint_as_float(w.z & 0xffff0000u); f[6] = __uint_as_float(w.w << 16); f[7] = __uint_as_float(w.w & 0xffff0000u);
}
__device__ __forceinline__ float sigmoidf_(float z) { return 1.0f / (1.0f + __expf(-z)); }

__device__ __forceinline__ int srccol_in(int n) {
    if (n < 1024) return n;
    if (n < 2560) return n + 40;
    if (n < 3072) return n + 48;
    if (n < 3112) return n - 3072 + 1024;
    if (n < 3120) return n - 3112 + 2600;
    return -1;
}
__device__ __forceinline__ int srccol_gu(int n) { return ((n & 128) ? 1024 : 0) + 128 * (n >> 8) + (n & 127); }

template <int WHICH> __device__ __forceinline__ void tr_tile(const float* __restrict__ src, int ld, bf16_t* __restrict__ dst, int K, int k0, int n0, float* tile, int tid) {
#pragma unroll
    for (int i = 0; i < 2; ++i) {
        const int k = (tid >> 4) + 32 * i, n4 = (tid & 15) * 4, dn = n0 + n4;
        const int sc = WHICH == 0 ? srccol_in(dn) : (WHICH == 1 ? srccol_gu(dn) : dn);
        float4 v = make_float4(0.f, 0.f, 0.f, 0.f);
        if (sc >= 0) v = *(const float4*)(src + (size_t)(k0 + k) * ld + sc);
        float* tp = tile + k * 65 + n4; tp[0] = v.x; tp[1] = v.y; tp[2] = v.z; tp[3] = v.w;
    }
    __syncthreads();
    {
        const int n = tid >> 3, k8 = (tid & 7) * 8; float f[8];
#pragma unroll
        for (int j = 0; j < 8; ++j) f[j] = tile[(k8 + j) * 65 + n];
        *(u32x4*)(dst + (size_t)(n0 + n) * K + k0 + k8) = pack8(f);
    }
    __syncthreads();
}

__device__ __forceinline__ void phase_prologue(const Params& p, unsigned char* lds) {
    const int tid = tid_opaque(), wid = tid >> 6, lane = tid & 63;
    float* tile = (float*)lds;
    constexpr int NT_IN = (NPW / 64) * 16, NT_OUT = 16 * 16, NT_GU = 32 * 32 * 16, NT_DN = 32 * 16 * 16;
    for (int id = blockIdx.x; id < NT_IN + NT_OUT + NT_GU + NT_DN; id += gridDim.x) {
        if (id < NT_IN) { const int kt = id & 15, nt = id >> 4; tr_tile<0>(p.w_in, PW_SRC, p.wt_in, 1024, kt * 64, nt * 64, tile, tid); }
        else if (id < NT_IN + NT_OUT) { const int j = id - NT_IN, kt = j & 15, nt = j >> 4; tr_tile<2>(p.w_out, 1024, p.wt_out, 1024, kt * 64, nt * 64, tile, tid); }
        else if (id < NT_IN + NT_OUT + NT_GU) { const int j = id - NT_IN - NT_OUT, kt = j & 15, nt = (j >> 4) & 31, e = j >> 9;
            tr_tile<1>(p.w_gu + (size_t)e * 1024 * 2048, 2048, p.wt_gu + (size_t)e * 2048 * 1024, 1024, kt * 64, nt * 64, tile, tid); }
        else { const int j = id - NT_IN - NT_OUT - NT_GU, kt = j & 15, nt = (j >> 4) & 15, e = j >> 8;
            tr_tile<2>(p.w_dn + (size_t)e * 1024 * 1024, 1024, p.wt_dn + (size_t)e * 1024 * 1024, 1024, kt * 64, nt * 64, tile, tid); }
    }
    for (int row = blockIdx.x * 8 + wid; row < T_TOK; row += gridDim.x * 8) {
        const float4* xr = (const float4*)(p.x + (size_t)row * DM); float4 v[4]; float ss = 0.f;
#pragma unroll
        for (int i = 0; i < 4; ++i) { v[i] = xr[lane + 64 * i]; ss += v[i].x * v[i].x + v[i].y * v[i].y + v[i].z * v[i].z + v[i].w * v[i].w; }
        ss = wave_sum(ss); const float rs = 1.0f / sqrtf(ss * (1.0f / DM) + NORM_EPS);
#pragma unroll
        for (int i = 0; i < 4; ++i) { const float4 w = ((const float4*)p.mix_norm_w)[lane + 64 * i];
            u32x2 o; o.x = pk2(v[i].x * rs * w.x, v[i].y * rs * w.y); o.y = pk2(v[i].z * rs * w.z, v[i].w * rs * w.w);
            *(u32x2*)(p.xn + (size_t)row * DM + (lane + 64 * i) * 4) = o; }
    }
    for (int i = blockIdx.x * NTHREADS + tid; i < SEQ * 12; i += gridDim.x * NTHREADS) {
        const int pos = i / 12, j = i % 12; const bool att = j < 8; const int jj = att ? j : j - 8; const double ex = att ? (double)(2 * jj) / 16.0 : (double)(2 * jj) / 8.0;
        const float invf = (float)pow(500000.0, -ex); const float ang = (float)pos * invf; const double a = (double)ang;
        float* dst = att ? (p.ropea + ((size_t)pos * 8 + jj) * 2) : (p.ropei + ((size_t)pos * 4 + jj) * 2);
        dst[0] = (float)cos(a); dst[1] = (float)sin(a);
    }
    if (blockIdx.x == 0 && tid < NEXP) p.cnt[tid] = 0;
}

struct EpiProj {
    static constexpr bool PERM = true, AFTER_DRAIN = false;
    bf16_t* proj; bf16_t* ikb; float* iw; float* mi; float* mf; const float* ropea; const float* ropei; const float* igb; const float* fgb;
    __device__ __forceinline__ void operator()(const f32x4 (&acc)[2][2][4][2], const Unit& u, int wr, int wc, int fr, int fq) const {
        const float idx_w_scale = 0.35355339059327373f * 0.17677669529663687f;
#pragma unroll
        for (int ai = 0; ai < 2; ++ai)
#pragma unroll
            for (int m = 0; m < 4; ++m) {
                const int row = u.pm * 256 + ai * 128 + wr * 64 + m * 16 + fr; const int pos = row & (SEQ - 1);
#pragma unroll
                for (int bj = 0; bj < 2; ++bj) {
                    f32x4 v0 = acc[ai][bj][m][0], v1 = acc[ai][bj][m][1];
                    const int cw = u.pn * 256 + bj * 128 + wc * 32;
                    if (cw < C_AV) {
                        if ((cw & 32) == 0) {
                            f32x4 q0, q1;
#pragma unroll
                            for (int j = 0; j < 4; ++j) { q0[j] = __shfl_xor(v0[j], 16); q1[j] = __shfl_xor(v1[j], 16); }
                            if (fq < 2) {
                                const float4* cs = (const float4*)(ropea + (size_t)pos * 16);
                                const float4 c01 = cs[0], c23 = cs[1], c45 = cs[2], c67 = cs[3];
                                const float co[8] = {c01.x, c01.z, c23.x, c23.z, c45.x, c45.z, c67.x, c67.z}, si[8] = {c01.y, c01.w, c23.y, c23.w, c45.y, c45.w, c67.y, c67.w};
                                if (fq == 0) {
#pragma unroll
                                    for (int j = 0; j < 4; ++j) { v0[j] = v0[j] * co[j] - q0[j] * si[j]; v1[j] = v1[j] * co[4 + j] - q1[j] * si[4 + j]; }
                                } else {
#pragma unroll
                                    for (int j = 0; j < 4; ++j) { v0[j] = v0[j] * co[j] + q0[j] * si[j]; v1[j] = v1[j] * co[4 + j] + q1[j] * si[4 + j]; }
                                }
                            }
                        }
                    } else if (cw >= C_IQ && cw < C_MQ) {
                        if (fq == 0) {
                            const float4* cs = (const float4*)(ropei + (size_t)pos * 8); const float4 c01 = cs[0], c23 = cs[1];
                            const float co[4] = {c01.x, c01.z, c23.x, c23.z}, si[4] = {c01.y, c01.w, c23.y, c23.w};
#pragma unroll
                            for (int j = 0; j < 4; ++j) { const float a = v0[j], b = v1[j]; v0[j] = a * co[j] - b * si[j]; v1[j] = b * co[j] + a * si[j]; }
                        }
                    } else if (cw >= PP) {
                        const int cs_ = cw - PP;
                        if (cs_ == 0) {
                            if (fq == 0) {
                                const float4* cs = (const float4*)(ropei + (size_t)pos * 8); const float4 c01 = cs[0], c23 = cs[1];
                                const float co[4] = {c01.x, c01.z, c23.x, c23.z}, si[4] = {c01.y, c01.w, c23.y, c23.w};
#pragma unroll
                                for (int j = 0; j < 4; ++j) { const float a = v0[j], b = v1[j]; v0[j] = a * co[j] - b * si[j]; v1[j] = b * co[j] + a * si[j]; }
                            }
                            u32x4 w; w.x = pk2(v0[0], v0[1]); w.y = pk2(v0[2], v0[3]); w.z = pk2(v1[0], v1[1]); w.w = pk2(v1[2], v1[3]);
                            *(u32x4*)(ikb + (size_t)row * 32 + fq * 8) = w;
                        } else if (cs_ == 32) {
                            if (fq == 0) { *(f32x4*)(iw + (size_t)row * 8) = v0 * idx_w_scale; *(f32x4*)(iw + (size_t)row * 8 + 4) = v1 * idx_w_scale; }
                            else if (fq == 1) {
                                f32x4 a, b;
#pragma unroll
                                for (int j = 0; j < 4; ++j) { a[j] = v0[j] + igb[j]; const float z = v1[j] + fgb[j]; b[j] = fminf(z, 0.f) - log1pf(__expf(-fabsf(z))); }
                                *(f32x4*)(mi + (size_t)row * 4) = a; *(f32x4*)(mf + (size_t)row * 4) = b;
                            }
                        }
                        continue;
                    }
                    u32x4 w; w.x = pk2(v0[0], v0[1]); w.y = pk2(v0[2], v0[3]); w.z = pk2(v1[0], v1[1]); w.w = pk2(v1[2], v1[3]);
                    *(u32x4*)(proj + (size_t)row * PP + cw + fq * 8) = w;
                }
            }
    }
};

struct EpiResid {
    static constexpr bool PERM = true, AFTER_DRAIN = false;
    const float* x; float* x1;
    __device__ __forceinline__ void operator()(const f32x4 (&acc)[2][2][4][2], const Unit& u, int wr, int wc, int fr, int fq) const {
#pragma unroll
        for (int ai = 0; ai < 2; ++ai)
#pragma unroll
            for (int m = 0; m < 4; ++m) {
                const int row = u.pm * 256 + ai * 128 + wr * 64 + m * 16 + fr;
#pragma unroll
                for (int bj = 0; bj < 2; ++bj) {
                    const size_t off = (size_t)row * DM + u.pn * 256 + bj * 128 + wc * 32 + fq * 8;
                    const f32x4 a = *(const f32x4*)(x + off), b = *(const f32x4*)(x + off + 4);
                    *(f32x4*)(x1 + off) = a + acc[ai][bj][m][0]; *(f32x4*)(x1 + off + 4) = b + acc[ai][bj][m][1];
                }
            }
    }
};

struct EpiSwiglu {
    static constexpr bool PERM = true, AFTER_DRAIN = false;
    const float* bgu; bf16_t* act;
    __device__ __forceinline__ void operator()(const f32x4 (&acc)[2][2][4][2], const Unit& u, int wr, int wc, int fr, int fq) const {
        const int hc = u.pn * 128 + wc * 32 + fq * 8;
        const float* bg = bgu + (size_t)u.ex * 2048 + hc;
        float bgl[8], bli[8];
#pragma unroll
        for (int j = 0; j < 8; ++j) { bgl[j] = bg[j]; bli[j] = bg[1024 + j]; }
#pragma unroll
        for (int ai = 0; ai < 2; ++ai)
#pragma unroll
            for (int m = 0; m < 4; ++m) {
                const int row = u.pm * 256 + ai * 128 + wr * 64 + m * 16 + fr; float o[8];
#pragma unroll
                for (int j = 0; j < 8; ++j) {
                    float g = (j < 4 ? acc[ai][0][m][0][j & 3] : acc[ai][0][m][1][j & 3]) + bgl[j];
                    float l = (j < 4 ? acc[ai][1][m][0][j & 3] : acc[ai][1][m][1][j & 3]) + bli[j];
                    g = fminf(g, 7.0f); l = fminf(fmaxf(l, -7.0f), 7.0f);
                    o[j] = g * sigmoidf_(1.702f * g) * (l + 1.0f);
                }
                *(u32x4*)(act + (size_t)row * 1024 + hc) = pack8(o);
            }
    }
};

struct EpiBiasBf16 {
    static constexpr bool PERM = true, AFTER_DRAIN = false;
    const float* bdn; bf16_t* y;
    __device__ __forceinline__ void operator()(const f32x4 (&acc)[2][2][4][2], const Unit& u, int wr, int wc, int fr, int fq) const {
#pragma unroll
        for (int bj = 0; bj < 2; ++bj) {
            const int c8 = u.pn * 256 + bj * 128 + wc * 32 + fq * 8; const float* bb = bdn + (size_t)u.ex * 1024 + c8;
            const f32x4 b0 = *(const f32x4*)bb, b1 = *(const f32x4*)(bb + 4);
#pragma unroll
            for (int ai = 0; ai < 2; ++ai)
#pragma unroll
                for (int m = 0; m < 4; ++m) {
                    const int row = u.pm * 256 + ai * 128 + wr * 64 + m * 16 + fr;
                    const f32x4 v0 = acc[ai][bj][m][0] + b0, v1 = acc[ai][bj][m][1] + b1;
                    u32x4 w; w.x = pk2(v0[0], v0[1]); w.y = pk2(v0[2], v0[3]); w.z = pk2(v1[0], v1[1]); w.w = pk2(v1[2], v1[3]);
                    *(u32x4*)(y + (size_t)row * 1024 + c8) = w;
                }
        }
    }
};

struct GroupOrder {
    const int* tstart; int ncol, G, c;
    __device__ __forceinline__ bool next(int i, Unit& u) const {
        const int L = i * G + c; const int total = tstart[NEXP] * ncol; if (L >= total) return false;
        const int rt = L / ncol, ct = L - rt * ncol; int e = 0;
        while (tstart[e + 1] <= rt) ++e;
        u.pm = rt; u.pn = ct; u.pb = e * ncol + ct; u.ex = e; return true;
    }
    __device__ __forceinline__ void a_ready(const Unit&) const {}
    __device__ __forceinline__ void done(const Unit&) const {}
};

__device__ __forceinline__ void mlstm_local(const Params& p, int item, unsigned char* lds) {
    const int tid = tid_opaque(), wid = tid >> 6, lane = tid & 63, fr = lane & 15, fq = lane >> 4;
    const int bh = item >> 6, c = item & 63, b = bh >> 2, h = bh & 3, t0 = b * SEQ + c * 64;
    bf16_t* kwT = (bf16_t*)lds;
    bf16_t* vT = kwT + 128 * 72;
    float* wgt = (float*)(lds + 2 * 128 * 72 * 2);
    if (wid == 0) {
        const float lf = p.mf[(size_t)(t0 + lane) * 4 + h], ii = p.mi[(size_t)(t0 + lane) * 4 + h];
        float bs = lf;
#pragma unroll
        for (int d = 1; d < 64; d <<= 1) { const float o = __shfl_up(bs, d); if (lane >= d) bs += o; }
        const float bl = __shfl(bs, 63); const float wl = bl - bs + ii; const float mx = wave_max(wl);
        wgt[lane] = __expf(wl - mx); p.cb[(size_t)(t0 + lane) * 4 + h] = bs;
        if (lane == 0) { p.bl[item] = bl; p.mloc[item] = mx; }
    }
    __syncthreads();
    {
        const int tok = lane, d0 = wid * 16, pos = c * 64 + tok; float aq[16], ak[16];
#pragma unroll
        for (int i = 0; i < 16; ++i) { aq[i] = p.conv_b[h * 128 + d0 + i]; ak[i] = p.conv_b[512 + h * 128 + d0 + i]; }
#pragma unroll
        for (int j = 0; j < 4; ++j) {
            const int pp = pos - 3 + j;
            if (pp >= 0) {
                const bf16_t* rq = p.proj + (size_t)(b * SEQ + pp) * PP + C_MQ + h * 128 + d0; const bf16_t* rk = p.proj + (size_t)(b * SEQ + pp) * PP + C_MK + h * 128 + d0;
                float xq[16], xk[16]; unpack8(*(const u32x4*)rq, xq); unpack8(*(const u32x4*)(rq + 8), xq + 8); unpack8(*(const u32x4*)rk, xk); unpack8(*(const u32x4*)(rk + 8), xk + 8);
                const float* wq = p.conv_w + j * 1024 + h * 128 + d0; const float* wk = wq + 512;
#pragma unroll
                for (int i = 0; i < 16; ++i) { aq[i] += wq[i] * xq[i]; ak[i] += wk[i] * xk[i]; }
            }
        }
        const float wt = wgt[tok]; const float ksc = 0.08838834764831845f;
        float vv[16]; const bf16_t* rv = p.proj + (size_t)(t0 + tok) * PP + C_MV + h * 128 + d0; unpack8(*(const u32x4*)rv, vv); unpack8(*(const u32x4*)(rv + 8), vv + 8);
#pragma unroll
        for (int i = 0; i < 16; ++i) { aq[i] = aq[i] * sigmoidf_(aq[i]); ak[i] = ak[i] * sigmoidf_(ak[i]) * ksc; }
        bf16_t* oq = p.cq + (size_t)(t0 + tok) * 512 + h * 128 + d0; bf16_t* ok = p.ck + (size_t)(t0 + tok) * 512 + h * 128 + d0;
        *(u32x4*)oq = pack8(aq); *(u32x4*)(oq + 8) = pack8(aq + 8); *(u32x4*)ok = pack8(ak); *(u32x4*)(ok + 8) = pack8(ak + 8);
#pragma unroll
        for (int i = 0; i < 16; ++i) { kwT[(d0 + i) * 72 + tok] = f2bf(ak[i] * wt); vT[(d0 + i) * 72 + tok] = f2bf(vv[i]); }
    }
    __syncthreads();
    {
        bf16x8 a[2];
#pragma unroll
        for (int ks = 0; ks < 2; ++ks) a[ks] = *(const bf16x8*)(vT + (16 * wid + fr) * 72 + ks * 32 + fq * 8);
#pragma unroll
        for (int db = 0; db < 8; ++db) {
            f32x4 acc = {0.f, 0.f, 0.f, 0.f};
#pragma unroll
            for (int ks = 0; ks < 2; ++ks) { const bf16x8 bb = *(const bf16x8*)(kwT + (16 * db + fr) * 72 + ks * 32 + fq * 8); acc = mfma16(a[ks], bb, acc); }
#pragma unroll
            for (int r = 0; r < 4; ++r) p.ut[((size_t)item * 128 + 16 * wid + 4 * fq + r) * 128 + 16 * db + fr] = acc[r];
        }
    }
    if (tid < 128) { float s = 0.f;
#pragma unroll 8
        for (int i = 0; i < 64; ++i) s += bf2f(kwT[tid * 72 + i]);
        p.nu[(size_t)item * 128 + tid] = s; }
    __syncthreads();
}

__device__ __forceinline__ int slotpos(int key) { const int x = key & 15; return (key & 48) | (8 * ((x >> 2) & 1) + 4 * (x >> 3) + (x & 3)); }
__device__ __forceinline__ void vtrans(const Params& p, int item, unsigned char* lds) {
    const int tid = tid_opaque(), wid = tid >> 6, lane = tid & 63;
    const int bg = item >> 6, c = item & 63, b = bg >> 1, g = bg & 1;
    bf16_t* tl = (bf16_t*)lds;
    { const int key = lane, d8 = wid * 8; float v[8]; unpack8(*(const u32x4*)(p.proj + (size_t)(b * SEQ + c * 64 + key) * PP + C_AV + g * 64 + d8), v); const int sp = slotpos(key);
#pragma unroll
      for (int i = 0; i < 8; ++i) tl[(d8 + i) * 72 + sp] = f2bf(v[i]); }
    __syncthreads();
    { const int d = tid >> 3, ch = tid & 7; *(u32x4*)(p.vt + ((size_t)(bg * 64 + d)) * SEQ + c * 64 + ch * 8) = *(const u32x4*)(tl + d * 72 + ch * 8); }
    __syncthreads();
}

__device__ __forceinline__ void idx_topk(const Params& p, int j, unsigned char* lds) {
    const int tid = tid_opaque(), wid = tid >> 6, lane = tid & 63, fr = lane & 15, fq = lane >> 4;
    const int k = j >> 8, w = j & 255; const int cc = (w & 7) * 4 + (k & 3); const int c = (k < 4) ? cc : 63 - cc; const int b = (w >> 3) & 3, sub = w >> 5;
    const int t0 = b * SEQ + c * 64 + sub * 8; const int nj = c + 1, nkb = 4 * nj;
    float* sc = (float*)lds;
    {
        bf16x8 afr[4]; float wv[4][4];
#pragma unroll
        for (int rb = 0; rb < 4; ++rb) {
            const int tok = 2 * rb + (fr >> 3), head = fr & 7;
            afr[rb] = *(const bf16x8*)(p.proj + (size_t)(t0 + tok) * PP + C_IQ + head * 32 + fq * 8);
            const int tk = 2 * rb + (fq >> 1);
#pragma unroll
            for (int r = 0; r < 4; ++r) wv[rb][r] = p.iw[(size_t)(t0 + tk) * 8 + 4 * (fq & 1) + r];
        }
        for (int kb = wid; kb < nkb; kb += 8) {
            const bf16x8 bfr = *(const bf16x8*)(p.ikb + (size_t)(b * SEQ + kb * 16 + fr) * 32 + fq * 8);
#pragma unroll
            for (int rb = 0; rb < 4; ++rb) {
                f32x4 ca = {0.f, 0.f, 0.f, 0.f}; ca = mfma16(afr[rb], bfr, ca);
                float s = wv[rb][0] * fmaxf(ca[0], 0.f); s += wv[rb][1] * fmaxf(ca[1], 0.f); s += wv[rb][2] * fmaxf(ca[2], 0.f); s += wv[rb][3] * fmaxf(ca[3], 0.f);
                s += __shfl_xor(s, 16);
                if ((fq & 1) == 0) sc[(2 * rb + (fq >> 1)) * 4096 + kb * 16 + fr] = s + 0.0f;
            }
        }
    }
    __syncthreads();
    {
        const float* row = sc + wid * 4096;
        unsigned key[64];
#pragma unroll
        for (int jj = 0; jj < 64; ++jj) { unsigned kk = 0u; if (jj < nj) { const unsigned u = __float_as_uint(row[jj * 64 + lane]); kk = (u & 0x80000000u) ? ~u : (u | 0x80000000u); } key[jj] = kk; }
        unsigned long long word = 0ull;
        if (nj <= 4) { if (lane < nj) word = ~0ull; }
        else {
            unsigned Tt = 0u; bool exact = false;
            for (int bit = 31; bit >= 0; --bit) {
                const unsigned cand = Tt | (1u << bit); int cnt = 0;
#pragma unroll
                for (int jj = 0; jj < 64; ++jj) if (jj < nj) cnt += __popcll(__ballot(key[jj] >= cand));
                if (cnt >= 256) { Tt = cand; if (cnt == 256) { exact = true; break; } }
            }
            if (exact) {
#pragma unroll
                for (int jj = 0; jj < 64; ++jj) if (jj < nj) { const unsigned long long bm = __ballot(key[jj] >= Tt); if (lane == jj) word = bm; }
            } else {
                int cgt = 0;
#pragma unroll
                for (int jj = 0; jj < 64; ++jj) if (jj < nj) cgt += __popcll(__ballot(key[jj] > Tt));
                int rem = 256 - cgt;
#pragma unroll
                for (int jj = 0; jj < 64; ++jj) if (jj < nj) {
                    const unsigned long long gm = __ballot(key[jj] > Tt), em = __ballot(key[jj] == Tt);
                    const int ce = __popcll(em); unsigned long long take = em;
                    if (ce > rem) { const int rank = __popcll(em & ((1ull << lane) - 1ull)); take = __ballot(key[jj] == Tt && rank < rem); }
                    rem -= (ce > rem) ? rem : ce;
                    const unsigned long long bm = gm | take; if (lane == jj) word = bm;
                }
            }
        }
        if (lane < nj) p.mask[(size_t)(t0 + wid) * 64 + lane] = word;
    }
    __syncthreads();
}

__device__ __forceinline__ void mlstm_scan(const Params& p, int item) {
    const int tid = tid_opaque(), bh = item >> 5, sl = item & 31, idx = sl * 512 + tid;
    float C = 0.f, m = 0.f, nn = 0.f; const bool don = (sl == 0 && tid < 128);
#pragma unroll 8
    for (int c = 0; c < 64; ++c) {
        const int it = bh * 64 + c; const float bl = p.bl[it], ml = p.mloc[it]; const float u = p.ut[(size_t)it * 16384 + idx];
        p.cst[(size_t)it * 16384 + idx] = f2bf(C);
        if (don) { p.ns[it * 128 + tid] = nn; if (tid == 0) p.ms[it] = m; }
        const float mnew = fmaxf(bl + m, ml); const float dec = __expf(bl + m - mnew), su = __expf(ml - mnew);
        C = dec * C + su * u; if (don) nn = dec * nn + su * p.nu[it * 128 + tid]; m = mnew;
    }
}

__device__ __forceinline__ void attn_unit(const Params& p, int b, int g, int c, unsigned char* lds) {
    const int tid = tid_opaque(), wid = tid >> 6, lane = tid & 63, r32 = lane & 31, hi = lane >> 5;
    const int hq = g * 4 + (wid & 3), tq = (wid >> 2) * 32 + r32, t0 = b * SEQ + c * 64, trow = t0 + tq;
    bf16_t* ktl = (bf16_t*)lds;
    bf16_t* vtl = ktl + 2 * 64 * 72;
    const float C2 = 0.125f * 1.4426950408889634f;
    bf16x8 qf[4];
#pragma unroll
    for (int ds = 0; ds < 4; ++ds) qf[ds] = *(const bf16x8*)(p.proj + (size_t)trow * PP + C_AQ + hq * 64 + ds * 16 + hi * 8);
    f32x16 o0, o1;
#pragma unroll
    for (int r = 0; r < 16; ++r) { o0[r] = 0.f; o1[r] = 0.f; }
    float m_run = -INFINITY, lsum = 0.f;
    const int ntiles = c + 1, srow = tid >> 3, sch = tid & 7;
    const bf16_t* kbase = p.proj + (size_t)(b * SEQ + srow) * PP + C_AK + g * 64 + sch * 8;
    const bf16_t* vbase = p.vt + ((size_t)((b * 2 + g) * 64 + srow)) * SEQ + sch * 8;
    u32x4 kreg = *(const u32x4*)kbase, vreg = *(const u32x4*)vbase;
    *(u32x4*)(ktl + srow * 72 + sch * 8) = kreg; *(u32x4*)(vtl + srow * 72 + sch * 8) = vreg;
    __syncthreads();
    for (int tile = 0; tile < ntiles; ++tile) {
        const int cur = tile & 1;
        if (tile + 1 < ntiles) { kreg = *(const u32x4*)(kbase + (size_t)(tile + 1) * 64 * PP); vreg = *(const u32x4*)(vbase + (tile + 1) * 64); }
        const unsigned long long W = p.mask[(size_t)trow * 64 + tile];
        const bf16_t* kt = ktl + cur * 64 * 72; const bf16_t* vt = vtl + cur * 64 * 72;
        f32x16 p0, p1;
#pragma unroll
        for (int r = 0; r < 16; ++r) { p0[r] = 0.f; p1[r] = 0.f; }
#pragma unroll
        for (int ds = 0; ds < 4; ++ds) {
            const bf16x8 a0 = *(const bf16x8*)(kt + r32 * 72 + ds * 16 + hi * 8), a1 = *(const bf16x8*)(kt + (r32 + 32) * 72 + ds * 16 + hi * 8);
            p0 = mfma32(a0, qf[ds], p0); p1 = mfma32(a1, qf[ds], p1);
        }
        const unsigned wlo = (unsigned)W >> (4 * hi), whi = (unsigned)(W >> 32) >> (4 * hi);
        float mx = -INFINITY;
#pragma unroll
        for (int r = 0; r < 16; ++r) { const int kl = (r & 3) + 8 * (r >> 2);
            p0[r] = ((wlo >> kl) & 1u) ? p0[r] : -INFINITY; p1[r] = ((whi >> kl) & 1u) ? p1[r] : -INFINITY; mx = fmaxf(mx, fmaxf(p0[r], p1[r])); }
        mx = fmaxf(mx, __shfl_xor(mx, 32));
        const float mnew = fmaxf(m_run, mx); const float muse = (mnew == -INFINITY) ? 0.f : mnew;
        const float alpha = __builtin_amdgcn_exp2f((m_run - muse) * C2); m_run = mnew;
        const float ms = muse * C2; float ps = 0.f;
#pragma unroll
        for (int r = 0; r < 16; ++r) { p0[r] = __builtin_amdgcn_exp2f(p0[r] * C2 - ms); p1[r] = __builtin_amdgcn_exp2f(p1[r] * C2 - ms); ps += p0[r] + p1[r]; }
        lsum = lsum * alpha + ps;
#pragma unroll
        for (int r = 0; r < 16; ++r) { o0[r] *= alpha; o1[r] *= alpha; }
#pragma unroll
        for (int ks = 0; ks < 4; ++ks) {
            u32x4 bw;
            if (ks == 0) { bw.x = pk2(p0[0], p0[1]); bw.y = pk2(p0[2], p0[3]); bw.z = pk2(p0[4], p0[5]); bw.w = pk2(p0[6], p0[7]); }
            else if (ks == 1) { bw.x = pk2(p0[8], p0[9]); bw.y = pk2(p0[10], p0[11]); bw.z = pk2(p0[12], p0[13]); bw.w = pk2(p0[14], p0[15]); }
            else if (ks == 2) { bw.x = pk2(p1[0], p1[1]); bw.y = pk2(p1[2], p1[3]); bw.z = pk2(p1[4], p1[5]); bw.w = pk2(p1[6], p1[7]); }
            else { bw.x = pk2(p1[8], p1[9]); bw.y = pk2(p1[10], p1[11]); bw.z = pk2(p1[12], p1[13]); bw.w = pk2(p1[14], p1[15]); }
            const bf16x8 bfrag = __builtin_bit_cast(bf16x8, bw);
            const bf16x8 a0 = *(const bf16x8*)(vt + r32 * 72 + ks * 16 + hi * 8), a1 = *(const bf16x8*)(vt + (r32 + 32) * 72 + ks * 16 + hi * 8);
            o0 = mfma32(a0, bfrag, o0); o1 = mfma32(a1, bfrag, o1);
        }
        if (tile + 1 < ntiles) { *(u32x4*)(ktl + (cur ^ 1) * 64 * 72 + srow * 72 + sch * 8) = kreg; *(u32x4*)(vtl + (cur ^ 1) * 64 * 72 + srow * 72 + sch * 8) = vreg; }
        __syncthreads();
    }
    lsum += __shfl_xor(lsum, 32);
    const float inv = 1.0f / lsum;
    bf16_t* orow = p.mix + (size_t)trow * 1024 + hq * 64;
#pragma unroll
    for (int r4 = 0; r4 < 4; ++r4) {
        const int d = 8 * r4 + 4 * hi; u32x2 w0, w1;
        w0.x = pk2(o0[4 * r4] * inv, o0[4 * r4 + 1] * inv); w0.y = pk2(o0[4 * r4 + 2] * inv, o0[4 * r4 + 3] * inv);
        w1.x = pk2(o1[4 * r4] * inv, o1[4 * r4 + 1] * inv); w1.y = pk2(o1[4 * r4 + 2] * inv, o1[4 * r4 + 3] * inv);
        *(u32x2*)(orow + d) = w0; *(u32x2*)(orow + 32 + d) = w1;
    }
}

__device__ __forceinline__ void mlstm_out(const Params& p, int item, unsigned char* lds) {
    const int tid = tid_opaque(), wid = tid >> 6, lane = tid & 63, fr = lane & 15, fq = lane >> 4;
    const int bh = item >> 6, c = item & 63, b = bh >> 2, h = bh & 3, t0 = b * SEQ + c * 64;
    bf16_t* Ql = (bf16_t*)lds;
    bf16_t* Kl = (bf16_t*)(lds + 17408);
    bf16_t* VT = (bf16_t*)(lds + 34816);
    bf16_t* CT = (bf16_t*)(lds + 53248);
    float* HB = (float*)(lds + 53248);
    bf16_t* SS = (bf16_t*)(lds + 88064);
    float* bsum = (float*)(lds + 97280); float* aa = bsum + 64; float* mt = aa + 64; float* iwt = mt + 64; float* den = iwt + 64; float* nvec = den + 64;
    {
        const int row = tid >> 3, ch = tid & 7;
#pragma unroll
        for (int i = 0; i < 2; ++i) { const int cch = ch + 8 * i;
            *(u32x4*)(Ql + row * 136 + cch * 8) = *(const u32x4*)(p.cq + (size_t)(t0 + row) * 512 + h * 128 + cch * 8);
            *(u32x4*)(Kl + row * 136 + cch * 8) = *(const u32x4*)(p.ck + (size_t)(t0 + row) * 512 + h * 128 + cch * 8); }
#pragma unroll
        for (int i = 0; i < 4; ++i) { const int q = tid + 512 * i, e = q >> 4, cch = q & 15; *(u32x4*)(CT + e * 136 + cch * 8) = *(const u32x4*)(p.cst + (size_t)item * 16384 + e * 128 + cch * 8); }
        const int tok = lane, d0 = wid * 16; float vv[16]; const bf16_t* rv = p.proj + (size_t)(t0 + tok) * PP + C_MV + h * 128 + d0; unpack8(*(const u32x4*)rv, vv); unpack8(*(const u32x4*)(rv + 8), vv + 8);
#pragma unroll
        for (int i = 0; i < 16; ++i) VT[(d0 + i) * 72 + tok] = f2bf(vv[i]);
        if (wid == 0) {
            const float bs = p.cb[(size_t)(t0 + lane) * 4 + h], ii = p.mi[(size_t)(t0 + lane) * 4 + h]; const float a = ii - bs; float pm = a;
#pragma unroll
            for (int d = 1; d < 64; d <<= 1) { const float o = __shfl_up(pm, d); if (lane >= d) pm = fmaxf(pm, o); }
            const float mprev = p.ms[item]; const float mtv = bs + fmaxf(mprev, pm);
            bsum[lane] = bs; aa[lane] = a; mt[lane] = mtv; iwt[lane] = __expf(bs + mprev - mtv);
        } else if (wid <= 2) { nvec[tid - 64] = p.ns[(size_t)item * 128 + tid - 64]; }
    }
    __syncthreads();
    const int tb = wid >> 1;
    {
#pragma unroll
        for (int sbi = 0; sbi < 2; ++sbi) {
            const int sb = (wid & 1) * 2 + sbi; f32x4 acc = {0.f, 0.f, 0.f, 0.f};
#pragma unroll
            for (int ks = 0; ks < 4; ++ks) { const bf16x8 a = *(const bf16x8*)(Ql + (16 * tb + fr) * 136 + ks * 32 + fq * 8), bb = *(const bf16x8*)(Kl + (16 * sb + fr) * 136 + ks * 32 + fq * 8); acc = mfma16(a, bb, acc); }
            const int s = 16 * sb + fr; const float as = aa[s];
#pragma unroll
            for (int r = 0; r < 4; ++r) { const int t = 16 * tb + 4 * fq + r; const float v = (s <= t) ? acc[r] * __expf(bsum[t] + as - mt[t]) : 0.f; SS[t * 72 + s] = f2bf(v); }
        }
    }
    __syncthreads();
    if (wid == 0) {
        const int t = lane; float s1 = 0.f, s2 = 0.f;
        for (int s = 0; s < 64; ++s) s1 += bf2f(SS[t * 72 + s]);
        for (int d = 0; d < 128; ++d) s2 += bf2f(Ql[t * 136 + d]) * nvec[d];
        den[t] = s1 + iwt[t] * s2;
    }
    f32x4 num[4];
#pragma unroll
    for (int ebi = 0; ebi < 4; ++ebi) {
        const int eb = (wid & 1) * 4 + ebi; f32x4 a1 = {0.f, 0.f, 0.f, 0.f}, a2 = {0.f, 0.f, 0.f, 0.f};
#pragma unroll
        for (int ks = 0; ks < 2; ++ks) { const bf16x8 a = *(const bf16x8*)(SS + (16 * tb + fr) * 72 + ks * 32 + fq * 8), bb = *(const bf16x8*)(VT + (16 * eb + fr) * 72 + ks * 32 + fq * 8); a1 = mfma16(a, bb, a1); }
#pragma unroll
        for (int ks = 0; ks < 4; ++ks) { const bf16x8 a = *(const bf16x8*)(Ql + (16 * tb + fr) * 136 + ks * 32 + fq * 8), bb = *(const bf16x8*)(CT + (16 * eb + fr) * 136 + ks * 32 + fq * 8); a2 = mfma16(a, bb, a2); }
#pragma unroll
        for (int r = 0; r < 4; ++r) num[ebi][r] = a1[r] + iwt[16 * tb + 4 * fq + r] * a2[r];
    }
    __syncthreads();
#pragma unroll
    for (int ebi = 0; ebi < 4; ++ebi) {
        const int e = 16 * ((wid & 1) * 4 + ebi) + fr;
#pragma unroll
        for (int r = 0; r < 4; ++r) { const int t = 16 * tb + 4 * fq + r; const float dn = fmaxf(fabsf(den[t]), __expf(-mt[t])); HB[t * 132 + e] = num[ebi][r] / dn; }
    }
    __syncthreads();
    {
        const int t = tid >> 3, e16 = (tid & 7) * 16; float hv[16]; float ss = 0.f;
#pragma unroll
        for (int i = 0; i < 16; ++i) { hv[i] = HB[t * 132 + e16 + i]; ss += hv[i] * hv[i]; }
        ss += __shfl_xor(ss, 1); ss += __shfl_xor(ss, 2); ss += __shfl_xor(ss, 4);
        const float rs = 1.0f / sqrtf(ss * (1.0f / 128.0f) + NORM_EPS);
        float mo[16]; const bf16_t* rm = p.proj + (size_t)(t0 + t) * PP + C_MO + h * 128 + e16; unpack8(*(const u32x4*)rm, mo); unpack8(*(const u32x4*)(rm + 8), mo + 8);
        const float* nw = p.mlstm_norm_w + h * 128 + e16; float o[16];
#pragma unroll
        for (int i = 0; i < 16; ++i) o[i] = hv[i] * rs * nw[i] * sigmoidf_(mo[i]);
        bf16_t* orow = p.mix + (size_t)(t0 + t) * 1024 + 512 + h * 128 + e16; *(u32x4*)orow = pack8(o); *(u32x4*)(orow + 8) = pack8(o + 8);
    }
    __syncthreads();
}

__device__ __forceinline__ void router_phase(const Params& p, unsigned char* lds) {
    const int tid = tid_opaque(), wid = tid >> 6, lane = tid & 63;
    float* rwT = (float*)lds;
    int* lcnt = (int*)(lds + 131072); int* lbase = lcnt + 32;
    float* lg = (float*)(lds + 131072 + 256);
    float* selv = lg + 8 * 2 * 32;
    int* sele = (int*)(selv + 64);
    int* info = sele + 64;
    float* ginfo = (float*)(info + 512);
    for (int i = tid; i < 32768; i += NTHREADS) { const int d = i >> 5, e = i & 31; rwT[e * 1024 + d] = p.router_w[i]; }
    for (int grp = blockIdx.x; grp < T_TOK / 64; grp += gridDim.x) {
        if (tid < 32) lcnt[tid] = 0;
        __syncthreads();
        for (int it = 0; it < 4; ++it) {
            const int tl0 = wid * 8 + it * 2;
            float h2[2][16];
#pragma unroll
            for (int tt = 0; tt < 2; ++tt) {
                const size_t row = (size_t)grp * 64 + tl0 + tt; const float* xr = p.x1 + row * DM; float ss = 0.f;
#pragma unroll
                for (int i = 0; i < 16; ++i) { h2[tt][i] = xr[lane + 64 * i]; ss += h2[tt][i] * h2[tt][i]; }
                ss = wave_sum(ss); const float rs = 1.0f / sqrtf(ss * (1.0f / DM) + NORM_EPS);
#pragma unroll
                for (int i = 0; i < 16; ++i) { h2[tt][i] = h2[tt][i] * rs * p.ffn_norm_w[lane + 64 * i]; p.xn[row * DM + lane + 64 * i] = f2bf(h2[tt][i]); }
            }
            float lg0 = 0.f, lg1 = 0.f;
#pragma unroll 2
            for (int e = 0; e < 32; ++e) {
                float a0 = 0.f, a1 = 0.f;
#pragma unroll
                for (int i = 0; i < 16; ++i) { const float wv = rwT[e * 1024 + lane + 64 * i]; a0 += h2[0][i] * wv; a1 += h2[1][i] * wv; }
                a0 = wave_sum(a0); a1 = wave_sum(a1);
                if (lane == e) { lg0 = a0; lg1 = a1; }
            }
            if (lane < 32) { const float rb = p.router_b[lane]; lg[(wid * 2 + 0) * 32 + lane] = lg0 + rb; lg[(wid * 2 + 1) * 32 + lane] = lg1 + rb; }
            if (lane < 32) {
#pragma unroll
                for (int tt = 0; tt < 2; ++tt) {
                    const float* l = lg + (wid * 2 + tt) * 32; const float v = l[lane]; int rank = 0;
#pragma unroll
                    for (int e = 0; e < 32; ++e) { const float o = l[e]; rank += (o > v || (o == v && e < lane)) ? 1 : 0; }
                    if (rank < 4) { selv[(wid * 2 + tt) * 4 + rank] = v; sele[(wid * 2 + tt) * 4 + rank] = lane; }
                }
            }
            if (lane < 8) {
                const int tt = lane >> 2, kk = lane & 3; const float* sv = selv + (wid * 2 + tt) * 4;
                const float v0 = sv[0]; const float e0 = 1.0f, e1 = __expf(sv[1] - v0), e2 = __expf(sv[2] - v0), e3 = __expf(sv[3] - v0); const float sum = e0 + e1 + e2 + e3;
                const float mine = (kk == 0 ? e0 : kk == 1 ? e1 : kk == 2 ? e2 : e3) / sum; const int e = sele[(wid * 2 + tt) * 4 + kk];
                const int lp = atomicAdd(&lcnt[e], 1); const int tl = tl0 + tt;
                info[(tl * 4 + kk) * 2] = e; info[(tl * 4 + kk) * 2 + 1] = lp; ginfo[tl * 4 + kk] = mine;
            }
        }
        __syncthreads();
        if (tid < 32) lbase[tid] = atomicAdd(&p.cnt[tid], lcnt[tid]);
        __syncthreads();
        if (tid < 256) { const int e = info[tid * 2], lp = info[tid * 2 + 1]; const size_t o = (size_t)grp * 256 + tid; p.tope[o] = e; p.topp[o] = lbase[e] + lp; p.topg[o] = ginfo[tid]; }
        __syncthreads();
    }
}

__device__ __forceinline__ void compute_tstart(const Params& p, int* ts) {
    if (threadIdx.x == 0) { int a = 0; for (int e = 0; e < NEXP; ++e) { ts[e] = a; a += (p.cnt[e] + 255) >> 8; } ts[NEXP] = a; }
    __syncthreads();
}

__device__ __forceinline__ void scatter_phase(const Params& p, unsigned char* lds) {
    const int tid = tid_opaque(), wid = tid >> 6, lane = tid & 63; int* ts = (int*)lds;
    compute_tstart(p, ts);
    for (int t = blockIdx.x * 8 + wid; t < T_TOK; t += gridDim.x * 8) {
        const u32x4 a = *(const u32x4*)(p.xn + (size_t)t * DM + lane * 8), bq = *(const u32x4*)(p.xn + (size_t)t * DM + 512 + lane * 8);
#pragma unroll
        for (int k = 0; k < 4; ++k) { const int e = p.tope[t * 4 + k]; const size_t dst = (size_t)ts[e] * 256 + p.topp[t * 4 + k];
            *(u32x4*)(p.xbuf + dst * DM + lane * 8) = a; *(u32x4*)(p.xbuf + dst * DM + 512 + lane * 8) = bq; }
    }
}

__device__ __forceinline__ void combine_phase(const Params& p, unsigned char* lds) {
    const int tid = tid_opaque(), wid = tid >> 6, lane = tid & 63; int* ts = (int*)lds;
    compute_tstart(p, ts);
    const bf16_t* Y = p.xbuf;
    for (int t = blockIdx.x * 8 + wid; t < T_TOK; t += gridDim.x * 8) {
        float v[16];
#pragma unroll
        for (int i = 0; i < 4; ++i) { const float4 a = *(const float4*)(p.x1 + (size_t)t * DM + i * 256 + lane * 4); v[4 * i] = a.x; v[4 * i + 1] = a.y; v[4 * i + 2] = a.z; v[4 * i + 3] = a.w; }
#pragma unroll
        for (int k = 0; k < 4; ++k) { const int e = p.tope[t * 4 + k]; const size_t src = (size_t)ts[e] * 256 + p.topp[t * 4 + k]; const float g = p.topg[t * 4 + k];
#pragma unroll
            for (int i = 0; i < 4; ++i) { const u32x2 w = *(const u32x2*)(Y + src * DM + i * 256 + lane * 4);
                v[4 * i] += g * __uint_as_float(w.x << 16); v[4 * i + 1] += g * __uint_as_float(w.x & 0xffff0000u); v[4 * i + 2] += g * __uint_as_float(w.y << 16); v[4 * i + 3] += g * __uint_as_float(w.y & 0xffff0000u); } }
        float ss = 0.f;
#pragma unroll
        for (int i = 0; i < 16; ++i) ss += v[i] * v[i];
        ss = wave_sum(ss); const float rs = 1.0f / sqrtf(ss * (1.0f / DM) + NORM_EPS);
#pragma unroll
        for (int i = 0; i < 4; ++i) { const float4 w = *(const float4*)(p.final_norm_w + i * 256 + lane * 4);
            *(float4*)(p.out + (size_t)t * DM + i * 256 + lane * 4) = make_float4(v[4 * i] * rs * w.x, v[4 * i + 1] * rs * w.y, v[4 * i + 2] * rs * w.z, v[4 * i + 3] * rs * w.w); }
    }
}

#ifndef MK_SPLIT
#define MK_SPLIT 0
#endif
constexpr int N_PHASES = 11;

__device__ __forceinline__ void run_phase(const Params& p, int ph, unsigned char* lds) {
    typedef __attribute__((address_space(3))) unsigned char* las_ptr;
    const int G = gridDim.x, c = blockIdx.x;
    switch (ph) {
    case 0: phase_prologue(p, lds); break;
    case 1: {
        Gemm g{p.xn, p.wt_in, T_TOK, NPW, 1024}; pg8::StaticOrder S; S.init(T_TOK, NPW, G, c);
        EpiProj E{p.proj, p.ikb, p.iw, p.mi, p.mf, p.ropea, p.ropei, p.igate_b, p.fgate_b};
        pg8::gemm_phase<EpiProj, pg8::StaticOrder, true, true>((las_ptr)lds, g, S, E);
    } break;
    case 2: {
        for (int it = c; it < 1024 + 512 + 2048; it += G) {
            if (it < 1024) mlstm_local(p, it, lds);
            else if (it < 1536) vtrans(p, it - 1024, lds);
            else idx_topk(p, it - 1536, lds);
        }
    } break;
    case 3: {
        for (int it = c; it < 512 + 256; it += G) {
            if (it < 512) mlstm_scan(p, it);
            else { const int pi = it - 512, b = pi >> 6, g = (pi >> 5) & 1, cp = pi & 31; for (int uu = 0; uu < 2; ++uu) attn_unit(p, b, g, uu ? cp : 63 - cp, lds); }
        }
    } break;
    case 4: for (int it = c; it < 1024; it += G) mlstm_out(p, it, lds); break;
    case 5: {
        Gemm g{p.mix, p.wt_out, T_TOK, 1024, 1024}; pg8::StaticOrder S; S.init(T_TOK, 1024, G, c);
        EpiResid E{p.x, p.x1};
        pg8::gemm_phase<EpiResid, pg8::StaticOrder, true, true>((las_ptr)lds, g, S, E);
    } break;
    case 6: router_phase(p, lds); break;
    case 7: scatter_phase(p, lds); break;
    case 8: {
        int* ts = (int*)(lds + 131072); compute_tstart(p, ts);
        Gemm g{p.xbuf, p.wt_gu, XROWS, 2048, 1024}; GroupOrder S{ts, 8, G, c}; EpiSwiglu E{p.b_gu, p.act};
        pg8::gemm_phase<EpiSwiglu, GroupOrder, true, true>((las_ptr)lds, g, S, E);
    } break;
    case 9: {
        int* ts = (int*)(lds + 131072); compute_tstart(p, ts);
        Gemm g{p.act, p.wt_dn, XROWS, 1024, 1024}; GroupOrder S{ts, 4, G, c}; EpiBiasBf16 E{p.b_dn, p.xbuf};
        pg8::gemm_phase<EpiBiasBf16, GroupOrder, true, true>((las_ptr)lds, g, S, E);
    } break;
    case 10: combine_phase(p, lds); break;
    }
}

#if MK_SPLIT
template <int PH> __global__ void __launch_bounds__(NTHREADS) fwd_phase_kernel(Params p) {
    extern __shared__ __attribute__((aligned(16))) unsigned char lds[];
    run_phase(p, PH, lds);
}
template <int PH> static void launch_phase(const Params& p, hipStream_t stream) {
    (void)hipFuncSetAttribute((const void*)fwd_phase_kernel<PH>, hipFuncAttributeMaxDynamicSharedMemorySize, LDS_BYTES);
    hipLaunchKernelGGL(fwd_phase_kernel<PH>, dim3(256), dim3(NTHREADS), LDS_BYTES, stream, p);
}
#else
__global__ void __launch_bounds__(NTHREADS) fwd_megakernel(Params p) {
    extern __shared__ __attribute__((aligned(16))) unsigned char lds[];
    cg::grid_group grid = cg::this_grid();
#define GSYNC() do { __syncthreads(); grid.sync(); } while (0)
    run_phase(p, 0, lds); GSYNC(); run_phase(p, 1, lds); GSYNC(); run_phase(p, 2, lds); GSYNC(); run_phase(p, 3, lds); GSYNC();
    run_phase(p, 4, lds); GSYNC(); run_phase(p, 5, lds); GSYNC(); run_phase(p, 6, lds); GSYNC(); run_phase(p, 7, lds); GSYNC();
    run_phase(p, 8, lds); GSYNC(); run_phase(p, 9, lds); GSYNC(); run_phase(p, 10, lds);
#undef GSYNC
}
#endif

extern "C" void kernel_launch(void* const* d_in, const int* in_sizes, int n_in, void* d_out, int out_size, void* d_ws, size_t ws_size, hipStream_t stream) {
    (void)in_sizes; (void)n_in; (void)out_size;
    Params p{};
    p.x = (const float*)d_in[0]; p.mix_norm_w = (const float*)d_in[1]; p.w_in = (const float*)d_in[2]; p.conv_w = (const float*)d_in[3]; p.conv_b = (const float*)d_in[4];
    p.igate_b = (const float*)d_in[5]; p.fgate_b = (const float*)d_in[6]; p.mlstm_norm_w = (const float*)d_in[7]; p.w_out = (const float*)d_in[8]; p.ffn_norm_w = (const float*)d_in[9];
    p.router_w = (const float*)d_in[10]; p.router_b = (const float*)d_in[11]; p.w_gu = (const float*)d_in[12]; p.b_gu = (const float*)d_in[13]; p.w_dn = (const float*)d_in[14];
    p.b_dn = (const float*)d_in[15]; p.final_norm_w = (const float*)d_in[16];
    p.out = (float*)d_out;
    size_t off = 0; unsigned char* base = (unsigned char*)d_ws;
    auto take = [&](size_t bytes) { unsigned char* r = base + off; off += (bytes + 255) & ~(size_t)255; return r; };
    p.cnt = (int*)take(256);
    p.wt_in = (bf16_t*)take((size_t)NPW * 1024 * 2); p.wt_out = (bf16_t*)take((size_t)1024 * 1024 * 2);
    p.wt_gu = (bf16_t*)take((size_t)32 * 2048 * 1024 * 2); p.wt_dn = (bf16_t*)take((size_t)32 * 1024 * 1024 * 2);
    p.xn = (bf16_t*)take((size_t)T_TOK * 1024 * 2); p.proj = (bf16_t*)take((size_t)T_TOK * PP * 2); p.ikb = (bf16_t*)take((size_t)T_TOK * 32 * 2);
    p.vt = (bf16_t*)take((size_t)4 * 2 * 64 * SEQ * 2); p.cq = (bf16_t*)take((size_t)T_TOK * 512 * 2); p.ck = (bf16_t*)take((size_t)T_TOK * 512 * 2);
    p.cst = (bf16_t*)take((size_t)1024 * 16384 * 2); p.mix = (bf16_t*)take((size_t)T_TOK * 1024 * 2);
    p.xbuf = (bf16_t*)take((size_t)XROWS * 1024 * 2); p.act = (bf16_t*)take((size_t)XROWS * 1024 * 2);
    p.iw = (float*)take((size_t)T_TOK * 8 * 4); p.mi = (float*)take((size_t)T_TOK * 4 * 4); p.mf = (float*)take((size_t)T_TOK * 4 * 4); p.cb = (float*)take((size_t)T_TOK * 4 * 4);
    p.ropea = (float*)take((size_t)SEQ * 16 * 4); p.ropei = (float*)take((size_t)SEQ * 8 * 4);
    p.ut = (float*)take((size_t)1024 * 16384 * 4); p.nu = (float*)take((size_t)1024 * 128 * 4); p.bl = (float*)take(1024 * 4); p.mloc = (float*)take(1024 * 4);
    p.ns = (float*)take((size_t)1024 * 128 * 4); p.ms = (float*)take(1024 * 4); p.x1 = (float*)take((size_t)T_TOK * 1024 * 4); p.topg = (float*)take((size_t)T_TOK * 4 * 4);
    p.mask = (unsigned long long*)take((size_t)T_TOK * 64 * 8); p.tope = (int*)take((size_t)T_TOK * 4 * 4); p.topp = (int*)take((size_t)T_TOK * 4 * 4);
    if (off > ws_size) { fprintf(stderr, "workspace too small: need %zu have %zu\n", off, ws_size); return; }
#if MK_SPLIT
    launch_phase<0>(p, stream); launch_phase<1>(p, stream); launch_phase<2>(p, stream); launch_phase<3>(p, stream); launch_phase<4>(p, stream); launch_phase<5>(p, stream);
    launch_phase<6>(p, stream); launch_phase<7>(p, stream); launch_phase<8>(p, stream); launch_phase<9>(p, stream); launch_phase<10>(p, stream);
#else
    static int grid_blocks = 0;
    if (!grid_blocks) {
        int dev = 0, cus = 0, per_cu = 0;
        (void)hipGetDevice(&dev); (void)hipDeviceGetAttribute(&cus, hipDeviceAttributeMultiprocessorCount, dev);
        (void)hipFuncSetAttribute((const void*)fwd_megakernel, hipFuncAttributeMaxDynamicSharedMemorySize, LDS_BYTES);
        (void)hipOccupancyMaxActiveBlocksPerMultiprocessor(&per_cu, fwd_megakernel, NTHREADS, LDS_BYTES);
        if (per_cu < 1) fprintf(stderr, "occupancy query returned %d blocks per CU\n", per_cu);
        grid_blocks = cus;
    }
    void* args[] = {&p};
    hipError_t e = hipLaunchCooperativeKernel((void*)fwd_megakernel, dim3(grid_blocks), dim3(NTHREADS), args, LDS_BYTES, stream);
    if (e != hipSuccess) fprintf(stderr, "cooperative launch failed: %s (grid %d)\n", hipGetErrorString(e), grid_blocks);
#endif
}
```

```cpp
#include <hip/hip_runtime.h>
#include <hip/hip_cooperative_groups.h>
#include <cstdio>
#include <cstdint>
namespace cg = cooperative_groups;

__device__ __forceinline__ int tid_opaque() { int t = threadIdx.x; asm volatile("" : "+v"(t)); return t; }
namespace pg8 {
#define PG8_LAS __attribute__((address_space(3)))
typedef unsigned short bf16_t;
typedef short bf16x8 __attribute__((ext_vector_type(8)));
typedef float f32x4 __attribute__((ext_vector_type(4)));
typedef unsigned u32x4 __attribute__((ext_vector_type(4)));
constexpr int BM = 256, BK = 64, HALF = 128, HTB = HALF * BK * 2  , STAGE_BYTES = 8 * HTB, NXCD = 8, WGM = 8;

__host__ __device__ __forceinline__ int lds_byte(int r, int c) { const int st = (r >> 4) * 2 + (c >> 5), rr = r & 15, cc = c & 31, ob = rr * 64 + cc * 2; return st * 1024 + (ob ^ (((ob >> 9) & 1) << 5)); }
__host__ __device__ __forceinline__ void stage_rc(int b, int& R, int& C) { const int st = b / 1024, sb = b % 1024, swz = sb ^ (((sb >> 9) & 1) << 5); R = (st >> 1) * 16 + swz / 64; C = (st & 1) * 32 + (swz % 64) / 2; }
__host__ __device__ __forceinline__ int perm32(int rho) { const int n = rho >> 4, i = rho & 15; return 8 * (i >> 2) + 4 * n + (i & 3); }

struct Unit { int pm, pn, pb, ex; };
struct Gemm { const bf16_t* A; const bf16_t* Bt; int M, N, K; };

struct StaticOrder {
    int nM, nN, nwg, G, c;
    __host__ __device__ void init(int M, int N, int G_, int c_) { nM = M / BM; nN = N / BM; nwg = nM * nN; G = G_; c = c_; }
    __host__ __device__ bool next(int i, Unit& u) const {
        const long L = (long)i * G + c; if (L >= nwg) return false;
        int wgid = (int)L; { const int q = nwg / NXCD, r = nwg % NXCD, xcd = wgid % NXCD, off = wgid / NXCD; wgid = (xcd < r ? xcd * (q + 1) : r * (q + 1) + (xcd - r) * q) + off; }
        const int nig = WGM * nN, gid = wgid / nig, fm = gid * WGM, gsz = (nM - fm) < WGM ? (nM - fm) : WGM;
        u.pm = fm + ((wgid % nig) % gsz); u.pn = (wgid % nig) / gsz; u.pb = u.pn; u.ex = 0; return true;
    }
    __device__ __forceinline__ void a_ready(const Unit&) const {}
    __device__ __forceinline__ void done(const Unit&) const {}
};

__device__ __forceinline__ unsigned cvt_pk_bf16(float lo, float hi) { unsigned r; asm volatile("v_cvt_pk_bf16_f32 %0, %1, %2" : "=v"(r) : "v"(lo), "v"(hi)); return r; }
typedef int i32x8 __attribute__((ext_vector_type(8)));
typedef int i32x4v __attribute__((ext_vector_type(4)));
__device__ __forceinline__ f32x4 mfma_fp8_128(bf16x8 a0, bf16x8 a1, bf16x8 b0, bf16x8 b1, f32x4 c) {
    const i32x4v x0 = __builtin_bit_cast(i32x4v, a0), x1 = __builtin_bit_cast(i32x4v, a1), y0 = __builtin_bit_cast(i32x4v, b0), y1 = __builtin_bit_cast(i32x4v, b1);
    const i32x8 a = {x0[0], x0[1], x0[2], x0[3], x1[0], x1[1], x1[2], x1[3]}, b = {y0[0], y0[1], y0[2], y0[3], y1[0], y1[1], y1[2], y1[3]};
    return __builtin_amdgcn_mfma_scale_f32_16x16x128_f8f6f4(a, b, c, 0, 0, 0, 0x7f7f7f7f, 0, 0x7f7f7f7f);
}
template <class Epi, class Sched, bool ALIGN_EPI = false, bool SP2 = false, bool FP8 = false>
__device__ __forceinline__ void gemm_phase(PG8_LAS unsigned char* lds, const Gemm g, const Sched& S, const Epi& E) {
    const int tid = tid_opaque(), wid = __builtin_amdgcn_readfirstlane(tid >> 6), lane = tid & 63, wr = wid >> 2, wc = wid & 3, fr = lane & 15, fq = lane >> 4;
    const int K = FP8 ? g.K / 2 : g.K, nt = K / BK;
    unsigned voffA[2], voffB[2];
#pragma unroll
    for (int i = 0; i < 2; ++i) { int R, C; stage_rc(tid * 16 + i * 8192, R, C); const int Rb = Epi::PERM ? ((R & ~31) + perm32(R & 31)) : R;
        voffA[i] = (unsigned)(R * K + C) * 2u; voffB[i] = (unsigned)(Rb * K + C) * 2u; }
    const size_t kstep = (size_t)(BK * 2);
    const size_t hstep = (size_t)HALF * K * 2;
    const size_t tstep = 2 * hstep;
    const unsigned pfoff = (unsigned)(tid & 255) * (unsigned)K * 2u;
    const unsigned ldsw = (unsigned)wid * 1024u;
    const int aoff = lds_byte(wr * 64 + fr, fq * 8), boff = lds_byte(wc * 32 + fr, fq * 8);
#define PG8_SA(b, h) (((b) * 2 + (h)) * HTB)
#define PG8_SB(b, h) ((4 + (b) * 2 + (h)) * HTB)
#define PG8_STAGE(bufoff, gbase, voff) do { _Pragma("unroll") for (int _i = 0; _i < 2; ++_i) \
        __builtin_amdgcn_global_load_lds((const unsigned*)((const char*)(gbase) + (voff)[_i]), (PG8_LAS unsigned*)(lds + (bufoff) + ldsw + _i * 8192), 16, 0, 0); } while (0)
#define PG8_LDA(dst, b, h) do { _Pragma("unroll") for (int m = 0; m < 4; ++m) { if constexpr (FP8) { dst##8[m].lo = *(const PG8_LAS i32x4v*)(lds + PG8_SA(b, h) + aoff + m * 2048); dst##8[m].hi = *(const PG8_LAS i32x4v*)(lds + PG8_SA(b, h) + aoff + m * 2048 + 1024); } \
        else { _Pragma("unroll") for (int k = 0; k < 2; ++k) dst[m][k] = *(const PG8_LAS bf16x8*)(lds + PG8_SA(b, h) + aoff + m * 2048 + k * 1024); } } } while (0)
#define PG8_LDB(dst, b, h) do { _Pragma("unroll") for (int n = 0; n < 2; ++n) { if constexpr (FP8) { dst##8[n].lo = *(const PG8_LAS i32x4v*)(lds + PG8_SB(b, h) + boff + n * 2048); dst##8[n].hi = *(const PG8_LAS i32x4v*)(lds + PG8_SB(b, h) + boff + n * 2048 + 1024); } \
        else { _Pragma("unroll") for (int k = 0; k < 2; ++k) dst[n][k] = *(const PG8_LAS bf16x8*)(lds + PG8_SB(b, h) + boff + n * 2048 + k * 1024); } } } while (0)
#define PG8_MMA(ai, bj, At, Bt) do { __builtin_amdgcn_s_setprio(1); _Pragma("unroll") for (int m = 0; m < 4; ++m) _Pragma("unroll") for (int n = 0; n < 2; ++n) _Pragma("unroll") for (int k = 0; k < 2; ++k) \
        { if constexpr (FP8) { if (k == 0) asm volatile("v_mfma_scale_f32_16x16x128_f8f6f4 %0, %1, %2, %0, %3, %3 op_sel_hi:[0,0,0]" : "+v"(acc[ai][bj][m][n]) : "v"(Bt##8[n]), "v"(At##8[m]), "v"(fp8_unit_scale)); } \
          else acc[ai][bj][m][n] = __builtin_amdgcn_mfma_f32_16x16x32_bf16(Bt[n][k], At[m][k], acc[ai][bj][m][n], 0, 0, 0); } __builtin_amdgcn_s_setprio(0); } while (0)
#define PG8_WAIT_V(n) asm volatile("s_waitcnt vmcnt(" #n ")" ::: "memory")
#ifndef PG8_PF
#define PG8_PF 0
#endif
#ifndef PG8_PFD
#define PG8_PFD 4
#endif
#if PG8_PF
#define PG8_WAIT_V8 PG8_WAIT_V(9)
#define PG8_PREFETCH(q_) do { const int q = (q_); const char* pb_ = (q < nt) ? ((wid < 4 ? cA : cB) + (size_t)q * kstep) : ((wid < 4 ? nA : nB) + (size_t)(q - nt) * kstep); \
        __builtin_amdgcn_global_load_lds((const unsigned*)(pb_ + pfoff), (PG8_LAS unsigned*)(lds + STAGE_BYTES + 2048 + wid * 256), 4, 0, 0); } while (0)
#else
#define PG8_WAIT_V8 PG8_WAIT_V(8)
#define PG8_PREFETCH(q_) do { } while (0)
#endif
#define PG8_WAIT_L(n) asm volatile("s_waitcnt lgkmcnt(" #n ")" ::: "memory")
#define PG8_BAR __builtin_amdgcn_s_barrier()
#define PG8_SCHED __builtin_amdgcn_sched_barrier(0)
    Unit cur, nxt; int ui = 0;
    if (!S.next(0, cur)) return;
#ifndef PG8_KROT
#define PG8_KROT 0
#endif
    const int ktm = nt - 1;
#define PG8_ROT(u) (PG8_KROT ? (((u).pn + 2 * (u).pm) & ktm) : 0)
#define PG8_KT(rot, t) ((size_t)(((t) + (rot)) & ktm) * kstep)
    f32x4 acc[2][2][4][2];
#pragma unroll
    for (int a = 0; a < 2; ++a)
#pragma unroll
        for (int b = 0; b < 2; ++b)
#pragma unroll
            for (int m = 0; m < 4; ++m)
#pragma unroll
                for (int n = 0; n < 2; ++n) acc[a][b][m][n] = (f32x4){0.f, 0.f, 0.f, 0.f};
    const int fp8_unit_scale = 0x7f7f7f7f; (void)fp8_unit_scale;
    bf16x8 At[4][2], B0[2][2], B1[2][2]; i32x8 At8[4], B08[2], B18[2];
    const char* cA = (const char*)g.A + (size_t)cur.pm * tstep; const char* cB = (const char*)g.Bt + (size_t)cur.pb * tstep;
    S.a_ready(cur);
    int rot = PG8_ROT(cur);
    if constexpr (SP2) {
        { const size_t k0 = PG8_KT(rot, 0), k1 = PG8_KT(rot, 1);
        PG8_STAGE(PG8_SB(0, 0), cB + k0, voffB); PG8_STAGE(PG8_SB(0, 1), cB + hstep + k0, voffB); PG8_STAGE(PG8_SA(0, 0), cA + k0, voffA); PG8_STAGE(PG8_SA(0, 1), cA + hstep + k0, voffA);
        if (wr == 1) PG8_BAR;
        PG8_WAIT_V(2); PG8_BAR;
        PG8_STAGE(PG8_SB(1, 0), cB + k1, voffB); PG8_STAGE(PG8_SA(1, 0), cA + k1, voffA); PG8_STAGE(PG8_SB(1, 1), cB + hstep + k1, voffB); }
        PG8_WAIT_V(6); PG8_BAR;
    } else {
        const size_t k0 = PG8_KT(rot, 0), k1 = PG8_KT(rot, 1);
        PG8_STAGE(PG8_SB(0, 0), cB + k0, voffB); PG8_STAGE(PG8_SA(0, 0), cA + k0, voffA); PG8_STAGE(PG8_SB(0, 1), cB + hstep + k0, voffB); PG8_STAGE(PG8_SA(0, 1), cA + hstep + k0, voffA);
        if (wr == 1) PG8_BAR;
        PG8_WAIT_V(4); PG8_BAR;
        PG8_STAGE(PG8_SB(1, 0), cB + k1, voffB); PG8_STAGE(PG8_SA(1, 0), cA + k1, voffA); PG8_STAGE(PG8_SB(1, 1), cB + hstep + k1, voffB);
        PG8_WAIT_V(6); PG8_BAR;
    }
    for (;;) {
        const bool has_next = S.next(ui + 1, nxt);
        const char* nA = has_next ? (const char*)g.A + (size_t)nxt.pm * tstep : cA; const char* nB = has_next ? (const char*)g.Bt + (size_t)nxt.pb * tstep : cB;
        const int nrot = has_next ? PG8_ROT(nxt) : rot;
        for (int t = 0; t < nt; t += 2) {
            const bool last = (t == nt - 2);
            const char* a1 = cA + PG8_KT(rot, t + 1);
            const char* a2 = last ? nA + PG8_KT(nrot, 0) : cA + PG8_KT(rot, t + 2); const char* b2 = last ? nB + PG8_KT(nrot, 0) : cB + PG8_KT(rot, t + 2);
            const char* a3 = last ? nA + PG8_KT(nrot, 1) : cA + PG8_KT(rot, t + 3); const char* b3 = last ? nB + PG8_KT(nrot, 1) : cB + PG8_KT(rot, t + 3);
            if (last && has_next) S.a_ready(nxt);
            if constexpr (SP2) {
            PG8_LDB(B0, 0, 0); PG8_LDB(B1, 0, 1); PG8_SCHED; PG8_LDA(At, 0, 0); PG8_STAGE(PG8_SA(1, 1), a1 + hstep, voffA);
            PG8_WAIT_V8; PG8_WAIT_L(0); PG8_BAR; PG8_MMA(0, 0, At, B0); PG8_MMA(0, 1, At, B1); PG8_BAR; PG8_SCHED;
            PG8_LDA(At, 0, 1); PG8_STAGE(PG8_SB(0, 0), b2, voffB); PG8_STAGE(PG8_SB(0, 1), b2 + hstep, voffB); PG8_STAGE(PG8_SA(0, 0), a2, voffA); PG8_PREFETCH(t + PG8_PFD);
            PG8_WAIT_V8; PG8_WAIT_L(0); PG8_BAR; PG8_MMA(1, 0, At, B0); PG8_MMA(1, 1, At, B1); PG8_BAR; PG8_SCHED;
            PG8_LDB(B0, 1, 0); PG8_LDB(B1, 1, 1); PG8_SCHED; PG8_LDA(At, 1, 0); PG8_STAGE(PG8_SA(0, 1), a2 + hstep, voffA);
            PG8_WAIT_V8; PG8_WAIT_L(0); PG8_BAR; PG8_MMA(0, 0, At, B0); PG8_MMA(0, 1, At, B1); PG8_BAR; PG8_SCHED;
            PG8_LDA(At, 1, 1); PG8_STAGE(PG8_SB(1, 0), b3, voffB); PG8_STAGE(PG8_SB(1, 1), b3 + hstep, voffB); PG8_STAGE(PG8_SA(1, 0), a3, voffA); PG8_PREFETCH(t + 1 + PG8_PFD);
            PG8_WAIT_V8; PG8_WAIT_L(0); PG8_BAR; PG8_MMA(1, 0, At, B0); PG8_MMA(1, 1, At, B1); PG8_BAR; PG8_SCHED;
            } else {
            PG8_LDB(B0, 0, 0); PG8_SCHED; PG8_LDA(At, 0, 0); PG8_STAGE(PG8_SA(1, 1), a1 + hstep, voffA);
            PG8_WAIT_L(8); PG8_BAR; PG8_WAIT_L(0); PG8_MMA(0, 0, At, B0); PG8_BAR; PG8_SCHED;
            PG8_LDB(B1, 0, 1); PG8_STAGE(PG8_SB(0, 0), b2, voffB);
            PG8_BAR; PG8_WAIT_L(0); PG8_MMA(0, 1, At, B1); PG8_BAR;
            PG8_LDA(At, 0, 1); PG8_STAGE(PG8_SA(0, 0), a2, voffA);
            PG8_BAR; PG8_WAIT_L(0); PG8_MMA(1, 0, At, B0); PG8_BAR; PG8_SCHED;
            PG8_STAGE(PG8_SB(0, 1), b2 + hstep, voffB);
            PG8_WAIT_V(6); PG8_BAR; PG8_MMA(1, 1, At, B1); PG8_BAR;
            PG8_LDB(B0, 1, 0); PG8_SCHED; PG8_LDA(At, 1, 0); PG8_STAGE(PG8_SA(0, 1), a2 + hstep, voffA);
            PG8_WAIT_L(8); PG8_BAR; PG8_WAIT_L(0); PG8_MMA(0, 0, At, B0); PG8_BAR; PG8_SCHED;
            PG8_LDB(B1, 1, 1); PG8_STAGE(PG8_SB(1, 0), b3, voffB);
            PG8_BAR; PG8_WAIT_L(0); PG8_MMA(0, 1, At, B1); PG8_BAR;
            PG8_LDA(At, 1, 1); PG8_STAGE(PG8_SA(1, 0), a3, voffA);
            PG8_BAR; PG8_WAIT_L(0); PG8_MMA(1, 0, At, B0); PG8_BAR; PG8_SCHED;
            PG8_STAGE(PG8_SB(1, 1), b3 + hstep, voffB);
            PG8_WAIT_V(6); PG8_BAR; PG8_MMA(1, 1, At, B1); PG8_BAR;
            }
        }
        if constexpr (FP8) asm volatile("s_nop 15\n\ts_nop 15" ::: "memory");
        if constexpr (ALIGN_EPI) { if (wr == 0) PG8_BAR; }
        if constexpr (!Epi::AFTER_DRAIN) { E(acc, cur, wr, wc, fr, fq); S.done(cur); }
        if (!has_next) break;
#pragma unroll
        for (int a = 0; a < 2; ++a)
#pragma unroll
            for (int b = 0; b < 2; ++b)
#pragma unroll
                for (int m = 0; m < 4; ++m)
#pragma unroll
                    for (int n = 0; n < 2; ++n) acc[a][b][m][n] = (f32x4){0.f, 0.f, 0.f, 0.f};
        cur = nxt; cA = nA; cB = nB; rot = nrot; ++ui;
        if constexpr (ALIGN_EPI) { if (wr == 1) PG8_BAR; }
    }
    PG8_WAIT_V(0);
    if constexpr (!ALIGN_EPI) { if (wr == 0) PG8_BAR; }
    PG8_BAR;
    if constexpr (Epi::AFTER_DRAIN) { E.fused(acc, cur, wr, wc, fr, fq, lds, wid, lane); S.done(cur); }
#undef PG8_ROT
#undef PG8_KT
#undef PG8_SA
#undef PG8_SB
#undef PG8_STAGE
#undef PG8_LDA
#undef PG8_LDB
#undef PG8_MMA
#undef PG8_WAIT_V
#undef PG8_WAIT_V8
#undef PG8_PREFETCH
#undef PG8_WAIT_L
#undef PG8_BAR
#undef PG8_SCHED
}
}
#include <cstdlib>
#include <vector>

#define XB_TMO      128
#define XB_XCNT(j)  (256  + 64 * (j))
#define XB_XSUB(j)  (1280 + 64 * (j))
#define XB_XGEN(j)  (2304 + 64 * (j))
#define XB_TOP      3328
#define XB_TOPGEN   3392
#define XCD_BAR_WORDS 3456
#define XB_SPIN_CAP (1u << 18)
#define LAS __attribute__((address_space(3)))

__device__ __forceinline__ unsigned xb_ld(unsigned* p)              { return __hip_atomic_load(p, __ATOMIC_RELAXED, __HIP_MEMORY_SCOPE_AGENT); }
__device__ __forceinline__ unsigned xb_add(unsigned* p, unsigned v) { return __hip_atomic_fetch_add(p, v, __ATOMIC_RELAXED, __HIP_MEMORY_SCOPE_AGENT); }
__device__ __forceinline__ unsigned xb_xcc_id() { return (unsigned)__builtin_amdgcn_s_getreg((3 << 11) | 20) & 0xFu; }
#define XB_SPIN(cond, bar) do { unsigned _sp = 0; while (cond) { __builtin_amdgcn_s_sleep(1); \
    if ((++_sp & 255u) == 0u) { if (xb_ld(&(bar)[XB_TMO])) break; if (_sp > XB_SPIN_CAP) { atomicAdd(&(bar)[XB_TMO], 1u); break; } } } } while (0)

struct XcdBarrier {
    unsigned* bar; unsigned x;
    volatile LAS unsigned* st;
};

__device__ __forceinline__ XcdBarrier xcd_barrier_post(unsigned* bar, volatile LAS unsigned* st) {
    XcdBarrier b; b.bar = bar; b.x = xb_xcc_id(); b.st = st;
    if (tid_opaque() == 0) (void)xb_add(&bar[XB_XCNT(b.x)], 1u);
    return b;
}
__device__ __forceinline__ void xcd_barrier_complete(unsigned* bar, unsigned x, unsigned& nloc, unsigned& nx) {
    const unsigned G = gridDim.x * gridDim.y * gridDim.z;
    unsigned sum, cnt, mine, sp = 0u;
    for (;;) {
        sum = 0u; cnt = 0u; mine = 0u;
#pragma unroll
        for (unsigned j = 0; j < 16; ++j) { const unsigned c = xb_ld(&bar[XB_XCNT(j)]); sum += c; cnt += (c > 0u) ? 1u : 0u; mine = (j == x) ? c : mine; }
        if (sum == G) break;
        __builtin_amdgcn_s_sleep(1);
        if ((++sp & 255u) == 0u) { if (xb_ld(&bar[XB_TMO])) break; if (sp > XB_SPIN_CAP) { atomicAdd(&bar[XB_TMO], 1u); break; } }
    }
    nloc = mine > 0u ? mine : 1u; nx = cnt > 0u ? cnt : 1u;
}

__device__ __forceinline__ void xcd_barrier(const XcdBarrier& b) {
    asm volatile("s_waitcnt vmcnt(0)" ::: "memory");
    __syncthreads();
    if (tid_opaque() == 0) {
        unsigned* bar = b.bar;
        __builtin_amdgcn_s_waitcnt(0);
        unsigned nloc = b.st[0], nx = b.st[1];
        if (nloc == 0u) { xcd_barrier_complete(bar, b.x, nloc, nx); b.st[0] = nloc; b.st[1] = nx; }
        const unsigned old = xb_add(&bar[XB_XSUB(b.x)], 1u);
        const unsigned gen = old / nloc;
        if (old + 1u == (gen + 1u) * nloc) {
            __builtin_amdgcn_fence(__ATOMIC_RELEASE, "agent");
            asm volatile("s_waitcnt vmcnt(0)" ::: "memory");
            const unsigned og = xb_add(&bar[XB_TOP], 1u);
            const unsigned tg = og / nx;
            if (og + 1u == (tg + 1u) * nx) xb_add(&bar[XB_TOPGEN], 1u);
            else XB_SPIN(xb_ld(&bar[XB_TOPGEN]) == tg, bar);
            __builtin_amdgcn_fence(__ATOMIC_ACQUIRE, "agent");
            xb_add(&bar[XB_XGEN(b.x)], 1u);
            asm volatile("s_waitcnt vmcnt(0)" ::: "memory");
        } else {
            XB_SPIN(xb_ld(&bar[XB_XGEN(b.x)]) == gen, bar);
            __builtin_amdgcn_fence(__ATOMIC_ACQUIRE, "agent");
            asm volatile("s_waitcnt vmcnt(0)" ::: "memory");
        }
    }
    __syncthreads();
}

using pg8::bf16_t; using pg8::bf16x8; using pg8::f32x4; using pg8::u32x4; using pg8::Unit; using pg8::Gemm;
typedef float f32x16 __attribute__((ext_vector_type(16)));
typedef unsigned u32x2 __attribute__((ext_vector_type(2)));

constexpr int T_TOK = 16384, SEQ = 4096, DM = 1024;
constexpr int NPW = 3328;
constexpr int PW_SRC = 3120;
constexpr int PP = 3072;
constexpr int C_AQ = 0, C_AK = 512, C_AV = 640, C_IQ = 768, C_MQ = 1024, C_MK = 1536, C_MV = 2048, C_MO = 2560;
constexpr int NEXP = 32, XROWS = 65536 + 32 * 256;
constexpr int NTHREADS = 512;
constexpr int LDS_BYTES = 160 * 1024;
constexpr int RDY_WORDS = 320;
constexpr float NORM_EPS = 1e-6f;

struct Params {
    const float *x, *mix_norm_w, *w_in, *conv_w, *conv_b, *igate_b, *fgate_b, *mlstm_norm_w, *w_out, *ffn_norm_w, *router_w, *router_b, *w_gu, *b_gu, *w_dn,
        *b_dn, *final_norm_w;
    float* out;
    bf16_t *wt_in, *wt_out, *wt_gu, *wt_dn, *xn, *proj, *ikb, *vt, *cq, *ck, *cst, *mix, *xbuf, *act, *ybuf;
    float *iw, *mi, *mf, *cb, *ropea, *ropei, *nu, *bl, *mloc, *ns, *ms, *topg, *rsv;
    bf16_t* ut;
    bf16_t* x1;
    unsigned long long* mask;
    int *tope, *topp, *cnt;
    unsigned* bar; unsigned* rdy;
    unsigned char *xn8, *wt_in8;
};

#ifndef MOE_FP8
#define MOE_FP8 1
#endif
#ifndef PROJ_FP8
#define PROJ_FP8 1
#endif
constexpr float FP8_XS = 4.0f, FP8_WS = 64.0f, FP8_INV = 1.0f / (4.0f * 64.0f);
__device__ __forceinline__ unsigned pk4_fp8(float a, float b, float c, float d) { int w = 0; w = __builtin_amdgcn_cvt_pk_fp8_f32(a, b, w, false); w = __builtin_amdgcn_cvt_pk_fp8_f32(c, d, w, true); return (unsigned)w; }
#ifndef WT_EPI
#define WT_EPI 0
#endif
__device__ __forceinline__ void store16_wt(void* base, size_t byte_off, u32x4 v) {
#if WT_EPI
    const __amdgpu_buffer_rsrc_t r = __builtin_amdgcn_make_buffer_rsrc(base, 0, 0x7fffffff, 0x00020000);
    __builtin_amdgcn_raw_buffer_store_b128(v, r, (unsigned)byte_off, 0, 16);
#else
    *(u32x4*)((unsigned char*)base + byte_off) = v;
#endif
}
__device__ __forceinline__ float bf2f(unsigned short h) { return __uint_as_float(((unsigned)h) << 16); }
__device__ __forceinline__ unsigned pk2(float lo, float hi) { typedef float f2_ __attribute__((ext_vector_type(2))); typedef __bf16 b2_ __attribute__((ext_vector_type(2))); return __builtin_bit_cast(unsigned, __builtin_convertvector((f2_){lo, hi}, b2_)); }
__device__ __forceinline__ unsigned pk2c(float lo, float hi) { typedef float f2_ __attribute__((ext_vector_type(2))); typedef __bf16 b2_ __attribute__((ext_vector_type(2))); return __builtin_bit_cast(unsigned, __builtin_convertvector((f2_){lo, hi}, b2_)); }
__device__ __forceinline__ unsigned short f2bf(float f) { return (unsigned short)(pk2(f, 0.f) & 0xffffu); }
__device__ __forceinline__ f32x4 mfma16(bf16x8 a, bf16x8 b, f32x4 c) { return __builtin_amdgcn_mfma_f32_16x16x32_bf16(a, b, c, 0, 0, 0); }
__device__ __forceinline__ f32x16 mfma32(bf16x8 a, bf16x8 b, f32x16 c) { return __builtin_amdgcn_mfma_f32_32x32x16_bf16(a, b, c, 0, 0, 0); }
__device__ __forceinline__ float wave_sum(float v) {
#pragma unroll
    for (int o = 32; o > 0; o >>= 1) v += __shfl_xor(v, o);
    return v;
}
__device__ __forceinline__ float wave_max(float v) {
#pragma unroll
    for (int o = 32; o > 0; o >>= 1) v = fmaxf(v, __shfl_xor(v, o));
    return v;
}
__device__ __forceinline__ u32x4 pack8(const float* f) { u32x4 w; w.x = pk2(f[0], f[1]); w.y = pk2(f[2], f[3]); w.z = pk2(f[4], f[5]); w.w = pk2(f[6], f[7]); return w; }
__device__ __forceinline__ void unpack8(u32x4 w, float* f) {
    f[0] = __uint_as_float(w.x << 16); f[1] = __uint_as_float(w.x & 0xffff0000u); f[2] = __uint_as_float(w.y << 16); f[3] = __uint_as_float(w.y & 0xffff0000u);
    f[4] = __uint_as_float(w.z << 16); f[5] = __uint_as_float(w.z & 0xffff0000u); f[6] = __uint_as_float(w.w << 16); f[7] = __uint_as_float(w.w & 0xffff0000u);
}
__device__ __forceinline__ float sigmoidf_(float z) { return __builtin_amdgcn_rcpf(1.0f + __builtin_amdgcn_exp2f(-1.4426950408889634f * z)); }

typedef short v4i16_t __attribute__((ext_vector_type(4)));
__device__ __forceinline__ v4i16_t lds_tr16(const bf16_t* ptr) { return __builtin_amdgcn_ds_read_tr16_b64_v4i16((__attribute__((address_space(3))) v4i16_t*)ptr); }
__device__ __forceinline__ int srccol_in(int n) {
    if (n < 1024) return n;
    if (n < 2560) return n + 40;
    if (n < 3072) return n + 48;
    if (n < 3112) return n - 3072 + 1024;
    if (n < 3120) return n - 3112 + 2600;
    return -1;
}
__device__ __forceinline__ int srccol_gu(int n) { return ((n & 128) ? 1024 : 0) + 128 * (n >> 8) + (n & 127); }

#ifndef CONV_NB
#define CONV_NB 4
#endif
struct TrTile { const float* src; bf16_t* dst; int ld, k0, n0, which; unsigned char* dst8; };
__device__ __forceinline__ TrTile tr_decode_in(const Params& p, int id) { TrTile t; t.src = p.w_in; t.dst = p.wt_in; t.ld = PW_SRC; t.n0 = (id % (NPW / 64)) * 64; t.k0 = (id / (NPW / 64)) * 64; t.which = 0; t.dst8 = p.wt_in8; return t; }
__device__ __forceinline__ TrTile tr_decode_s(const Params& p, int id) {
    const bool is_out = id < 256, is_gu = id < 256 + 16384;
    const int j = is_out ? id : (is_gu ? id - 256 : id - 256 - 16384);
    const int e = is_out ? 0 : (is_gu ? (j >> 9) : (j >> 8));
    const size_t esz_src = is_gu ? (size_t)1024 * 2048 : (size_t)1024 * 1024, esz_dst = (is_gu ? (size_t)2048 * 1024 : (size_t)1024 * 1024) * (MOE_FP8 ? 1 : 2);
    const float* sb = is_out ? p.w_out : (is_gu ? p.w_gu : p.w_dn); unsigned char* db = (unsigned char*)(is_out ? p.wt_out : (is_gu ? p.wt_gu : p.wt_dn));
    TrTile t; t.src = sb + (size_t)e * esz_src; t.dst = (bf16_t*)(db + (size_t)e * esz_dst); t.ld = (!is_out && is_gu) ? 2048 : 1024;
    t.n0 = ((!is_out && is_gu) ? (j & 31) : (j & 15)) * 64; t.k0 = ((!is_out && is_gu) ? ((j >> 5) & 15) : ((j >> 4) & 15)) * 64; t.which = is_out ? 2 : (is_gu ? 1 : 3); t.dst8 = nullptr;
    return t;
}
__device__ __forceinline__ void tr_load(const TrTile& t, int tid, float4 (&v)[2]) {
#pragma unroll
    for (int i = 0; i < 2; ++i) {
        const int k = (tid >> 4) + 32 * i, dn = t.n0 + (tid & 15) * 4; const int sc = (t.which == 1) ? srccol_gu(dn) : dn;
        { const f32x4 t4 = __builtin_nontemporal_load((const f32x4*)(t.src + (size_t)(t.k0 + k) * t.ld + sc)); v[i] = make_float4(t4[0], t4[1], t4[2], t4[3]); }
    }
}
__device__ __forceinline__ void tr_load_in(const TrTile& t, int tid, float4 (&v)[2]) {
#pragma unroll
    for (int i = 0; i < 2; ++i) {
        const int k = (tid >> 4) + 32 * i, dn = t.n0 + (tid & 15) * 4; const int sc = srccol_in(dn);
        const float4 ld4 = *(const float4*)(t.src + (size_t)(t.k0 + k) * t.ld + max(sc, 0));
        v[i] = (sc >= 0) ? ld4 : make_float4(0.f, 0.f, 0.f, 0.f);
    }
}
__device__ __forceinline__ void tr_lds_write(float* tile, int tid, const float4 (&v)[2]) {
#pragma unroll
    for (int i = 0; i < 2; ++i) { float* tp = tile + ((tid >> 4) + 32 * i) * 65 + (tid & 15) * 4; tp[0] = v[i].x; tp[1] = v[i].y; tp[2] = v[i].z; tp[3] = v[i].w; }
}
__device__ __forceinline__ void tr_store(const TrTile& t, const float* tile, int tid) {
    const int n = tid >> 3, k8 = (tid & 7) * 8; float f[8];
#pragma unroll
    for (int j = 0; j < 8; ++j) f[j] = tile[(k8 + j) * 65 + n];
#if MOE_FP8
    if (t.which == 1 || t.which == 3) { u32x2 w; w.x = pk4_fp8(f[0] * FP8_WS, f[1] * FP8_WS, f[2] * FP8_WS, f[3] * FP8_WS); w.y = pk4_fp8(f[4] * FP8_WS, f[5] * FP8_WS, f[6] * FP8_WS, f[7] * FP8_WS);
        *(u32x2*)((unsigned char*)t.dst + (size_t)(t.n0 + n) * 1024 + t.k0 + k8) = w; return; }
#endif
    *(u32x4*)(t.dst + (size_t)(t.n0 + n) * 1024 + t.k0 + k8) = pack8(f);
#if PROJ_FP8
    if (t.which == 0 && t.n0 + n < PP) { u32x2 w; w.x = pk4_fp8(f[0] * FP8_WS, f[1] * FP8_WS, f[2] * FP8_WS, f[3] * FP8_WS); w.y = pk4_fp8(f[4] * FP8_WS, f[5] * FP8_WS, f[6] * FP8_WS, f[7] * FP8_WS);
        *(u32x2*)(t.dst8 + (size_t)(t.n0 + n) * 1024 + t.k0 + k8) = w; }
#endif
}

#ifndef CONV_WAVES
#define CONV_WAVES 1
#endif
__device__ __forceinline__ int streamed_tiles_of_wg() { constexpr int NT_S = (CONV_WAVES && MOE_FP8) ? 256 : 256 + 16384 + 8192; const int G = gridDim.x; return (NT_S - (int)blockIdx.x + G - 1) / G; }
__device__ __forceinline__ void convert_streamed(const Params& p, unsigned char* lds, int qbeg, int qend) {
    const int tid = tid_opaque();
    float* tiles = (float*)lds; constexpr int TB = 64 * 65; const int G = gridDim.x;
    {
        constexpr int NB = CONV_NB;
        const int nper = qend - qbeg;
        if (nper <= 0) return;
        float4 cur[NB][2], nxt[NB][2];
#pragma unroll
        for (int j = 0; j < NB; ++j) { const int q = min(j, nper - 1); tr_load(tr_decode_s(p, blockIdx.x + (qbeg + q) * G), tid, cur[j]); }
        int par = 0;
        for (int q0 = 0; q0 < nper; q0 += NB) {
#pragma unroll
            for (int j = 0; j < NB; ++j) { const int q = min(q0 + NB + j, nper - 1); tr_load(tr_decode_s(p, blockIdx.x + (qbeg + q) * G), tid, nxt[j]); }
#pragma unroll
            for (int sub = 0; sub < NB; sub += 4, par ^= 1) {
#pragma unroll
                for (int j = 0; j < 4; ++j) tr_lds_write(tiles + (par * 4 + j) * TB, tid, cur[sub + j]);
                asm volatile("s_waitcnt lgkmcnt(0)" ::: "memory"); __builtin_amdgcn_s_barrier(); asm volatile("" ::: "memory");
#pragma unroll
                for (int j = 0; j < 4; ++j) if (q0 + sub + j < nper) tr_store(tr_decode_s(p, blockIdx.x + (qbeg + q0 + sub + j) * G), tiles + (par * 4 + j) * TB, tid);
            }
#pragma unroll
            for (int j = 0; j < NB; ++j) { cur[j][0] = nxt[j][0]; cur[j][1] = nxt[j][1]; }
        }
        __syncthreads();
    }
}

constexpr int NT_W8 = 16384 + 8192;
__device__ __forceinline__ void wt8_addr(const Params& p, int id, int lane, const float*& src, unsigned char*& dst, int& ld) {
    const bool gu = id < 16384; const int j = gu ? id : id - 16384;
    const int e = gu ? (j >> 9) : (j >> 8), nb = gu ? (j & 63) : (j & 31), kb = gu ? ((j >> 6) & 7) : ((j >> 5) & 7);
    ld = gu ? 2048 : 1024;
    const int ng = lane & 7, kg = lane >> 3, dn = nb * 32 + ng * 4, sc = gu ? srccol_gu(dn) : dn;
    src = (gu ? p.w_gu : p.w_dn) + (size_t)e * 1024 * ld + (size_t)(kb * 128 + kg * 16) * ld + sc;
    dst = (unsigned char*)(gu ? p.wt_gu : p.wt_dn) + (size_t)e * ld * 1024 + (size_t)dn * 1024 + kb * 128 + kg * 16;
}
__device__ __forceinline__ void wt8_load(const Params& p, int id, int lane, f32x4 (&v)[16]) {
    const float* src; unsigned char* dst; int ld; wt8_addr(p, id, lane, src, dst, ld);
#pragma unroll
    for (int j = 0; j < 16; ++j) v[j] = __builtin_nontemporal_load((const f32x4*)(src + (size_t)j * ld));
}
__device__ __forceinline__ void wt8_store(const Params& p, int id, int lane, const f32x4 (&v)[16]) {
    const float* src; unsigned char* dst; int ld; wt8_addr(p, id, lane, src, dst, ld);
#pragma unroll
    for (int c = 0; c < 4; ++c) { u32x4 w;
#pragma unroll
        for (int d = 0; d < 4; ++d) w[d] = pk4_fp8(v[4 * d][c] * FP8_WS, v[4 * d + 1][c] * FP8_WS, v[4 * d + 2][c] * FP8_WS, v[4 * d + 3][c] * FP8_WS);
        *(u32x4*)(dst + (size_t)c * 1024) = w; }
}
__device__ __forceinline__ void wt8_cvt(const f32x4 (&v)[16], u32x4 (&w)[4]) {
#pragma unroll
    for (int c = 0; c < 4; ++c)
#pragma unroll
        for (int d = 0; d < 4; ++d) w[c][d] = pk4_fp8(v[4 * d][c] * FP8_WS, v[4 * d + 1][c] * FP8_WS, v[4 * d + 2][c] * FP8_WS, v[4 * d + 3][c] * FP8_WS);
}
__device__ __forceinline__ void wt8_put(const Params& p, int id, int lane, const u32x4 (&w)[4]) {
    const float* src; unsigned char* dst; int ld; wt8_addr(p, id, lane, src, dst, ld);
#pragma unroll
    for (int c = 0; c < 4; ++c) *(u32x4*)(dst + (size_t)c * 1024) = w[c];
}
__device__ __forceinline__ void convert_fp8_waves(const Params& p, int i0) {
    const int tid = tid_opaque(), wid = __builtin_amdgcn_readfirstlane(tid >> 6), lane = tid & 63, stride = gridDim.x * 8, first = blockIdx.x * 8 + wid + i0 * stride;
    if (first >= NT_W8) return;
    const int n = (NT_W8 - first + stride - 1) / stride;
    f32x4 a[16], b[16];
    wt8_load(p, first, lane, a);
    int i = 0;
    for (; i + 3 < n; i += 2) {
        wt8_load(p, first + (i + 1) * stride, lane, b); wt8_store(p, first + i * stride, lane, a);
        wt8_load(p, first + (i + 2) * stride, lane, a); wt8_store(p, first + (i + 1) * stride, lane, b);
    }
    if (i + 1 < n) {
        wt8_load(p, first + (i + 1) * stride, lane, b); wt8_store(p, first + i * stride, lane, a);
        if (i + 2 < n) { wt8_load(p, first + (i + 2) * stride, lane, a); wt8_store(p, first + (i + 1) * stride, lane, b); wt8_store(p, first + (i + 2) * stride, lane, a); }
        else wt8_store(p, first + (i + 1) * stride, lane, b);
    } else wt8_store(p, first + i * stride, lane, a);
}

#ifdef PROBE_LOADONLY
__device__ __forceinline__ void convert_fp8_loadonly(const Params& p) {
    const int tid = tid_opaque(), wid = __builtin_amdgcn_readfirstlane(tid >> 6), lane = tid & 63, stride = gridDim.x * 8, first = blockIdx.x * 8 + wid;
    if (first >= NT_W8) return;
    const int n = (NT_W8 - first + stride - 1) / stride;
    f32x4 a[16], b[16]; float acc = 0.f;
    wt8_load(p, first, lane, a);
    for (int i = 0; i < n; i += 2) {
        wt8_load(p, first + min(i + 1, n - 1) * stride, lane, b);
#pragma unroll
        for (int j = 0; j < 16; ++j) acc += a[j][0] + a[j][1] + a[j][2] + a[j][3];
        wt8_load(p, first + min(i + 2, n - 1) * stride, lane, a);
#pragma unroll
        for (int j = 0; j < 16; ++j) acc += b[j][0] + b[j][1] + b[j][2] + b[j][3];
    }
#pragma unroll
    for (int j = 0; j < 16; ++j) acc += a[j][0];
    asm volatile("" :: "v"(acc));
}
#endif
#ifndef TK_TILES_N
#define TK_TILES_N 0
#endif
constexpr int TK_TILES = TK_TILES_N;
__device__ __forceinline__ void wh8_addr(const Params& p, int hid, int lane, const float*& src, unsigned char*& dst, int& ld) {
    const int id = hid >> 1, kh = hid & 1; const bool gu = id < 16384; const int j = gu ? id : id - 16384;
    const int e = gu ? (j >> 9) : (j >> 8), nb = gu ? (j & 63) : (j & 31), kb = gu ? ((j >> 6) & 7) : ((j >> 5) & 7);
    ld = gu ? 2048 : 1024;
    const int ng = lane & 7, kg = lane >> 3, dn = nb * 32 + ng * 4, sc = gu ? srccol_gu(dn) : dn, k0 = kb * 128 + kh * 64 + kg * 8;
    src = (gu ? p.w_gu : p.w_dn) + (size_t)e * 1024 * ld + (size_t)k0 * ld + sc;
    dst = (unsigned char*)(gu ? p.wt_gu : p.wt_dn) + (size_t)e * ld * 1024 + (size_t)dn * 1024 + k0;
}
__device__ __forceinline__ void wh8_load(const Params& p, int hid, int lane, f32x4 (&v)[8]) {
    const float* src; unsigned char* dst; int ld; wh8_addr(p, hid, lane, src, dst, ld);
#pragma unroll
    for (int j = 0; j < 8; ++j) v[j] = __builtin_nontemporal_load((const f32x4*)(src + (size_t)j * ld));
}
__device__ __forceinline__ void wh8_store(const Params& p, int hid, int lane, const f32x4 (&v)[8]) {
    const float* src; unsigned char* dst; int ld; wh8_addr(p, hid, lane, src, dst, ld);
#pragma unroll
    for (int c = 0; c < 4; ++c) { u32x2 w; w.x = pk4_fp8(v[0][c] * FP8_WS, v[1][c] * FP8_WS, v[2][c] * FP8_WS, v[3][c] * FP8_WS); w.y = pk4_fp8(v[4][c] * FP8_WS, v[5][c] * FP8_WS, v[6][c] * FP8_WS, v[7][c] * FP8_WS);
        *(u32x2*)(dst + (size_t)c * 1024) = w; }
}
struct HostQ { int first, stride, i, n; };
__device__ __forceinline__ int hostq_id(const HostQ& q, int k) { return 2 * (q.first + (k >> 1) * q.stride) + (k & 1); }
__device__ __forceinline__ void convert_fp8_rest(const Params& p, int i0, int i1) {
    const int tid = tid_opaque(), wid = __builtin_amdgcn_readfirstlane(tid >> 6), lane = tid & 63, stride = gridDim.x * 8, first = blockIdx.x * 8 + wid;
    for (int i = i0; i < i1 && first + i * stride < NT_W8; ++i) { f32x4 v[16]; wt8_load(p, first + i * stride, lane, v); wt8_store(p, first + i * stride, lane, v); }
}
__device__ __forceinline__ void phase_prologue(const Params& p, unsigned char* lds) {
    const int tid = tid_opaque(), wid = tid >> 6, lane = tid & 63;
    float* tiles = (float*)lds;
    constexpr int TB = 64 * 65;
    const int G = gridDim.x;
    {
        constexpr int NT_IN = (NPW / 64) * 16;
        for (int id0 = blockIdx.x; id0 < NT_IN; id0 += 4 * G) {
            float4 v[4][2];
#pragma unroll
            for (int j = 0; j < 4; ++j) { const int id = (id0 + j * G < NT_IN) ? id0 + j * G : id0; tr_load_in(tr_decode_in(p, id), tid, v[j]); }
#pragma unroll
            for (int j = 0; j < 4; ++j) tr_lds_write(tiles + j * TB, tid, v[j]);
            __syncthreads();
#pragma unroll
            for (int j = 0; j < 4; ++j) if (id0 + j * G < NT_IN) tr_store(tr_decode_in(p, id0 + j * G), tiles + j * TB, tid);
            __syncthreads();
        }
    }
#ifdef PROBE_READ
    {
        constexpr int NT_S = 256 + 16384 + 8192, NB = 4;
        const int nper = (NT_S - (int)blockIdx.x + G - 1) / G; float4 acc4 = make_float4(0.f, 0.f, 0.f, 0.f);
        for (int q0 = 0; q0 < nper; q0 += NB) {
            float4 v[NB][2];
#pragma unroll
            for (int j = 0; j < NB; ++j) { const int q = min(q0 + j, nper - 1); tr_load(tr_decode_s(p, blockIdx.x + q * G), tid, v[j]); }
#pragma unroll
            for (int j = 0; j < NB; ++j) { acc4.x += v[j][0].x + v[j][1].x; acc4.y += v[j][0].y + v[j][1].y; }
        }
        asm volatile("" :: "v"(acc4.x), "v"(acc4.y));
    }
#endif
    for (int row = blockIdx.x * 8 + wid; row < T_TOK; row += gridDim.x * 8) {
        const float4* xr = (const float4*)(p.x + (size_t)row * DM); float4 v[4]; float ss = 0.f;
#pragma unroll
        for (int i = 0; i < 4; ++i) { v[i] = xr[lane + 64 * i]; ss += v[i].x * v[i].x + v[i].y * v[i].y + v[i].z * v[i].z + v[i].w * v[i].w; }
        ss = wave_sum(ss); const float rs = 1.0f / sqrtf(ss * (1.0f / DM) + NORM_EPS);
#pragma unroll
        for (int i = 0; i < 4; ++i) { const float4 w = ((const float4*)p.mix_norm_w)[lane + 64 * i];
            u32x2 o; o.x = pk2(v[i].x * rs * w.x, v[i].y * rs * w.y); o.y = pk2(v[i].z * rs * w.z, v[i].w * rs * w.w);
            *(u32x2*)(p.xn + (size_t)row * DM + (lane + 64 * i) * 4) = o;
#if PROJ_FP8
            *(unsigned*)(p.xn8 + (size_t)row * DM + (lane + 64 * i) * 4) = pk4_fp8(v[i].x * rs * w.x * FP8_XS, v[i].y * rs * w.y * FP8_XS, v[i].z * rs * w.z * FP8_XS, v[i].w * rs * w.w * FP8_XS);
#endif
        }
    }
    for (int i = blockIdx.x * NTHREADS + tid; i < SEQ * 12; i += gridDim.x * NTHREADS) {
        const float invf_tab[12] = {1.000000000e+00f, 1.939227432e-01f, 3.760603070e-02f, 7.292664610e-03f, 1.414213562e-03f, 2.742481884e-04f, 5.318295734e-05f, 1.031338525e-05f, 1.000000000e+00f, 3.760603070e-02f, 1.414213562e-03f, 5.318295734e-05f};
        const int pos = i / 12, j = i % 12; const bool att = j < 8; const int jj = att ? j : j - 8;
        float invf = invf_tab[0];
#pragma unroll
        for (int q = 1; q < 12; ++q) invf = (j == q) ? invf_tab[q] : invf;
        const float ang = (float)pos * invf; float sn, cs; sincosf(ang, &sn, &cs);
        float* dst = att ? (p.ropea + ((size_t)pos * 8 + jj) * 2) : (p.ropei + ((size_t)pos * 4 + jj) * 2);
        dst[0] = cs; dst[1] = sn;
    }
    if (blockIdx.x == 0 && tid < 64) p.cnt[tid] = 0;
    if (blockIdx.x == 1 && tid < RDY_WORDS) p.rdy[tid] = 0u;
}

template <bool F8>
struct EpiProjT {
    static constexpr bool PERM = true, AFTER_DRAIN = false;
    bf16_t* proj; bf16_t* ikb; float* iw; float* mi; float* mf; const float* ropea; const float* ropei; const float* igb; const float* fgb;
    __device__ __forceinline__ void operator()(const f32x4 (&acc)[2][2][4][2], const Unit& u, int wr, int wc, int fr, int fq) const {
        const float idx_w_scale = 0.35355339059327373f * 0.17677669529663687f;
#pragma unroll
        for (int ai = 0; ai < 2; ++ai)
#pragma unroll
            for (int m = 0; m < 4; ++m) {
                const int row = u.pm * 256 + ai * 128 + wr * 64 + m * 16 + fr; const int pos = row & (SEQ - 1);
#pragma unroll
                for (int bj = 0; bj < 2; ++bj) {
                    f32x4 v0 = acc[ai][bj][m][0], v1 = acc[ai][bj][m][1];
                    if constexpr (F8) { v0 *= FP8_INV; v1 *= FP8_INV; }
                    const int cw = u.pn * 256 + bj * 128 + wc * 32;
                    if (cw < C_AV) {
                        if ((cw & 32) == 0) {
                            f32x4 q0, q1;
#pragma unroll
                            for (int j = 0; j < 4; ++j) { q0[j] = __shfl_xor(v0[j], 16); q1[j] = __shfl_xor(v1[j], 16); }
                            if (fq < 2) {
                                const float4* cs = (const float4*)(ropea + (size_t)pos * 16);
                                const float4 c01 = cs[0], c23 = cs[1], c45 = cs[2], c67 = cs[3];
                                const float co[8] = {c01.x, c01.z, c23.x, c23.z, c45.x, c45.z, c67.x, c67.z}, si[8] = {c01.y, c01.w, c23.y, c23.w, c45.y, c45.w, c67.y, c67.w};
                                if (fq == 0) {
#pragma unroll
                                    for (int j = 0; j < 4; ++j) { v0[j] = v0[j] * co[j] - q0[j] * si[j]; v1[j] = v1[j] * co[4 + j] - q1[j] * si[4 + j]; }
                                } else {
#pragma unroll
                                    for (int j = 0; j < 4; ++j) { v0[j] = v0[j] * co[j] + q0[j] * si[j]; v1[j] = v1[j] * co[4 + j] + q1[j] * si[4 + j]; }
                                }
                            }
                        }
                    } else if (cw >= C_IQ && cw < C_MQ) {
                        if (fq == 0) {
                            const float4* cs = (const float4*)(ropei + (size_t)pos * 8); const float4 c01 = cs[0], c23 = cs[1];
                            const float co[4] = {c01.x, c01.z, c23.x, c23.z}, si[4] = {c01.y, c01.w, c23.y, c23.w};
#pragma unroll
                            for (int j = 0; j < 4; ++j) { const float a = v0[j], b = v1[j]; v0[j] = a * co[j] - b * si[j]; v1[j] = b * co[j] + a * si[j]; }
                        }
                    }
                    u32x4 w; w.x = pk2(v0[0], v0[1]); w.y = pk2(v0[2], v0[3]); w.z = pk2(v1[0], v1[1]); w.w = pk2(v1[2], v1[3]);
                    store16_wt(proj, ((size_t)row * PP + cw + fq * 8) * 2, w);
                }
            }
    }
};

struct EpiResid {
    static constexpr bool PERM = true, AFTER_DRAIN = false;
    const float* x; bf16_t* x1;
    __device__ __forceinline__ void operator()(const f32x4 (&acc)[2][2][4][2], const Unit& u, int wr, int wc, int fr, int fq) const {
#pragma unroll
        for (int ai = 0; ai < 2; ++ai)
#pragma unroll
            for (int m = 0; m < 4; ++m) {
                const int row = u.pm * 256 + ai * 128 + wr * 64 + m * 16 + fr;
#pragma unroll
                for (int bj = 0; bj < 2; ++bj) {
                    const size_t off = (size_t)row * DM + u.pn * 256 + bj * 128 + wc * 32 + fq * 8;
                    const f32x4 a = *(const f32x4*)(x + off), b = *(const f32x4*)(x + off + 4);
                    const f32x4 s0 = a + acc[ai][bj][m][0], s1 = b + acc[ai][bj][m][1];
                    u32x4 w; w.x = pk2(s0[0], s0[1]); w.y = pk2(s0[2], s0[3]); w.z = pk2(s1[0], s1[1]); w.w = pk2(s1[2], s1[3]); store16_wt(x1, off * 2, w);
                }
            }
    }
};

template <bool WT>
struct EpiSwigluT {
    static constexpr bool PERM = true, AFTER_DRAIN = false;
    const float* bgu; bf16_t* act;
    __device__ __forceinline__ void operator()(const f32x4 (&acc)[2][2][4][2], const Unit& u, int wr, int wc, int fr, int fq) const {
        typedef float f32x2 __attribute__((ext_vector_type(2)));
        const int hc = u.pn * 128 + wc * 32 + fq * 8;
        const float* bg = bgu + (size_t)u.ex * 2048 + hc;
        f32x2 bgl[4], bli[4];
#pragma unroll
        for (int j = 0; j < 4; ++j) { bgl[j] = *(const f32x2*)(bg + 2 * j); bli[j] = *(const f32x2*)(bg + 1024 + 2 * j); }
        const float inv = MOE_FP8 ? FP8_INV : 1.0f, xs = MOE_FP8 ? FP8_XS : 1.0f;
#if MOE_FP8
        typedef unsigned u32x2v __attribute__((ext_vector_type(2)));
        const __amdgpu_buffer_rsrc_t arsrc = __builtin_amdgcn_make_buffer_rsrc((void*)act, 0, XROWS * 1024, 0x00020000);
#endif
#pragma unroll
        for (int ai = 0; ai < 2; ++ai)
#pragma unroll
            for (int mp = 0; mp < 2; ++mp) {
                u32x2 w[2];
#pragma unroll
                for (int mm = 0; mm < 2; ++mm) {
                    const int m = 2 * mp + mm; f32x2 o[4];
#pragma unroll
                    for (int j = 0; j < 4; ++j) {
                        const f32x4& ga = acc[ai][0][m][j >> 1]; const f32x4& la = acc[ai][1][m][j >> 1];
                        f32x2 g = (f32x2){ga[2 * (j & 1)], ga[2 * (j & 1) + 1]} * inv + bgl[j];
                        f32x2 l = (f32x2){la[2 * (j & 1)], la[2 * (j & 1) + 1]} * inv + bli[j];
                        g = __builtin_elementwise_min(g, (f32x2){7.0f, 7.0f});
                        l = __builtin_elementwise_min(__builtin_elementwise_max(l, (f32x2){-7.0f, -7.0f}), (f32x2){7.0f, 7.0f});
                        const f32x2 t = g * (-1.702f * 1.4426950408889634f);
                        f32x2 e; e.x = __builtin_amdgcn_exp2f(t.x); e.y = __builtin_amdgcn_exp2f(t.y);
                        const f32x2 d = e + 1.0f; f32x2 r; r.x = __builtin_amdgcn_rcpf(d.x); r.y = __builtin_amdgcn_rcpf(d.y);
                        o[j] = (g * r) * (l * xs + xs);
                    }
#if MOE_FP8
                    w[mm].x = pk4_fp8(o[0].x, o[0].y, o[1].x, o[1].y); w[mm].y = pk4_fp8(o[2].x, o[2].y, o[3].x, o[3].y);
#else
                    { const int row = u.pm * 256 + ai * 128 + wr * 64 + m * 16 + fr; u32x4 ww; ww.x = pk2(o[0].x, o[0].y); ww.y = pk2(o[1].x, o[1].y); ww.z = pk2(o[2].x, o[2].y); ww.w = pk2(o[3].x, o[3].y); *(u32x4*)(act + (size_t)row * 1024 + hc) = ww; }
#endif
                }
#if MOE_FP8
                {
                    const u32x2v lo = __builtin_amdgcn_permlane16_swap(w[0].x, w[1].x, false, false), hi = __builtin_amdgcn_permlane16_swap(w[0].y, w[1].y, false, false);
                    const u32x4 v = {lo[0], hi[0], lo[1], hi[1]};
                    const int row = u.pm * 256 + ai * 128 + wr * 64 + (2 * mp + (fq & 1)) * 16 + fr;
                    __builtin_amdgcn_raw_buffer_store_b128(v, arsrc, (unsigned)(row * 1024 + hc - (fq & 1) * 8), 0, (WT || WT_EPI) ? 16 : 0);
                }
#endif
            }
    }
};

#ifndef Y_FP8
#define Y_FP8 1
#endif
constexpr float FP8_YS = 16.0f;
__device__ __forceinline__ float yq(float v) { return __builtin_amdgcn_fmed3f(v * FP8_YS, -440.0f, 440.0f); }
struct EpiBiasBf16 {
    static constexpr bool PERM = true, AFTER_DRAIN = false;
    const float* bdn; bf16_t* y;
    __device__ __forceinline__ void operator()(const f32x4 (&acc)[2][2][4][2], const Unit& u, int wr, int wc, int fr, int fq) const {
#pragma unroll
        for (int bj = 0; bj < 2; ++bj) {
            const int c8 = u.pn * 256 + bj * 128 + wc * 32 + fq * 8; const float* bb = bdn + (size_t)u.ex * 1024 + c8;
            const f32x4 b0 = *(const f32x4*)bb, b1 = *(const f32x4*)(bb + 4);
#pragma unroll
            for (int ai = 0; ai < 2; ++ai)
#pragma unroll
                for (int m = 0; m < 4; ++m) {
                    const int row = u.pm * 256 + ai * 128 + wr * 64 + m * 16 + fr;
                    const f32x4 v0 = acc[ai][bj][m][0] * (MOE_FP8 ? FP8_INV : 1.0f) + b0, v1 = acc[ai][bj][m][1] * (MOE_FP8 ? FP8_INV : 1.0f) + b1;
#if Y_FP8
                    { u32x2 w; w.x = pk4_fp8(yq(v0[0]), yq(v0[1]), yq(v0[2]), yq(v0[3])); w.y = pk4_fp8(yq(v1[0]), yq(v1[1]), yq(v1[2]), yq(v1[3])); *(u32x2*)((unsigned char*)y + (size_t)row * 1024 + c8) = w; }
#else
                    u32x4 w; w.x = pk2(v0[0], v0[1]); w.y = pk2(v0[2], v0[3]); w.z = pk2(v1[0], v1[1]); w.w = pk2(v1[2], v1[3]);
                    *(u32x4*)(y + (size_t)row * 1024 + c8) = w;
#endif
                }
        }
    }
};

template <class Base> struct OneUnit {
    Base base; int which;
    __device__ __forceinline__ bool next(int i, Unit& u) const { return i == 0 && base.next(which, u); }
    __device__ __forceinline__ void a_ready(const Unit&) const {}
    __device__ __forceinline__ void done(const Unit&) const {}
};
template <int MODE>
struct GroupOrderT {
    const int* tstart; int ncol, G, c, ibeg, iend; unsigned* rdy; int lim;
    __device__ __forceinline__ bool next(int i_, Unit& u) const {
        const int i = i_ + ibeg; if (i >= iend) return false;
        int rt, ct;
        if (G == 256) {
            const int rpx = 32 / ncol, y = c >> 3, x = (MODE == 2) ? 7 - (c & 7) : (c & 7); ct = y % ncol; rt = i * (256 / ncol) + x * rpx + y / ncol;
        } else { const int L = i * G + c; rt = L / ncol; ct = L - rt * ncol; }
        if (rt >= tstart[NEXP]) return false;
        int e = 0;
        while (tstart[e + 1] <= rt) ++e;
        u.pm = rt; u.pn = ct; u.pb = e * ncol + ct; u.ex = e; return true;
    }
    __device__ __forceinline__ void a_ready(const Unit& u) const {
        if (MODE == 2) {
            if (u.pm < lim) return;
            unsigned sp = 0;
            while ((unsigned)__builtin_amdgcn_readfirstlane((int)__hip_atomic_load(rdy + u.pm, __ATOMIC_RELAXED, __HIP_MEMORY_SCOPE_AGENT)) < 64u) { __builtin_amdgcn_s_sleep(1); if (++sp > (1u << 22)) break; }
            asm volatile("buffer_inv sc1" ::: "memory");
        }
    }
    __device__ __forceinline__ void done(const Unit& u) const {
        if (MODE == 1) {
            asm volatile("s_waitcnt vmcnt(0)" ::: "memory");
            if ((tid_opaque() & 63) == 0) __hip_atomic_fetch_add(rdy + u.pm, 1u, __ATOMIC_RELAXED, __HIP_MEMORY_SCOPE_AGENT);
        }
    }
};
typedef GroupOrderT<0> GroupOrder;
__device__ __forceinline__ void proj_small(const Params& p, int blk, unsigned char* lds) {
    const int tid = tid_opaque(), wid = tid >> 6, lane = tid & 63, fr = lane & 15, fq = lane >> 4;
    const int r0 = blk * 64 + (wid & 3) * 16, kh = wid >> 2;
    const bf16_t* ap = p.xn + (size_t)(r0 + fr) * 1024 + kh * 512 + fq * 8;
    const bf16_t* bp0 = p.wt_in + (size_t)(PP + fr) * 1024 + kh * 512 + fq * 8; const bf16_t* bp1 = bp0 + 16 * 1024; const bf16_t* bp2 = bp0 + 32 * 1024;
    f32x4 c0 = {0.f, 0.f, 0.f, 0.f}, c1 = {0.f, 0.f, 0.f, 0.f}, c2 = {0.f, 0.f, 0.f, 0.f};
#pragma unroll 8
    for (int ks = 0; ks < 16; ++ks) {
        const bf16x8 a = *(const bf16x8*)(ap + ks * 32), b0 = *(const bf16x8*)(bp0 + ks * 32), b1 = *(const bf16x8*)(bp1 + ks * 32), b2 = *(const bf16x8*)(bp2 + ks * 32);
        c0 = mfma16(a, b0, c0); c1 = mfma16(a, b1, c1); c2 = mfma16(a, b2, c2);
    }
    f32x4* red = (f32x4*)lds;
    if (kh == 1) { red[((wid & 3) * 3 + 0) * 64 + lane] = c0; red[((wid & 3) * 3 + 1) * 64 + lane] = c1; red[((wid & 3) * 3 + 2) * 64 + lane] = c2; }
    __syncthreads();
    if (kh == 0) {
        c0 += red[((wid & 3) * 3 + 0) * 64 + lane]; c1 += red[((wid & 3) * 3 + 1) * 64 + lane]; c2 += red[((wid & 3) * 3 + 2) * 64 + lane];
        const float idx_w_scale = 0.35355339059327373f * 0.17677669529663687f;
#pragma unroll
        for (int r = 0; r < 4; ++r) {
            const int row = r0 + 4 * fq + r, pos = row & (SEQ - 1); const float own = c0[r], oth = __shfl_xor(own, 4); float v = own;
            if (fr < 8) { const float2 cs = *(const float2*)(p.ropei + ((size_t)pos * 4 + (fr & 3)) * 2); v = (fr < 4) ? own * cs.x - oth * cs.y : own * cs.x + oth * cs.y; }
            p.ikb[(size_t)row * 32 + fr] = f2bf(v); p.ikb[(size_t)row * 32 + 16 + fr] = f2bf(c1[r]);
        }
#pragma unroll
        for (int r = 0; r < 4; ++r) {
            const int row = r0 + 4 * fq + r; const float v = c2[r];
            if (fr < 8) p.iw[(size_t)row * 8 + fr] = v * idx_w_scale;
            else if (fr < 12) p.mi[(size_t)row * 4 + fr - 8] = v + p.igate_b[fr - 8];
            else { const float z = v + p.fgate_b[fr - 12]; p.mf[(size_t)row * 4 + fr - 12] = fminf(z, 0.f) - log1pf(__expf(-fabsf(z))); }
        }
    }
    __syncthreads();
}

__device__ __forceinline__ bf16x8 tr_frag(const bf16_t* T, int ld, int kbase, int c0, int lane) {
    const int q = lane >> 4, qq = (lane & 15) >> 2, pp = lane & 3;
    const v4i16_t t1 = lds_tr16(T + (kbase + 8 * q + qq) * ld + c0 + 4 * pp), t2 = lds_tr16(T + (kbase + 8 * q + 4 + qq) * ld + c0 + 4 * pp);
    return (bf16x8){t1[0], t1[1], t1[2], t1[3], t2[0], t2[1], t2[2], t2[3]};
}
__device__ __forceinline__ void mlstm_local(const Params& p, int item, unsigned char* lds) {
    const int tid = tid_opaque(), wid = tid >> 6, lane = tid & 63, fr = lane & 15, fq = lane >> 4;
    const int bh = item >> 6, c = item & 63, b = bh >> 2, h = bh & 3, t0 = b * SEQ + c * 64;
    bf16_t* kw = (bf16_t*)lds;
    bf16_t* vl = kw + 64 * 136;
    float* wgt = (float*)(lds + 2 * 64 * 136 * 2);
    float* cwl = wgt + 64;
    if (wid == 0) {
        const float lf = p.mf[(size_t)(t0 + lane) * 4 + h], ii = p.mi[(size_t)(t0 + lane) * 4 + h];
        float bs = lf;
#pragma unroll
        for (int d = 1; d < 64; d <<= 1) { const float o = __shfl_up(bs, d); if (lane >= d) bs += o; }
        const float bl = __shfl(bs, 63); const float wl = bl - bs + ii; const float mx = wave_max(wl);
        wgt[lane] = __expf(wl - mx); p.cb[(size_t)(t0 + lane) * 4 + h] = bs;
        if (lane == 0) { p.bl[item] = bl; p.mloc[item] = mx; }
    } else {
        for (int i = tid - 64; i < 1280; i += 448) { const int j = i >> 8, cc = i & 255; const int src = (cc < 128 ? h * 128 + cc : 512 + h * 128 + cc - 128);
            cwl[i] = (j < 4) ? p.conv_w[j * 1024 + src] : p.conv_b[src]; }
    }
    __syncthreads();
    {
        const int tok = tid >> 3, d0 = (tid & 7) * 16, pos = c * 64 + tok; float aq[16], ak[16];
#pragma unroll
        for (int i = 0; i < 16; ++i) { aq[i] = cwl[1024 + d0 + i]; ak[i] = cwl[1024 + 128 + d0 + i]; }
#pragma unroll
        for (int j = 0; j < 4; ++j) {
            const int pp = pos - 3 + j;
            if (pp >= 0) {
                const bf16_t* rq = p.proj + (size_t)(b * SEQ + pp) * PP + C_MQ + h * 128 + d0; const bf16_t* rk = p.proj + (size_t)(b * SEQ + pp) * PP + C_MK + h * 128 + d0;
                float xq[16], xk[16]; unpack8(*(const u32x4*)rq, xq); unpack8(*(const u32x4*)(rq + 8), xq + 8); unpack8(*(const u32x4*)rk, xk); unpack8(*(const u32x4*)(rk + 8), xk + 8);
                const float* wq = cwl + j * 256 + d0; const float* wk = wq + 128;
#pragma unroll
                for (int i = 0; i < 16; ++i) { aq[i] += wq[i] * xq[i]; ak[i] += wk[i] * xk[i]; }
            }
        }
        const float wt = wgt[tok]; const float ksc = 0.08838834764831845f;
        const bf16_t* rv = p.proj + (size_t)(t0 + tok) * PP + C_MV + h * 128 + d0; const u32x4 v0 = *(const u32x4*)rv, v1 = *(const u32x4*)(rv + 8);
#pragma unroll
        for (int i = 0; i < 16; ++i) { aq[i] = aq[i] * sigmoidf_(aq[i]); ak[i] = ak[i] * sigmoidf_(ak[i]) * ksc; }
        bf16_t* oq = p.cq + (size_t)(t0 + tok) * 512 + h * 128 + d0; bf16_t* ok = p.ck + (size_t)(t0 + tok) * 512 + h * 128 + d0;
        *(u32x4*)oq = pack8(aq); *(u32x4*)(oq + 8) = pack8(aq + 8); *(u32x4*)ok = pack8(ak); *(u32x4*)(ok + 8) = pack8(ak + 8);
#pragma unroll
        for (int i = 0; i < 16; ++i) ak[i] *= wt;
        *(u32x4*)(kw + tok * 136 + d0) = pack8(ak); *(u32x4*)(kw + tok * 136 + d0 + 8) = pack8(ak + 8);
        *(u32x4*)(vl + tok * 136 + d0) = v0; *(u32x4*)(vl + tok * 136 + d0 + 8) = v1;
    }
    __syncthreads();
    {
        bf16x8 a[2];
#pragma unroll
        for (int ks = 0; ks < 2; ++ks) a[ks] = tr_frag(vl, 136, 32 * ks, 16 * wid, lane);
#pragma unroll
        for (int db = 0; db < 8; ++db) {
            f32x4 acc = {0.f, 0.f, 0.f, 0.f};
#pragma unroll
            for (int ks = 0; ks < 2; ++ks) { const bf16x8 bb = tr_frag(kw, 136, 32 * ks, 16 * db, lane); acc = mfma16(bb, a[ks], acc); }
            { u32x2 w; w.x = pk2c(acc[0], acc[1]); w.y = pk2c(acc[2], acc[3]); *(u32x2*)(p.ut + ((size_t)item * 128 + 16 * wid + fr) * 128 + 16 * db + 4 * fq) = w; }
        }
    }
    if (tid < 128) { float s = 0.f;
#pragma unroll 8
        for (int i = 0; i < 64; ++i) s += bf2f(kw[i * 136 + tid]);
        p.nu[(size_t)item * 128 + tid] = s; }
    __syncthreads();
}

__device__ __forceinline__ int slotpos(int key) { const int x = key & 15; return (key & 48) | (8 * ((x >> 2) & 1) + 4 * (x >> 3) + (x & 3)); }
__device__ __forceinline__ void vtrans(const Params& p, int item, unsigned char* lds) {
    const int tid = tid_opaque(), wid = tid >> 6, lane = tid & 63;
    const int bg = item >> 6, c = item & 63, b = bg >> 1, g = bg & 1;
    bf16_t* tl = (bf16_t*)lds;
    { const int key = lane, d8 = wid * 8; float v[8]; unpack8(*(const u32x4*)(p.proj + (size_t)(b * SEQ + c * 64 + key) * PP + C_AV + g * 64 + d8), v); const int sp = slotpos(key);
#pragma unroll
      for (int i = 0; i < 8; ++i) tl[(d8 + i) * 72 + sp] = f2bf(v[i]); }
    __syncthreads();
    { const int d = tid >> 3, ch = tid & 7; *(u32x4*)(p.vt + ((size_t)(bg * 64 + d)) * SEQ + c * 64 + ch * 8) = *(const u32x4*)(tl + d * 72 + ch * 8); }
    __syncthreads();
}

__device__ __forceinline__ void lds_add_u32(unsigned* p, unsigned v) { (void)__hip_atomic_fetch_add((__attribute__((address_space(3))) unsigned*)p, v, __ATOMIC_RELAXED, __HIP_MEMORY_SCOPE_WORKGROUP); }
__device__ __forceinline__ void lds_or_u32(unsigned* p, unsigned v) { (void)__hip_atomic_fetch_or((__attribute__((address_space(3))) unsigned*)p, v, __ATOMIC_RELAXED, __HIP_MEMORY_SCOPE_WORKGROUP); }
struct TopkPre { bf16x8 afr[2][2]; float wv[2][2][4]; bf16x8 bfr[4]; };
__device__ __forceinline__ void topk_prefetch(const Params& p, int j, TopkPre& q, int wid, int fr, int fq) {
    const int k = j >> 8, w = j & 255; const int cc = (w & 7) * 4 + (k & 3); const int c = (k < 4) ? cc : 63 - cc; const int b = (w >> 3) & 3, sub = w >> 5;
    const int t0 = b * SEQ + c * 64 + sub * 8, nkb = 4 * (c + 1);
#pragma unroll
    for (int pr = 0; pr < 2; ++pr)
#pragma unroll
        for (int hf = 0; hf < 2; ++hf) {
            const int tok = 4 * pr + (fr >> 2), head = 4 * hf + (fr & 3);
            q.afr[pr][hf] = *(const bf16x8*)(p.proj + (size_t)(t0 + tok) * PP + C_IQ + head * 32 + fq * 8);
            const f32x4 w4 = *(const f32x4*)(p.iw + (size_t)(t0 + 4 * pr + fq) * 8 + 4 * hf);
#pragma unroll
            for (int r = 0; r < 4; ++r) q.wv[pr][hf][r] = w4[r];
        }
    const bf16_t* kbp = p.ikb + (size_t)(b * SEQ + fr) * 32 + fq * 8; const int kb = (wid * 4 < nkb) ? wid * 4 : 0;
#pragma unroll
    for (int u = 0; u < 4; ++u) q.bfr[u] = *(const bf16x8*)(kbp + (size_t)(kb + u) * 16 * 32);
}
#ifndef CONV_IN_TOPK
#define CONV_IN_TOPK 1
#endif
__device__ __forceinline__ void idx_topk(const Params& p, int j, unsigned char* lds, const TopkPre& pc, TopkPre& pn, int jnext, bool has_next, bool do_b, int& qi) {
    const int tid = tid_opaque(), wid = tid >> 6, lane = tid & 63, fr = lane & 15, fq = lane >> 4;
    const int k = j >> 8, w = j & 255; const int cc = (w & 7) * 4 + (k & 3); const int c = (k < 4) ? cc : 63 - cc; const int b = (w >> 3) & 3, sub = w >> 5;
    const int t0 = b * SEQ + c * 64 + sub * 8; const int nj = c + 1, nkb = 4 * nj;
    constexpr int SCP = 4096 + 16;
    float* sc = (float*)lds;
    unsigned* hist = (unsigned*)(lds + 8 * SCP * 4) + wid * 512;
    unsigned* wsel = (unsigned*)(lds + 8 * SCP * 4 + 16384) + wid * 128;
    float* cval = (float*)(lds + 8 * SCP * 4 + 16384 + 4096) + wid * 64;
    int* cidx = (int*)(lds + 8 * SCP * 4 + 16384 + 4096 + 2048) + wid * 64;
    float* pm = (float*)(lds + 8 * SCP * 4 + 16384 + 4096 + 4096);
    {
        const bf16x8 (&afr)[2][2] = pc.afr; const float (&wv)[2][2][4] = pc.wv;
        float mn[2] = {INFINITY, INFINITY}, mx[2] = {-INFINITY, -INFINITY};
        const bf16_t* kbp = p.ikb + (size_t)(b * SEQ + fr) * 32 + fq * 8;
        bf16x8 bfr[4], nfr[4];
#pragma unroll
        for (int u = 0; u < 4; ++u) bfr[u] = pc.bfr[u];
        for (int kb0 = wid * 4; kb0 < nkb; kb0 += 32) {
            const int kn = (kb0 + 32 < nkb) ? kb0 + 32 : kb0;
#pragma unroll
            for (int u = 0; u < 4; ++u) nfr[u] = *(const bf16x8*)(kbp + (size_t)(kn + u) * 16 * 32);
#pragma unroll
            for (int u = 0; u < 4; ++u)
#pragma unroll
                for (int pr = 0; pr < 2; ++pr) {
                    f32x4 c0 = {0.f, 0.f, 0.f, 0.f}, c1 = {0.f, 0.f, 0.f, 0.f};
                    c0 = mfma16(afr[pr][0], bfr[u], c0); c1 = mfma16(afr[pr][1], bfr[u], c1);
                    float s = wv[pr][0][0] * fmaxf(c0[0], 0.f); s += wv[pr][0][1] * fmaxf(c0[1], 0.f); s += wv[pr][0][2] * fmaxf(c0[2], 0.f); s += wv[pr][0][3] * fmaxf(c0[3], 0.f);
                    s += wv[pr][1][0] * fmaxf(c1[0], 0.f); s += wv[pr][1][1] * fmaxf(c1[1], 0.f); s += wv[pr][1][2] * fmaxf(c1[2], 0.f); s += wv[pr][1][3] * fmaxf(c1[3], 0.f);
                    s += 0.0f;
                    sc[(4 * pr + fq) * SCP + (kb0 + u) * 16 + fr] = s; mn[pr] = fminf(mn[pr], s); mx[pr] = fmaxf(mx[pr], s);
                }
#pragma unroll
            for (int u = 0; u < 4; ++u) bfr[u] = nfr[u];
        }
#pragma unroll
        for (int pr = 0; pr < 2; ++pr) {
#pragma unroll
            for (int o = 1; o < 16; o <<= 1) { mn[pr] = fminf(mn[pr], __shfl_xor(mn[pr], o)); mx[pr] = fmaxf(mx[pr], __shfl_xor(mx[pr], o)); }
            if (fr == 0) { pm[(wid * 8 + 4 * pr + fq) * 2] = mn[pr]; pm[(wid * 8 + 4 * pr + fq) * 2 + 1] = mx[pr]; }
        }
    }
    __syncthreads();
    constexpr bool PRE_EARLY = !(CONV_IN_TOPK && MOE_FP8) || TK_TILES == 0;
    if (has_next && (PRE_EARLY || !do_b)) topk_prefetch(p, jnext, pn, wid, fr, fq);
#ifndef BREP
#define BREP 1
#endif
    if (do_b) for (int brep_ = 0; brep_ < BREP; ++brep_) {
        const float* row = sc + wid * SCP;
        unsigned long long word = 0ull;
#if CONV_IN_TOPK && MOE_FP8
        f32x4 cv[16]; int cid = -1;
        const int cfirst = blockIdx.x * 8 + __builtin_amdgcn_readfirstlane(wid), cstride = gridDim.x * 8, cn = min((cfirst < NT_W8) ? (NT_W8 - cfirst + cstride - 1) / cstride : 0, TK_TILES);
        qi = __builtin_amdgcn_readfirstlane(qi);
        const int slots = (nj >= 48) ? 3 : (nj >= 24) ? 2 : (nj >= 8) ? 1 : 0;
#define TK_SLOT(more) do { if (cid >= 0) { wt8_store(p, cid, lane, cv); cid = -1; } if ((more) && qi < cn) { cid = cfirst + qi * cstride; ++qi; wt8_load(p, cid, lane, cv); } } while (0)
#else
#define TK_SLOT(more) do { } while (0)
#endif
        if (nj <= 4) { if (lane < nj) word = ~0ull; }
        else {
            float lo = INFINITY, hi = -INFINITY;
#pragma unroll
            for (int i = 0; i < 8; ++i) { lo = fminf(lo, pm[(i * 8 + wid) * 2]); hi = fmaxf(hi, pm[(i * 8 + wid) * 2 + 1]); }
            int need = 256; wsel[lane * 2] = 0u; wsel[lane * 2 + 1] = 0u;
            TK_SLOT(slots >= 1);
            auto level_body = [&](auto first_) -> bool {
                constexpr bool FIRST = decltype(first_)::value;
                if (!(hi > lo)) {
                    for (int jj = 0; jj < nj; ++jj) {
                        const float s = row[jj * 64 + lane]; const unsigned long long em = __ballot(s >= lo && s <= hi);
                        const int ce = __popcll(em); unsigned long long take = em;
                        if (ce > need) { const int rank = __popcll(em & ((1ull << lane) - 1ull)); take = __ballot(((em >> lane) & 1ull) && rank < need); }
                        need -= (ce > need) ? need : ce;
                        if (lane == jj) word |= take;
                    }
                    return true;
                }
                const float scale = 1023.5f / (hi - lo);
#pragma unroll
                for (int i = 0; i < 8; ++i) hist[lane * 8 + i] = 0u;
                asm volatile("s_waitcnt lgkmcnt(0)" ::: "memory");
#pragma unroll 8
                for (int jj = 0; jj < nj; ++jj) {
                    const float s = row[jj * 64 + lane]; const bool part = (s >= lo) && (s <= hi);
                    const unsigned bn = (unsigned)fminf(fmaxf(s - lo, 0.f) * scale, 1023.0f);
                    if (part) lds_add_u32(&hist[bn >> 1], 1u << (16 * (bn & 1u)));
                }
                asm volatile("s_waitcnt lgkmcnt(0)" ::: "memory");
                if constexpr (FIRST) TK_SLOT(slots >= 2);
                unsigned cw[8]; int cl = 0;
#pragma unroll
                for (int i = 0; i < 8; ++i) { cw[i] = hist[lane * 8 + i]; cl += (int)(cw[i] & 0xffffu) + (int)(cw[i] >> 16); }
                int inc = cl;
#pragma unroll
                for (int d = 1; d < 64; d <<= 1) { const int o = __shfl_down(inc, d); if (lane + d < 64) inc += o; }
                const unsigned long long okm = __ballot(inc >= need);
                const int L = 63 - __builtin_clzll(okm);
                int bstar_v = 0, above_v = 0;
                { int run = inc - cl; bool found = false;
#pragma unroll
                  for (int bq = 15; bq >= 0; --bq) { const int cnt = (int)((cw[bq >> 1] >> (16 * (bq & 1))) & 0xffffu); if (!found && run + cnt >= need) { found = true; bstar_v = lane * 16 + bq; above_v = run; } run += cnt; } }
                const unsigned bstar = (unsigned)__shfl(bstar_v, L); const int above = __shfl(above_v, L);
                need -= above;
                int base = 0; float cmn = INFINITY, cmx = -INFINITY;
#pragma unroll 4
                for (int jj = 0; jj < nj; ++jj) {
                    const float s = row[jj * 64 + lane]; const bool part = (s >= lo) && (s <= hi);
                    const unsigned bn = (unsigned)fminf(fmaxf(s - lo, 0.f) * scale, 1023.0f);
                    const bool gt = part && bn > bstar, eq = part && bn == bstar;
                    const unsigned long long gm = __ballot(gt), em = __ballot(eq);
                    if (lane == jj) word |= gm;
                    if (em) {
                        const int pos = base + (int)__builtin_amdgcn_mbcnt_hi((unsigned)(em >> 32), __builtin_amdgcn_mbcnt_lo((unsigned)em, 0u));
                        if (eq) { cmn = fminf(cmn, s); cmx = fmaxf(cmx, s); if (pos < 64) { cval[pos] = s; cidx[pos] = jj * 64 + lane; } }
                        base += __popcll(em);
                    }
                }
                if constexpr (FIRST) TK_SLOT(slots >= 3);
                if (base <= 64) {
                    asm volatile("s_waitcnt lgkmcnt(0)" ::: "memory");
                    if (lane < base) {
                        const float v = cval[lane]; const int id = cidx[lane]; int rank = 0;
                        for (int q = 0; q < base; ++q) { const float ov = cval[q]; rank += (ov > v || (ov == v && q < lane)) ? 1 : 0; }
                        if (rank < need) lds_or_u32(&wsel[(id >> 6) * 2 + ((id >> 5) & 1)], 1u << (id & 31));
                    }
                    asm volatile("s_waitcnt lgkmcnt(0)" ::: "memory");
                    word |= ((unsigned long long)wsel[lane * 2 + 1] << 32) | (unsigned long long)wsel[lane * 2];
                    return true;
                }
#pragma unroll
                for (int o = 32; o > 0; o >>= 1) { cmn = fminf(cmn, __shfl_xor(cmn, o)); cmx = fmaxf(cmx, __shfl_xor(cmx, o)); }
                lo = cmn; hi = cmx; return false;
            };
            if (!level_body(std::integral_constant<bool, true>{})) for (int level = 1; level < 16; ++level) if (level_body(std::integral_constant<bool, false>{})) break;
        }
#if CONV_IN_TOPK && MOE_FP8
        if (!PRE_EARLY && has_next && brep_ == BREP - 1) topk_prefetch(p, jnext, pn, wid, fr, fq);
#endif
        TK_SLOT(false);
        if (lane < nj) p.mask[(size_t)(t0 + wid) * 64 + lane] = word;
#undef TK_SLOT
    }
    __syncthreads();
}

__device__ __forceinline__ void mlstm_scan(const Params& p, int item) {
    const int tid = tid_opaque(), bh = item >> 4, sl = item & 15, idx = sl * 1024 + 2 * tid;
    float C0 = 0.f, C1 = 0.f, m = 0.f, nn = 0.f; const bool don = (sl == 0 && tid < 128);
    const bf16_t* __restrict__ utp = p.ut + (size_t)bh * 64 * 16384 + idx; bf16_t* __restrict__ csp = p.cst + (size_t)bh * 64 * 16384 + idx;
    for (int c0 = 0; c0 < 64; c0 += 16) {
        unsigned uu[16]; float nu[16];
#pragma unroll
        for (int i = 0; i < 16; ++i) { uu[i] = *(const unsigned*)(utp + (size_t)(c0 + i) * 16384); nu[i] = don ? p.nu[(bh * 64 + c0 + i) * 128 + tid] : 0.f; }
#pragma unroll
        for (int i = 0; i < 16; ++i) {
            const int it = bh * 64 + c0 + i; const float bl = p.bl[it], ml = p.mloc[it];
            *(unsigned*)(csp + (size_t)(c0 + i) * 16384) = pk2(C0, C1);
            if (don) { p.ns[it * 128 + tid] = nn; if (tid == 0) p.ms[it] = m; }
            const float mnew = fmaxf(bl + m, ml); const float dec = __expf(bl + m - mnew), su = __expf(ml - mnew);
            C0 = dec * C0 + su * __uint_as_float(uu[i] << 16); C1 = dec * C1 + su * __uint_as_float(uu[i] & 0xffff0000u); nn = dec * nn + su * nu[i]; m = mnew;
        }
    }
}

typedef __bf16 bf16x2_v __attribute__((ext_vector_type(2)));
__device__ __forceinline__ float dot2_ones(unsigned pair, float acc) { return __builtin_amdgcn_fdot2_f32_bf16(__builtin_bit_cast(bf16x2_v, pair), __builtin_bit_cast(bf16x2_v, 0x3f803f80u), acc, false); }
__device__ __forceinline__ void attn_unit(const Params& p, int b, int g, int c, unsigned char* lds, HostQ& wq) {
    const int tid = tid_opaque(), wid = tid >> 6, lane = tid & 63, r32 = lane & 31, hi = lane >> 5;
    const int hq = g * 4 + (wid & 3), tq = (wid >> 2) * 32 + r32, t0 = b * SEQ + c * 64, trow = t0 + tq;
    bf16_t* ktl = (bf16_t*)lds;
    bf16_t* vtl = ktl + 2 * 64 * 72;
    const float C2 = 0.125f * 1.4426950408889634f;
    bf16x8 qf[4];
#pragma unroll
    for (int ds = 0; ds < 4; ++ds) qf[ds] = *(const bf16x8*)(p.proj + (size_t)trow * PP + C_AQ + hq * 64 + ds * 16 + hi * 8);
    f32x16 o0, o1;
#pragma unroll
    for (int r = 0; r < 16; ++r) { o0[r] = 0.f; o1[r] = 0.f; }
    float m_run = -INFINITY, lsum = 0.f;
    const int ntiles = c + 1, srow = tid >> 3, sch = tid & 7;
    const bf16_t* kbase = p.proj + (size_t)(b * SEQ + srow) * PP + C_AK + g * 64 + sch * 8;
    const bf16_t* vbase = p.vt + ((size_t)((b * 2 + g) * 64 + srow)) * SEQ + sch * 8;
    u32x4 kreg = *(const u32x4*)kbase, vreg = *(const u32x4*)vbase;
    *(u32x4*)(ktl + srow * 72 + sch * 8) = kreg; *(u32x4*)(vtl + srow * 72 + sch * 8) = vreg;
    if (ntiles > 1) { kreg = *(const u32x4*)(kbase + (size_t)64 * PP); *(u32x4*)(ktl + 64 * 72 + srow * 72 + sch * 8) = kreg; }
    __syncthreads();
    const unsigned long long* mrow = p.mask + (size_t)trow * 64;
    unsigned long long W0 = mrow[0], W1 = (ntiles > 1) ? mrow[1] : 0ull;
    f32x16 p0, p1;
#pragma unroll
    for (int r = 0; r < 16; ++r) { p0[r] = 0.f; p1[r] = 0.f; }
#pragma unroll
    for (int ds = 0; ds < 4; ++ds) {
        const bf16x8 a0 = *(const bf16x8*)(ktl + r32 * 72 + ds * 16 + hi * 8), a1 = *(const bf16x8*)(ktl + (r32 + 32) * 72 + ds * 16 + hi * 8);
        p0 = mfma32(a0, qf[ds], p0); p1 = mfma32(a1, qf[ds], p1);
    }
    f32x16 q0, q1;
    f32x4 cv[8]; (void)cv;
    auto step = [&](f32x16& p0, f32x16& p1, f32x16& n0, f32x16& n1, const int tile, auto mode_, const int hid) {
        constexpr int MODE = decltype(mode_)::value;
        const int cur = tile & 1;
        if (tile + 2 < ntiles) kreg = *(const u32x4*)(kbase + (size_t)(tile + 2) * 64 * PP);
        if (tile + 1 < ntiles) vreg = *(const u32x4*)(vbase + (tile + 1) * 64);
        const unsigned long long W = W0; W0 = W1; if (tile + 2 < ntiles) W1 = mrow[tile + 2];
        if constexpr (MODE == 1) wh8_load(p, hid, lane, cv);
        const bf16_t* vt = vtl + cur * 64 * 72;
#pragma unroll
        for (int r = 0; r < 16; ++r) { n0[r] = 0.f; n1[r] = 0.f; }
        if (tile + 1 < ntiles) {
            const bf16_t* kt = ktl + (cur ^ 1) * 64 * 72;
#pragma unroll
            for (int ds = 0; ds < 4; ++ds) {
                const bf16x8 a0 = *(const bf16x8*)(kt + r32 * 72 + ds * 16 + hi * 8), a1 = *(const bf16x8*)(kt + (r32 + 32) * 72 + ds * 16 + hi * 8);
                n0 = mfma32(a0, qf[ds], n0); n1 = mfma32(a1, qf[ds], n1);
            }
        }
#ifdef ATT_X1
        { f32x16 z0, z1;
#pragma unroll
          for (int r = 0; r < 16; ++r) { z0[r] = 0.f; z1[r] = 0.f; }
#pragma unroll
          for (int ds = 0; ds < 4; ++ds) { z0 = mfma32(qf[ds], qf[(ds + 1) & 3], z0); z1 = mfma32(qf[(ds + 2) & 3], qf[ds], z1); }
          asm volatile("" :: "v"(z0), "v"(z1)); }
#endif
#ifdef ATT_X2
        { float d0 = p0[0], d1 = p1[0];
#pragma unroll
          for (int r = 0; r < 32; ++r) { asm volatile("v_max_f32_e32 %0, %0, %1" : "+v"(d0) : "v"(p0[r & 15])); asm volatile("v_add_f32_e32 %0, %0, %1" : "+v"(d1) : "v"(p1[r & 15])); }
          asm volatile("" :: "v"(d0), "v"(d1)); }
#endif
        const unsigned wlo = (unsigned)W >> (4 * hi), whi = (unsigned)(W >> 32) >> (4 * hi);
        float mx = -INFINITY;
#pragma unroll
        for (int r = 0; r < 16; ++r) { const int kl = (r & 3) + 8 * (r >> 2);
            const unsigned m0 = (unsigned)__builtin_amdgcn_sbfe((int)wlo, kl, 1), m1 = (unsigned)__builtin_amdgcn_sbfe((int)whi, kl, 1);
            p0[r] = __uint_as_float((m0 & __float_as_uint(p0[r])) | (~m0 & 0xff800000u)); p1[r] = __uint_as_float((m1 & __float_as_uint(p1[r])) | (~m1 & 0xff800000u));
            asm("v_max3_f32 %0, %0, %1, %2" : "+v"(mx) : "v"(p0[r]), "v"(p1[r])); }
        mx = fmaxf(mx, __shfl_xor(mx, 32));
        const float mnew = fmaxf(m_run, mx); const float muse = (mnew == -INFINITY) ? 0.f : mnew;
        const float alpha = __builtin_amdgcn_exp2f((m_run - muse) * C2); m_run = mnew;
        const float ms = muse * C2; float ps = 0.f;
#pragma unroll
        for (int r = 0; r < 16; ++r) { p0[r] = __builtin_amdgcn_exp2f(p0[r] * C2 - ms); p1[r] = __builtin_amdgcn_exp2f(p1[r] * C2 - ms); ps += p0[r] + p1[r]; }
        if (__any(alpha != 1.0f)) {
#pragma unroll
            for (int r = 0; r < 16; ++r) { o0[r] *= alpha; o1[r] *= alpha; }
        }
#pragma unroll
        for (int ks = 0; ks < 4; ++ks) {
            u32x4 bw;
            if (ks == 0) { bw.x = pk2(p0[0], p0[1]); bw.y = pk2(p0[2], p0[3]); bw.z = pk2(p0[4], p0[5]); bw.w = pk2(p0[6], p0[7]); }
            else if (ks == 1) { bw.x = pk2(p0[8], p0[9]); bw.y = pk2(p0[10], p0[11]); bw.z = pk2(p0[12], p0[13]); bw.w = pk2(p0[14], p0[15]); }
            else if (ks == 2) { bw.x = pk2(p1[0], p1[1]); bw.y = pk2(p1[2], p1[3]); bw.z = pk2(p1[4], p1[5]); bw.w = pk2(p1[6], p1[7]); }
            else { bw.x = pk2(p1[8], p1[9]); bw.y = pk2(p1[10], p1[11]); bw.z = pk2(p1[12], p1[13]); bw.w = pk2(p1[14], p1[15]); }
            const bf16x8 bfrag = __builtin_bit_cast(bf16x8, bw);
            const bf16x8 a0 = *(const bf16x8*)(vt + r32 * 72 + ks * 16 + hi * 8), a1 = *(const bf16x8*)(vt + (r32 + 32) * 72 + ks * 16 + hi * 8);
            o0 = mfma32(a0, bfrag, o0); o1 = mfma32(a1, bfrag, o1);
        }
        lsum = lsum * alpha + ps;
        if constexpr (MODE == 2) { if (hid >= 0) wh8_store(p, hid, lane, cv); }
        if (tile + 2 < ntiles) *(u32x4*)(ktl + cur * 64 * 72 + srow * 72 + sch * 8) = kreg;
        if (tile + 1 < ntiles) *(u32x4*)(vtl + (cur ^ 1) * 64 * 72 + srow * 72 + sch * 8) = vreg;
        __syncthreads();
    };
    typedef std::integral_constant<int, 0> M0; typedef std::integral_constant<int, 1> M1; typedef std::integral_constant<int, 2> M2;
    for (int tile = 0; tile < ntiles; tile += 2) {
        if (tile + 1 < ntiles) {
            const bool hv = wq.i < wq.n; const int hid = hostq_id(wq, hv ? wq.i : 0); wq.i += hv ? 1 : 0;
            step(p0, p1, q0, q1, tile, M1{}, hid); step(q0, q1, p0, p1, tile + 1, M2{}, hv ? hid : -1);
        } else step(p0, p1, q0, q1, tile, M0{}, 0);
    }
    lsum += __shfl_xor(lsum, 32);
    const float inv = 1.0f / lsum;
    bf16_t* orow = p.mix + (size_t)trow * 1024 + hq * 64;
#pragma unroll
    for (int r4 = 0; r4 < 4; ++r4) {
        const int d = 8 * r4 + 4 * hi; u32x2 w0, w1;
        w0.x = pk2(o0[4 * r4] * inv, o0[4 * r4 + 1] * inv); w0.y = pk2(o0[4 * r4 + 2] * inv, o0[4 * r4 + 3] * inv);
        w1.x = pk2(o1[4 * r4] * inv, o1[4 * r4 + 1] * inv); w1.y = pk2(o1[4 * r4 + 2] * inv, o1[4 * r4 + 3] * inv);
        *(u32x2*)(orow + d) = w0; *(u32x2*)(orow + 32 + d) = w1;
    }
}


template <bool HOST>
__device__ __forceinline__ void mlstm_out(const Params& p, int item, unsigned char* lds, int wtile) {
    const int tid = tid_opaque(), wid = tid >> 6, lane = tid & 63, fr = lane & 15, fq = lane >> 4;
    const int bh = item >> 6, c = item & 63, b = bh >> 2, h = bh & 3, t0 = b * SEQ + c * 64;
    bf16_t* Ql = (bf16_t*)lds;
    bf16_t* Kl = (bf16_t*)(lds + 17408);
    bf16_t* Vl = (bf16_t*)(lds + 34816);
    bf16_t* CT = (bf16_t*)(lds + 53248);
    float* HB = (float*)(lds + 53248);
    bf16_t* SS = (bf16_t*)(lds + 88064);
    float* bsum = (float*)(lds + 97280); float* aa = bsum + 64; float* mt = aa + 64; float* iwt = mt + 64; float* den = iwt + 64; float* nvec = den + 64;
    {
        const int row = tid >> 3, ch = tid & 7;
#pragma unroll
        for (int i = 0; i < 2; ++i) { const int cch = ch + 8 * i;
            *(u32x4*)(Ql + row * 136 + cch * 8) = *(const u32x4*)(p.cq + (size_t)(t0 + row) * 512 + h * 128 + cch * 8);
            *(u32x4*)(Kl + row * 136 + cch * 8) = *(const u32x4*)(p.ck + (size_t)(t0 + row) * 512 + h * 128 + cch * 8); }
#pragma unroll
        for (int i = 0; i < 4; ++i) { const int q = tid + 512 * i, e = q >> 4, cch = q & 15; *(u32x4*)(CT + e * 136 + cch * 8) = *(const u32x4*)(p.cst + (size_t)item * 16384 + e * 128 + cch * 8); }
#pragma unroll
        for (int i = 0; i < 2; ++i) { const int cch = ch + 8 * i; *(u32x4*)(Vl + row * 136 + cch * 8) = *(const u32x4*)(p.proj + (size_t)(t0 + row) * PP + C_MV + h * 128 + cch * 8); }
        if (wid == 0) {
            const float bs = p.cb[(size_t)(t0 + lane) * 4 + h], ii = p.mi[(size_t)(t0 + lane) * 4 + h]; const float a = ii - bs; float pm = a;
#pragma unroll
            for (int d = 1; d < 64; d <<= 1) { const float o = __shfl_up(pm, d); if (lane >= d) pm = fmaxf(pm, o); }
            const float mprev = p.ms[item]; const float mtv = bs + fmaxf(mprev, pm);
            bsum[lane] = bs; aa[lane] = a; mt[lane] = mtv; iwt[lane] = __expf(bs + mprev - mtv);
        } else if (wid <= 2) { nvec[tid - 64] = p.ns[(size_t)item * 128 + tid - 64]; }
    }
    __syncthreads();
    f32x4 cv[16]; (void)cv;
    if constexpr (HOST) wt8_load(p, wtile, lane, cv);
    const int tb = wid >> 1;
    {
#pragma unroll
        for (int sbi = 0; sbi < 2; ++sbi) {
            const int sb = (wid & 1) * 2 + sbi; f32x4 acc = {0.f, 0.f, 0.f, 0.f};
#pragma unroll
            for (int ks = 0; ks < 4; ++ks) { const bf16x8 a = *(const bf16x8*)(Ql + (16 * tb + fr) * 136 + ks * 32 + fq * 8), bb = *(const bf16x8*)(Kl + (16 * sb + fr) * 136 + ks * 32 + fq * 8); acc = mfma16(a, bb, acc); }
            const int s = 16 * sb + fr; const float as = aa[s];
#pragma unroll
            for (int r = 0; r < 4; ++r) { const int t = 16 * tb + 4 * fq + r; const float v = (s <= t) ? acc[r] * __expf(bsum[t] + as - mt[t]) : 0.f; SS[t * 72 + s] = f2bf(v); }
        }
    }
    __syncthreads();
    if (wid == 0) {
        const int t = lane; float s1 = 0.f, s2 = 0.f;
        for (int s = 0; s < 64; ++s) s1 += bf2f(SS[t * 72 + s]);
        for (int d = 0; d < 128; ++d) s2 += bf2f(Ql[t * 136 + d]) * nvec[d];
        den[t] = s1 + iwt[t] * s2;
    }
    f32x4 num[4];
#pragma unroll
    for (int ebi = 0; ebi < 4; ++ebi) {
        const int eb = (wid & 1) * 4 + ebi; f32x4 a1 = {0.f, 0.f, 0.f, 0.f}, a2 = {0.f, 0.f, 0.f, 0.f};
#pragma unroll
        for (int ks = 0; ks < 2; ++ks) { const bf16x8 a = *(const bf16x8*)(SS + (16 * tb + fr) * 72 + ks * 32 + fq * 8), bb = tr_frag(Vl, 136, 32 * ks, 16 * eb, lane); a1 = mfma16(a, bb, a1); }
#pragma unroll
        for (int ks = 0; ks < 4; ++ks) { const bf16x8 a = *(const bf16x8*)(Ql + (16 * tb + fr) * 136 + ks * 32 + fq * 8), bb = *(const bf16x8*)(CT + (16 * eb + fr) * 136 + ks * 32 + fq * 8); a2 = mfma16(a, bb, a2); }
#pragma unroll
        for (int r = 0; r < 4; ++r) num[ebi][r] = a1[r] + iwt[16 * tb + 4 * fq + r] * a2[r];
    }
    __syncthreads();
#pragma unroll
    for (int ebi = 0; ebi < 4; ++ebi) {
        const int e = 16 * ((wid & 1) * 4 + ebi) + fr;
#pragma unroll
        for (int r = 0; r < 4; ++r) { const int t = 16 * tb + 4 * fq + r; const float dn = fmaxf(fabsf(den[t]), __expf(-mt[t])); HB[t * 132 + e] = num[ebi][r] / dn; }
    }
    __syncthreads();
    if constexpr (HOST) wt8_store(p, wtile, lane, cv);
    {
        const int t = tid >> 3, e16 = (tid & 7) * 16; float hv[16]; float ss = 0.f;
#pragma unroll
        for (int i = 0; i < 16; ++i) { hv[i] = HB[t * 132 + e16 + i]; ss += hv[i] * hv[i]; }
        ss += __shfl_xor(ss, 1); ss += __shfl_xor(ss, 2); ss += __shfl_xor(ss, 4);
        const float rs = 1.0f / sqrtf(ss * (1.0f / 128.0f) + NORM_EPS);
        float mo[16]; const bf16_t* rm = p.proj + (size_t)(t0 + t) * PP + C_MO + h * 128 + e16; unpack8(*(const u32x4*)rm, mo); unpack8(*(const u32x4*)(rm + 8), mo + 8);
        const float* nw = p.mlstm_norm_w + h * 128 + e16; float o[16];
#pragma unroll
        for (int i = 0; i < 16; ++i) o[i] = hv[i] * rs * nw[i] * sigmoidf_(mo[i]);
        { const size_t ob = ((size_t)(t0 + t) * 1024 + 512 + h * 128 + e16) * 2; store16_wt(p.mix, ob, pack8(o)); store16_wt(p.mix, ob + 16, pack8(o + 8)); }
    }
    __syncthreads();
}

__device__ __forceinline__ void compute_tstart(const Params& p, int* ts) {
    if (threadIdx.x == 0) { int a = 0; for (int e = 0; e < NEXP; ++e) { ts[e] = a; a += (p.cnt[e] + 255) >> 8; } ts[NEXP] = a; }
    __syncthreads();
}

__device__ __forceinline__ void scatter_tokens(const Params& p, const int* ts, int t_begin, int t_end, int wid, int lane) {
    constexpr int NTK = 4;
    float4 nw[4];
#pragma unroll
    for (int i = 0; i < 4; ++i) nw[i] = *(const float4*)(p.ffn_norm_w + i * 256 + lane * 4);
    for (int t0 = t_begin + wid; t0 < t_end; t0 += 8 * NTK) {
        int tt[NTK]; float rs[NTK]; u32x2 xa[NTK][4]; size_t dst[NTK][4];
#pragma unroll
        for (int j = 0; j < NTK; ++j) { tt[j] = min(t0 + 8 * j, t_end - 1); rs[j] = p.rsv[tt[j]];
#pragma unroll
            for (int i = 0; i < 4; ++i) xa[j][i] = *(const u32x2*)(p.x1 + (size_t)tt[j] * DM + i * 256 + lane * 4);
#pragma unroll
            for (int k = 0; k < 4; ++k) { const int e = p.tope[tt[j] * 4 + k]; dst[j][k] = (size_t)ts[e] * 256 + p.topp[tt[j] * 4 + k]; } }
#pragma unroll
        for (int j = 0; j < NTK; ++j) {
            if (t0 + 8 * j >= t_end) break;
            u32x2 h[4]; unsigned h8[4];
#pragma unroll
            for (int i = 0; i < 4; ++i) { const float4 w = nw[i];
                const float4 a = make_float4(__uint_as_float(xa[j][i].x << 16), __uint_as_float(xa[j][i].x & 0xffff0000u), __uint_as_float(xa[j][i].y << 16), __uint_as_float(xa[j][i].y & 0xffff0000u));
                h[i].x = pk2(a.x * rs[j] * w.x, a.y * rs[j] * w.y); h[i].y = pk2(a.z * rs[j] * w.z, a.w * rs[j] * w.w);
                h8[i] = pk4_fp8(a.x * rs[j] * w.x * FP8_XS, a.y * rs[j] * w.y * FP8_XS, a.z * rs[j] * w.z * FP8_XS, a.w * rs[j] * w.w * FP8_XS); }
#pragma unroll
            for (int k = 0; k < 4; ++k) {
#if MOE_FP8
#pragma unroll
                for (int i = 0; i < 4; ++i) *(unsigned*)((unsigned char*)p.xbuf + dst[j][k] * DM + i * 256 + lane * 4) = h8[i];
#else
#pragma unroll
                for (int i = 0; i < 4; ++i) *(u32x2*)(p.xbuf + dst[j][k] * DM + i * 256 + lane * 4) = h[i];
#endif
            }
        }
    }
}

__device__ __forceinline__ void router_phase(const Params& p, unsigned char* lds) {
    const int tid = tid_opaque(), wid = tid >> 6, lane = tid & 63, fr = lane & 15, fq = lane >> 4;
    constexpr int RWS = 36;
    float* rw = (float*)lds;
    unsigned char* ex = lds + 1024 * RWS * 4;
    float* lg = (float*)ex;
    float* rsq = lg + 64 * 33;
    int* lcnt = (int*)(rsq + 64); int* lbase = lcnt + 32;
    float* selv = (float*)(lbase + 32);
    int* sele = (int*)(selv + 256);
    int* info = sele + 256;
    float* ginfo = (float*)(info + 512);
    for (int i = tid; i < 32768; i += NTHREADS) { const int d = i >> 5, e = i & 31; rw[d * RWS + e] = p.router_w[i] * p.ffn_norm_w[d]; }
    __syncthreads();
    for (int grp = blockIdx.x; grp < T_TOK / 64; grp += gridDim.x) {
        if (tid < 32) lcnt[tid] = 0;
        {
            const int tb = (wid & 3) * 16, half = wid >> 2;
            const bf16_t* xr = p.x1 + ((size_t)grp * 64 + tb + fr) * DM + fq * 8; const float* rwp = rw + (fq * 8) * RWS + half * 16 + fr;
            f32x4 acc = {0.f, 0.f, 0.f, 0.f}; float ssq = 0.f;
#pragma unroll 4
            for (int kk = 0; kk < 32; ++kk) {
                const u32x4 xa = *(const u32x4*)(xr + kk * 32); float a[8]; unpack8(xa, a);
                const float* rr = rwp + kk * 32 * RWS;
#pragma unroll
                for (int j = 0; j < 8; ++j) { ssq += a[j] * a[j]; acc = __builtin_amdgcn_mfma_f32_16x16x4f32(a[j], rr[j * RWS], acc, 0, 0, 0); }
            }
            ssq += __shfl_xor(ssq, 16); ssq += __shfl_xor(ssq, 32);
            if (half == 0 && fq == 0) { const float rs = 1.0f / sqrtf(ssq * (1.0f / DM) + NORM_EPS); rsq[tb + fr] = rs; p.rsv[(size_t)grp * 64 + tb + fr] = rs; }
#pragma unroll
            for (int r = 0; r < 4; ++r) lg[(tb + 4 * fq + r) * 33 + half * 16 + fr] = acc[r];
        }
        __syncthreads();
        for (int rd = 0; rd < 4; ++rd) {
            const int tl = wid * 8 + rd * 2 + (lane >> 5), e = lane & 31; float* l = lg + tl * 33;
            const float v = l[e] * rsq[tl] + p.router_b[e];
            l[e] = v;
            int rank = 0;
#pragma unroll
            for (int o = 0; o < 32; ++o) { const float ov = l[o]; rank += (ov > v || (ov == v && o < e)) ? 1 : 0; }
            if (rank < 4) { selv[tl * 4 + rank] = v; sele[tl * 4 + rank] = e; }
            if (e < 4) {
                const float* sv = selv + tl * 4; const float v0 = sv[0]; const float e1 = __expf(sv[1] - v0), e2 = __expf(sv[2] - v0), e3 = __expf(sv[3] - v0); const float sum = 1.0f + e1 + e2 + e3;
                const float mine = (e == 0 ? 1.0f : e == 1 ? e1 : e == 2 ? e2 : e3) / sum; const int ex_ = sele[tl * 4 + e];
                const int lp = atomicAdd(&lcnt[ex_], 1);
                info[(tl * 4 + e) * 2] = ex_; info[(tl * 4 + e) * 2 + 1] = lp; ginfo[tl * 4 + e] = mine;
            }
        }
        __syncthreads();
        if (tid < 32) lbase[tid] = atomicAdd(&p.cnt[tid], lcnt[tid]);
        __syncthreads();
        if (tid < 256) { const int e = info[tid * 2], lp = info[tid * 2 + 1]; const size_t o = (size_t)grp * 256 + tid; p.tope[o] = e; p.topp[o] = lbase[e] + lp; p.topg[o] = ginfo[tid]; }
        __syncthreads();
    }
    asm volatile("s_waitcnt vmcnt(0)" ::: "memory");
    __syncthreads();
    if (tid == 0) {
        const int mine = (T_TOK / 64 - (int)blockIdx.x + (int)gridDim.x - 1) / (int)gridDim.x;
        __builtin_amdgcn_fence(__ATOMIC_RELEASE, "agent"); asm volatile("s_waitcnt vmcnt(0)" ::: "memory");
        __hip_atomic_fetch_add((unsigned*)&p.cnt[32], (unsigned)mine, __ATOMIC_RELAXED, __HIP_MEMORY_SCOPE_AGENT);
        unsigned sp = 0;
        while (__hip_atomic_load((unsigned*)&p.cnt[32], __ATOMIC_RELAXED, __HIP_MEMORY_SCOPE_AGENT) < (unsigned)(T_TOK / 64)) { __builtin_amdgcn_s_sleep(2); if (++sp > (1u << 22)) break; }
        __builtin_amdgcn_fence(__ATOMIC_ACQUIRE, "agent"); asm volatile("s_waitcnt vmcnt(0)" ::: "memory");
    }
    __syncthreads();
    int* ts = (int*)lds;
    compute_tstart(p, ts);
    for (int grp = blockIdx.x; grp < T_TOK / 64; grp += gridDim.x) scatter_tokens(p, ts, grp * 64, grp * 64 + 64, wid, lane);
}

__device__ __forceinline__ void combine_phase(const Params& p, unsigned char* lds) {
    const int tid = tid_opaque(), wid = tid >> 6, lane = tid & 63; int* ts = (int*)lds;
    compute_tstart(p, ts);
    const unsigned char* Y = (const unsigned char*)p.ybuf;
    constexpr int NTK = 4;
    const int tstride = gridDim.x * 8;
    for (int t0 = blockIdx.x * 8 + wid; t0 < T_TOK; t0 += tstride * NTK) {
        int tt[NTK]; size_t src[NTK][4]; float gs[NTK][4];
#pragma unroll
        for (int j = 0; j < NTK; ++j) { tt[j] = min(t0 + j * tstride, T_TOK - 1);
#pragma unroll
            for (int k = 0; k < 4; ++k) { const int e = p.tope[tt[j] * 4 + k]; src[j][k] = (size_t)ts[e] * 256 + p.topp[tt[j] * 4 + k]; gs[j][k] = p.topg[tt[j] * 4 + k] * (Y_FP8 ? 1.0f / FP8_YS : 1.0f); } }
        u32x2 xa[NTK][4];
#if Y_FP8
        unsigned yw[NTK][4][4];
#else
        u32x2 yw[NTK][4][4];
#endif
#pragma unroll
        for (int j = 0; j < NTK; ++j) {
#pragma unroll
            for (int i = 0; i < 4; ++i) xa[j][i] = *(const u32x2*)(p.x1 + (size_t)tt[j] * DM + i * 256 + lane * 4);
#pragma unroll
            for (int k = 0; k < 4; ++k)
#pragma unroll
                for (int i = 0; i < 4; ++i) {
#if Y_FP8
                    yw[j][k][i] = __builtin_nontemporal_load((const unsigned*)(Y + src[j][k] * DM + i * 256 + lane * 4));
#else
                    yw[j][k][i] = __builtin_nontemporal_load((const u32x2*)(Y + (src[j][k] * DM + i * 256 + lane * 4) * 2));
#endif
                }
        }
#pragma unroll
        for (int j = 0; j < NTK; ++j) {
            float v[16];
#pragma unroll
            for (int i = 0; i < 4; ++i) { v[4 * i] = __uint_as_float(xa[j][i].x << 16); v[4 * i + 1] = __uint_as_float(xa[j][i].x & 0xffff0000u); v[4 * i + 2] = __uint_as_float(xa[j][i].y << 16); v[4 * i + 3] = __uint_as_float(xa[j][i].y & 0xffff0000u); }
#pragma unroll
            for (int k = 0; k < 4; ++k)
#pragma unroll
                for (int i = 0; i < 4; ++i) {
#if Y_FP8
                    const int w = (int)yw[j][k][i];
                    v[4 * i] += gs[j][k] * __builtin_amdgcn_cvt_f32_fp8(w, 0); v[4 * i + 1] += gs[j][k] * __builtin_amdgcn_cvt_f32_fp8(w, 1); v[4 * i + 2] += gs[j][k] * __builtin_amdgcn_cvt_f32_fp8(w, 2); v[4 * i + 3] += gs[j][k] * __builtin_amdgcn_cvt_f32_fp8(w, 3);
#else
                    const u32x2 w = yw[j][k][i];
                    v[4 * i] += gs[j][k] * __uint_as_float(w.x << 16); v[4 * i + 1] += gs[j][k] * __uint_as_float(w.x & 0xffff0000u); v[4 * i + 2] += gs[j][k] * __uint_as_float(w.y << 16); v[4 * i + 3] += gs[j][k] * __uint_as_float(w.y & 0xffff0000u);
#endif
                }
            float ss = 0.f;
#pragma unroll
            for (int i = 0; i < 16; ++i) ss += v[i] * v[i];
            ss = wave_sum(ss); const float rs = 1.0f / sqrtf(ss * (1.0f / DM) + NORM_EPS);
            if (t0 + j * tstride < T_TOK) {
#pragma unroll
                for (int i = 0; i < 4; ++i) { const float4 w = *(const float4*)(p.final_norm_w + i * 256 + lane * 4);
                    __builtin_nontemporal_store((f32x4){v[4 * i] * rs * w.x, v[4 * i + 1] * rs * w.y, v[4 * i + 2] * rs * w.z, v[4 * i + 3] * rs * w.w}, (f32x4*)(p.out + (size_t)tt[j] * DM + i * 256 + lane * 4)); }
            }
        }
    }
}

#ifndef MK_SPLIT
#define MK_SPLIT 0
#endif
constexpr int N_PHASES = 11;

__device__ __forceinline__ void run_phase(const Params& p, int ph, unsigned char* lds) {
    typedef __attribute__((address_space(3))) unsigned char* las_ptr;
    const int G = gridDim.x, c = blockIdx.x;
    switch (ph) {
    case 0: phase_prologue(p, lds); break;
    case 1: {
        Gemm g{PROJ_FP8 ? (const bf16_t*)p.xn8 : p.xn, PROJ_FP8 ? (const bf16_t*)p.wt_in8 : p.wt_in, T_TOK, PP, 1024}; pg8::StaticOrder S; S.init(T_TOK, PP, G, c);
        EpiProjT<PROJ_FP8 != 0> E{p.proj, p.ikb, p.iw, p.mi, p.mf, p.ropea, p.ropei, p.igate_b, p.fgate_b};
        const bool conv_first = ((c >> 3) & 1) != 0;
#ifdef PROBE_LOADONLY
        if (conv_first) convert_fp8_loadonly(p);
#endif
        if (conv_first) { if (CONV_WAVES && MOE_FP8 && !CONV_IN_TOPK) convert_fp8_waves(p, 0); convert_streamed(p, lds, 0, streamed_tiles_of_wg()); __syncthreads(); }
        pg8::gemm_phase<EpiProjT<PROJ_FP8 != 0>, pg8::StaticOrder, true, true, PROJ_FP8 != 0>((las_ptr)lds, g, S, E);
        for (int blk = c; blk < T_TOK / 64; blk += G) proj_small(p, blk, lds);
        if (!conv_first) { __syncthreads(); convert_streamed(p, lds, 0, streamed_tiles_of_wg()); if (CONV_WAVES && MOE_FP8 && !CONV_IN_TOPK) convert_fp8_waves(p, 0); }
#ifdef PROBE_LOADONLY
        if (!conv_first) convert_fp8_loadonly(p);
#endif
    } break;
    case 2: {
#ifndef P2A_REP
#define P2A_REP 1
#endif
#ifndef P2C_REP
#define P2C_REP 1
#endif
        for (int r_ = 0; r_ < P2A_REP; ++r_) for (int it = c; it < 1024 + 512; it += G) { if (it < 1024) mlstm_local(p, it, lds); else vtrans(p, it - 1024, lds); }
        for (int r_ = 0; r_ < P2C_REP; ++r_) {
            TopkPre tkc, tkn; const int tid_ = tid_opaque();
            if (c < 2048) topk_prefetch(p, c, tkc, tid_ >> 6, tid_ & 15, (tid_ & 63) >> 4);
            int qi = 0;
            for (int it = c; it < 2048; it += G) { idx_topk(p, it, lds, tkc, tkn, it + G, it + G < 2048, r_ == 0, qi); tkc = tkn; }
#if CONV_IN_TOPK && MOE_FP8
            if (r_ == 0) convert_fp8_rest(p, qi, TK_TILES);
#endif
        }
    } break;
    case 3: {
#ifndef ATTN_UNIT
#define ATTN_UNIT attn_unit
#endif
#ifndef P3A_REP
#define P3A_REP 1
#endif
#ifndef P3B_REP
#define P3B_REP 1
#endif
        for (int r_ = 0; r_ < P3A_REP; ++r_) for (int it = c; it < 256; it += G) mlstm_scan(p, it);
        for (int r_ = 0; r_ < P3B_REP; ++r_) {
            HostQ hq; hq.stride = G * 8; hq.first = c * 8 + __builtin_amdgcn_readfirstlane(tid_opaque() >> 6) + TK_TILES * hq.stride; hq.i = 0;
            hq.n = (CONV_IN_TOPK && MOE_FP8 && hq.first < NT_W8) ? 2 * ((NT_W8 - hq.first + hq.stride - 1) / hq.stride) : 0;
            for (int pi = c; pi < 256; pi += G) { const int b = pi >> 6, g = (pi >> 5) & 1, cp = pi & 31; for (int uu = 0; uu < 2; ++uu) ATTN_UNIT(p, b, g, uu ? cp : 63 - cp, lds, hq); }
            for (; hq.i < hq.n; ++hq.i) { f32x4 v[8]; const int lane_ = tid_opaque() & 63; wh8_load(p, hostq_id(hq, hq.i), lane_, v); wh8_store(p, hostq_id(hq, hq.i), lane_, v); }
        }
    } break;
    case 4: for (int it = c; it < 1024; it += G) mlstm_out<false>(p, it, lds, 0); break;
    case 5: {
        Gemm g{p.mix, p.wt_out, T_TOK, 1024, 1024}; pg8::StaticOrder S; S.init(T_TOK, 1024, G, c);
        EpiResid E{p.x, p.x1};
        pg8::gemm_phase<EpiResid, pg8::StaticOrder, true, true>((las_ptr)lds, g, S, E);
    } break;
    case 6: router_phase(p, lds); break;
    case 7: break;
    case 8: {
        int* ts = (int*)(lds + 131072); compute_tstart(p, ts);
        const int upr = (G == 256) ? 32 : 1, nfull = (G == 256) ? ts[NEXP] / upr : 1 << 20;
        Gemm g{p.xbuf, p.wt_gu, XROWS, 2048, 1024}; GroupOrderT<0> S{ts, 8, G, c, 0, nfull, p.rdy, 0}; EpiSwigluT<false> E{p.b_gu, p.act};
        pg8::gemm_phase<EpiSwigluT<false>, GroupOrderT<0>, true, true, MOE_FP8 != 0>((las_ptr)lds, g, S, E);
    } break;
    case 9: {
        int* ts = (int*)(lds + 131072); compute_tstart(p, ts);
        const int nfull = (G == 256) ? ts[NEXP] / 32 : 1 << 20, lim = (G == 256) ? nfull * 32 : 1 << 30;
        if (G == 256) {
            Gemm g{p.xbuf, p.wt_gu, XROWS, 2048, 1024}; GroupOrderT<1> S{ts, 8, G, c, nfull, 1 << 20, p.rdy, 0}; EpiSwigluT<true> E{p.b_gu, p.act};
            pg8::gemm_phase<EpiSwigluT<true>, GroupOrderT<1>, true, true, MOE_FP8 != 0>((las_ptr)lds, g, S, E);
        }
        Gemm g{p.act, p.wt_dn, XROWS, 1024, 1024}; GroupOrderT<2> S{ts, 4, G, c, 0, 1 << 20, p.rdy, lim}; EpiBiasBf16 E{p.b_dn, p.ybuf};
        pg8::gemm_phase<EpiBiasBf16, GroupOrderT<2>, true, true, MOE_FP8 != 0>((las_ptr)lds, g, S, E);
    } break;
    case 10: combine_phase(p, lds); break;
    }
}

#if MK_SPLIT
template <int PH> __global__ void __launch_bounds__(NTHREADS) fwd_phase_kernel(Params p) {
    extern __shared__ __attribute__((aligned(16))) unsigned char lds[];
    run_phase(p, PH, lds);
}
template <int PH> static void launch_phase(const Params& p, hipStream_t stream) {
    (void)hipFuncSetAttribute((const void*)fwd_phase_kernel<PH>, hipFuncAttributeMaxDynamicSharedMemorySize, LDS_BYTES);
    hipLaunchKernelGGL(fwd_phase_kernel<PH>, dim3(256), dim3(NTHREADS), LDS_BYTES, stream, p);
}
#else
#ifndef REP0
#define REP0 1
#endif
#ifndef REP1
#define REP1 1
#endif
#ifndef REP2
#define REP2 1
#endif
#ifndef REP3
#define REP3 1
#endif
#ifndef REP4
#define REP4 1
#endif
#ifndef REP5
#define REP5 1
#endif
#ifndef REP7
#define REP7 1
#endif
#ifndef REP8
#define REP8 1
#endif
#ifndef REP9
#define REP9 1
#endif
#ifndef REP10
#define REP10 1
#endif
__global__ void __launch_bounds__(NTHREADS) fwd_megakernel(Params p) {
    extern __shared__ __attribute__((aligned(16))) unsigned char lds[];
    cg::grid_group grid = cg::this_grid();
    volatile LAS unsigned* xbst = (volatile LAS unsigned*)(lds + LDS_BYTES - 16);
    if (tid_opaque() == 0) { xbst[0] = 0u; xbst[1] = 0u; }
    if (blockIdx.x == 0) for (int i = tid_opaque(); i < XCD_BAR_WORDS; i += NTHREADS) p.bar[i] = 0u;
    __syncthreads();
#ifdef DBG_PH
#define STAMP(k) do { if (blockIdx.x == 0 && tid_opaque() == 0) ((unsigned long long*)(p.cnt + 64))[k] = __builtin_amdgcn_s_memrealtime(); } while (0)
#else
#define STAMP(k) do { } while (0)
#endif
    STAMP(0); run_phase(p, 0, lds); __syncthreads(); grid.sync(); STAMP(1);
    const XcdBarrier xb = xcd_barrier_post(p.bar, xbst);
#define XSYNC() xcd_barrier(xb)
#define RUN(ph, rep) do { for (int r_ = 0; r_ < (rep); ++r_) { run_phase(p, ph, lds); if (r_ + 1 < (rep)) XSYNC(); } } while (0)
    RUN(1, REP1); XSYNC(); STAMP(2); RUN(2, REP2); XSYNC(); STAMP(3); RUN(3, REP3); XSYNC(); STAMP(4); RUN(4, REP4); XSYNC(); STAMP(5); RUN(5, REP5); XSYNC(); STAMP(6);
    run_phase(p, 6, lds); XSYNC(); STAMP(7); STAMP(8); RUN(8, REP8); XSYNC(); STAMP(9); RUN(9, REP9); XSYNC(); STAMP(10); RUN(10, REP10);
#undef RUN
#undef XSYNC
}
#endif

extern "C" void kernel_launch(void* const* d_in, const int* in_sizes, int n_in, void* d_out, int out_size, void* d_ws, size_t ws_size, hipStream_t stream) {
    (void)in_sizes; (void)n_in; (void)out_size;
    Params p{};
    p.x = (const float*)d_in[0]; p.mix_norm_w = (const float*)d_in[1]; p.w_in = (const float*)d_in[2]; p.conv_w = (const float*)d_in[3]; p.conv_b = (const float*)d_in[4];
    p.igate_b = (const float*)d_in[5]; p.fgate_b = (const float*)d_in[6]; p.mlstm_norm_w = (const float*)d_in[7]; p.w_out = (const float*)d_in[8]; p.ffn_norm_w = (const float*)d_in[9];
    p.router_w = (const float*)d_in[10]; p.router_b = (const float*)d_in[11]; p.w_gu = (const float*)d_in[12]; p.b_gu = (const float*)d_in[13]; p.w_dn = (const float*)d_in[14];
    p.b_dn = (const float*)d_in[15]; p.final_norm_w = (const float*)d_in[16];
    p.out = (float*)d_out;
    size_t off = 0; unsigned char* base = (unsigned char*)d_ws;
    auto take = [&](size_t bytes) { unsigned char* r = base + off; off += (bytes + 255) & ~(size_t)255; return r; };
    p.bar = (unsigned*)take(XCD_BAR_WORDS * 4); p.cnt = (int*)take(1024); p.rdy = (unsigned*)take(RDY_WORDS * 4);
    p.wt_in = (bf16_t*)take((size_t)NPW * 1024 * 2); p.wt_out = (bf16_t*)take((size_t)1024 * 1024 * 2);
    p.wt_gu = (bf16_t*)take((size_t)32 * 2048 * 1024 * (MOE_FP8 ? 1 : 2)); p.wt_dn = (bf16_t*)take((size_t)32 * 1024 * 1024 * (MOE_FP8 ? 1 : 2));
    p.xn = (bf16_t*)take((size_t)T_TOK * 1024 * 2); p.proj = (bf16_t*)take((size_t)T_TOK * PP * 2); p.ikb = (bf16_t*)take((size_t)T_TOK * 32 * 2);
    p.vt = (bf16_t*)take((size_t)4 * 2 * 64 * SEQ * 2); p.cq = (bf16_t*)take((size_t)T_TOK * 512 * 2); p.ck = (bf16_t*)take((size_t)T_TOK * 512 * 2);
    p.cst = (bf16_t*)take((size_t)1024 * 16384 * 2); p.mix = (bf16_t*)take((size_t)T_TOK * 1024 * 2);
    p.xbuf = (bf16_t*)take((size_t)XROWS * 1024 * (MOE_FP8 ? 1 : 2)); p.act = (bf16_t*)take((size_t)XROWS * 1024 * (MOE_FP8 ? 1 : 2));
    p.ybuf = (MOE_FP8 ? (bf16_t*)take((size_t)XROWS * 1024 * 2) : p.xbuf);
    p.xn8 = take((size_t)T_TOK * 1024); p.wt_in8 = take((size_t)PP * 1024);
    p.iw = (float*)take((size_t)T_TOK * 8 * 4); p.mi = (float*)take((size_t)T_TOK * 4 * 4); p.mf = (float*)take((size_t)T_TOK * 4 * 4); p.cb = (float*)take((size_t)T_TOK * 4 * 4);
    p.ropea = (float*)take((size_t)SEQ * 16 * 4); p.ropei = (float*)take((size_t)SEQ * 8 * 4);
    p.ut = (bf16_t*)take((size_t)1024 * 16384 * 2); p.nu = (float*)take((size_t)1024 * 128 * 4); p.bl = (float*)take(1024 * 4); p.mloc = (float*)take(1024 * 4);
    p.ns = (float*)take((size_t)1024 * 128 * 4); p.ms = (float*)take(1024 * 4); p.x1 = (bf16_t*)take((size_t)T_TOK * 1024 * 2); p.topg = (float*)take((size_t)T_TOK * 4 * 4); p.rsv = (float*)take((size_t)T_TOK * 4);
    p.mask = (unsigned long long*)take((size_t)T_TOK * 64 * 8); p.tope = (int*)take((size_t)T_TOK * 4 * 4); p.topp = (int*)take((size_t)T_TOK * 4 * 4);
    if (off > ws_size) { fprintf(stderr, "workspace too small: need %zu have %zu\n", off, ws_size); return; }
#if MK_SPLIT
    launch_phase<0>(p, stream); launch_phase<1>(p, stream); launch_phase<2>(p, stream); launch_phase<3>(p, stream); launch_phase<4>(p, stream); launch_phase<5>(p, stream);
    launch_phase<6>(p, stream); launch_phase<7>(p, stream); launch_phase<8>(p, stream); launch_phase<9>(p, stream); launch_phase<10>(p, stream);
#else
    static int grid_blocks = 0;
    if (!grid_blocks) {
        int dev = 0, cus = 0, per_cu = 0;
        (void)hipGetDevice(&dev); (void)hipDeviceGetAttribute(&cus, hipDeviceAttributeMultiprocessorCount, dev);
        (void)hipFuncSetAttribute((const void*)fwd_megakernel, hipFuncAttributeMaxDynamicSharedMemorySize, LDS_BYTES);
        (void)hipOccupancyMaxActiveBlocksPerMultiprocessor(&per_cu, fwd_megakernel, NTHREADS, LDS_BYTES);
        if (per_cu < 1) fprintf(stderr, "occupancy query returned %d blocks per CU\n", per_cu);
        grid_blocks = cus;
    }
    void* args[] = {&p};
    hipError_t e = hipLaunchCooperativeKernel((void*)fwd_megakernel, dim3(grid_blocks), dim3(NTHREADS), args, LDS_BYTES, stream);
    if (e != hipSuccess) fprintf(stderr, "cooperative launch failed: %s (grid %d)\n", hipGetErrorString(e), grid_blocks);
#endif
}
```

```cpp
#include <hip/hip_runtime.h>
#include <hip/hip_cooperative_groups.h>
#include <cstdio>
#include <cstdint>
namespace cg = cooperative_groups;

__device__ __forceinline__ int tid_opaque() { int t = threadIdx.x; asm volatile("" : "+v"(t)); return t; }
namespace pg8 {
#define PG8_LAS __attribute__((address_space(3)))
typedef unsigned short bf16_t;
typedef short bf16x8 __attribute__((ext_vector_type(8)));
typedef float f32x4 __attribute__((ext_vector_type(4)));
typedef unsigned u32x4 __attribute__((ext_vector_type(4)));
constexpr int BM = 256, BK = 64, HALF = 128, HTB = HALF * BK * 2  , STAGE_BYTES = 8 * HTB, NXCD = 8, WGM = 8;

__host__ __device__ __forceinline__ int lds_byte(int r, int c) { const int st = (r >> 4) * 2 + (c >> 5), rr = r & 15, cc = c & 31, ob = rr * 64 + cc * 2; return st * 1024 + (ob ^ (((ob >> 9) & 1) << 5)); }
__host__ __device__ __forceinline__ void stage_rc(int b, int& R, int& C) { const int st = b / 1024, sb = b % 1024, swz = sb ^ (((sb >> 9) & 1) << 5); R = (st >> 1) * 16 + swz / 64; C = (st & 1) * 32 + (swz % 64) / 2; }
__host__ __device__ __forceinline__ int perm32(int rho) { const int n = rho >> 4, i = rho & 15; return 8 * (i >> 2) + 4 * n + (i & 3); }

struct Unit { int pm, pn, pb, ex; };
struct Gemm { const bf16_t* A; const bf16_t* Bt; int M, N, K; };

struct StaticOrder {
    int nM, nN, nwg, G, c;
    __host__ __device__ void init(int M, int N, int G_, int c_) { nM = M / BM; nN = N / BM; nwg = nM * nN; G = G_; c = c_; }
    __host__ __device__ bool next(int i, Unit& u) const {
        const long L = (long)i * G + c; if (L >= nwg) return false;
        int wgid = (int)L; { const int q = nwg / NXCD, r = nwg % NXCD, xcd = wgid % NXCD, off = wgid / NXCD; wgid = (xcd < r ? xcd * (q + 1) : r * (q + 1) + (xcd - r) * q) + off; }
        const int nig = WGM * nN, gid = wgid / nig, fm = gid * WGM, gsz = (nM - fm) < WGM ? (nM - fm) : WGM;
        u.pm = fm + ((wgid % nig) % gsz); u.pn = (wgid % nig) / gsz; u.pb = u.pn; u.ex = 0; return true;
    }
    __device__ __forceinline__ void a_ready(const Unit&) const {}
    __device__ __forceinline__ void done(const Unit&) const {}
};

__device__ __forceinline__ unsigned cvt_pk_bf16(float lo, float hi) { unsigned r; asm volatile("v_cvt_pk_bf16_f32 %0, %1, %2" : "=v"(r) : "v"(lo), "v"(hi)); return r; }
typedef int i32x8 __attribute__((ext_vector_type(8)));
typedef int i32x4v __attribute__((ext_vector_type(4)));
__device__ __forceinline__ f32x4 mfma_fp8_128(bf16x8 a0, bf16x8 a1, bf16x8 b0, bf16x8 b1, f32x4 c) {
    const i32x4v x0 = __builtin_bit_cast(i32x4v, a0), x1 = __builtin_bit_cast(i32x4v, a1), y0 = __builtin_bit_cast(i32x4v, b0), y1 = __builtin_bit_cast(i32x4v, b1);
    const i32x8 a = {x0[0], x0[1], x0[2], x0[3], x1[0], x1[1], x1[2], x1[3]}, b = {y0[0], y0[1], y0[2], y0[3], y1[0], y1[1], y1[2], y1[3]};
    return __builtin_amdgcn_mfma_scale_f32_16x16x128_f8f6f4(a, b, c, 0, 0, 0, 0x7f7f7f7f, 0, 0x7f7f7f7f);
}
template <class Epi, class Sched, bool ALIGN_EPI = false, bool SP2 = false, bool FP8 = false>
__device__ __forceinline__ void gemm_phase(PG8_LAS unsigned char* lds, const Gemm g, const Sched& S, const Epi& E) {
    const int tid = tid_opaque(), wid = __builtin_amdgcn_readfirstlane(tid >> 6), lane = tid & 63, wr = wid >> 2, wc = wid & 3, fr = lane & 15, fq = lane >> 4;
    const int K = FP8 ? g.K / 2 : g.K, nt = K / BK;
    unsigned voffA[2], voffB[2];
#pragma unroll
    for (int i = 0; i < 2; ++i) { int R, C; stage_rc(tid * 16 + i * 8192, R, C); const int Rb = Epi::PERM ? ((R & ~31) + perm32(R & 31)) : R;
        voffA[i] = (unsigned)(R * K + C) * 2u; voffB[i] = (unsigned)(Rb * K + C) * 2u; }
    const size_t kstep = (size_t)(BK * 2);
    const size_t hstep = (size_t)HALF * K * 2;
    const size_t tstep = 2 * hstep;
    const unsigned pfoff = (unsigned)(tid & 255) * (unsigned)K * 2u;
    const unsigned ldsw = (unsigned)wid * 1024u;
    const int aoff = lds_byte(wr * 64 + fr, fq * 8), boff = lds_byte(wc * 32 + fr, fq * 8);
#define PG8_SA(b, h) (((b) * 2 + (h)) * HTB)
#define PG8_SB(b, h) ((4 + (b) * 2 + (h)) * HTB)
#define PG8_STAGE(bufoff, gbase, voff) do { _Pragma("unroll") for (int _i = 0; _i < 2; ++_i) \
        __builtin_amdgcn_global_load_lds((const unsigned*)((const char*)(gbase) + (voff)[_i]), (PG8_LAS unsigned*)(lds + (bufoff) + ldsw + _i * 8192), 16, 0, 0); } while (0)
#define PG8_LDA(dst, b, h) do { _Pragma("unroll") for (int m = 0; m < 4; ++m) { if constexpr (FP8) { dst##8[m].lo = *(const PG8_LAS i32x4v*)(lds + PG8_SA(b, h) + aoff + m * 2048); dst##8[m].hi = *(const PG8_LAS i32x4v*)(lds + PG8_SA(b, h) + aoff + m * 2048 + 1024); } \
        else { _Pragma("unroll") for (int k = 0; k < 2; ++k) dst[m][k] = *(const PG8_LAS bf16x8*)(lds + PG8_SA(b, h) + aoff + m * 2048 + k * 1024); } } } while (0)
#define PG8_LDB(dst, b, h) do { _Pragma("unroll") for (int n = 0; n < 2; ++n) { if constexpr (FP8) { dst##8[n].lo = *(const PG8_LAS i32x4v*)(lds + PG8_SB(b, h) + boff + n * 2048); dst##8[n].hi = *(const PG8_LAS i32x4v*)(lds + PG8_SB(b, h) + boff + n * 2048 + 1024); } \
        else { _Pragma("unroll") for (int k = 0; k < 2; ++k) dst[n][k] = *(const PG8_LAS bf16x8*)(lds + PG8_SB(b, h) + boff + n * 2048 + k * 1024); } } } while (0)
#define PG8_MMA(ai, bj, At, Bt) do { __builtin_amdgcn_s_setprio(1); _Pragma("unroll") for (int m = 0; m < 4; ++m) _Pragma("unroll") for (int n = 0; n < 2; ++n) _Pragma("unroll") for (int k = 0; k < 2; ++k) \
        { if constexpr (FP8) { if (k == 0) asm volatile("v_mfma_scale_f32_16x16x128_f8f6f4 %0, %1, %2, %0, %3, %3 op_sel_hi:[0,0,0]" : "+v"(acc[ai][bj][m][n]) : "v"(Bt##8[n]), "v"(At##8[m]), "v"(fp8_unit_scale)); } \
          else acc[ai][bj][m][n] = __builtin_amdgcn_mfma_f32_16x16x32_bf16(Bt[n][k], At[m][k], acc[ai][bj][m][n], 0, 0, 0); } __builtin_amdgcn_s_setprio(0); } while (0)
#define PG8_WAIT_V(n) asm volatile("s_waitcnt vmcnt(" #n ")" ::: "memory")
#ifndef PG8_PF
#define PG8_PF 0
#endif
#ifndef PG8_PFD
#define PG8_PFD 4
#endif
#if PG8_PF
#define PG8_WAIT_V8 PG8_WAIT_V(9)
#define PG8_PREFETCH(q_) do { const int q = (q_); const char* pb_ = (q < nt) ? ((wid < 4 ? cA : cB) + (size_t)q * kstep) : ((wid < 4 ? nA : nB) + (size_t)(q - nt) * kstep); \
        __builtin_amdgcn_global_load_lds((const unsigned*)(pb_ + pfoff), (PG8_LAS unsigned*)(lds + STAGE_BYTES + 2048 + wid * 256), 4, 0, 0); } while (0)
#else
#define PG8_WAIT_V8 PG8_WAIT_V(8)
#define PG8_PREFETCH(q_) do { } while (0)
#endif
#define PG8_WAIT_L(n) asm volatile("s_waitcnt lgkmcnt(" #n ")" ::: "memory")
#define PG8_BAR __builtin_amdgcn_s_barrier()
#define PG8_SCHED __builtin_amdgcn_sched_barrier(0)
    Unit cur, nxt; int ui = 0;
    if (!S.next(0, cur)) return;
#ifndef PG8_KROT
#define PG8_KROT 0
#endif
    const int ktm = nt - 1;
#define PG8_ROT(u) (PG8_KROT ? (((u).pn + 2 * (u).pm) & ktm) : 0)
#define PG8_KT(rot, t) ((size_t)(((t) + (rot)) & ktm) * kstep)
    f32x4 acc[2][2][4][2];
#pragma unroll
    for (int a = 0; a < 2; ++a)
#pragma unroll
        for (int b = 0; b < 2; ++b)
#pragma unroll
            for (int m = 0; m < 4; ++m)
#pragma unroll
                for (int n = 0; n < 2; ++n) acc[a][b][m][n] = (f32x4){0.f, 0.f, 0.f, 0.f};
    const int fp8_unit_scale = 0x7f7f7f7f; (void)fp8_unit_scale;
    bf16x8 At[4][2], B0[2][2], B1[2][2]; i32x8 At8[4], B08[2], B18[2];
    const char* cA = (const char*)g.A + (size_t)cur.pm * tstep; const char* cB = (const char*)g.Bt + (size_t)cur.pb * tstep;
    S.a_ready(cur);
    int rot = PG8_ROT(cur);
    if constexpr (SP2) {
        { const size_t k0 = PG8_KT(rot, 0), k1 = PG8_KT(rot, 1);
        PG8_STAGE(PG8_SB(0, 0), cB + k0, voffB); PG8_STAGE(PG8_SB(0, 1), cB + hstep + k0, voffB); PG8_STAGE(PG8_SA(0, 0), cA + k0, voffA); PG8_STAGE(PG8_SA(0, 1), cA + hstep + k0, voffA);
        if (wr == 1) PG8_BAR;
        PG8_WAIT_V(2); PG8_BAR;
        PG8_STAGE(PG8_SB(1, 0), cB + k1, voffB); PG8_STAGE(PG8_SA(1, 0), cA + k1, voffA); PG8_STAGE(PG8_SB(1, 1), cB + hstep + k1, voffB); }
        PG8_WAIT_V(6); PG8_BAR;
    } else {
        const size_t k0 = PG8_KT(rot, 0), k1 = PG8_KT(rot, 1);
        PG8_STAGE(PG8_SB(0, 0), cB + k0, voffB); PG8_STAGE(PG8_SA(0, 0), cA + k0, voffA); PG8_STAGE(PG8_SB(0, 1), cB + hstep + k0, voffB); PG8_STAGE(PG8_SA(0, 1), cA + hstep + k0, voffA);
        if (wr == 1) PG8_BAR;
        PG8_WAIT_V(4); PG8_BAR;
        PG8_STAGE(PG8_SB(1, 0), cB + k1, voffB); PG8_STAGE(PG8_SA(1, 0), cA + k1, voffA); PG8_STAGE(PG8_SB(1, 1), cB + hstep + k1, voffB);
        PG8_WAIT_V(6); PG8_BAR;
    }
    for (;;) {
        const bool has_next = S.next(ui + 1, nxt);
        const char* nA = has_next ? (const char*)g.A + (size_t)nxt.pm * tstep : cA; const char* nB = has_next ? (const char*)g.Bt + (size_t)nxt.pb * tstep : cB;
        const int nrot = has_next ? PG8_ROT(nxt) : rot;
        for (int t = 0; t < nt; t += 2) {
            const bool last = (t == nt - 2);
            const char* a1 = cA + PG8_KT(rot, t + 1);
            const char* a2 = last ? nA + PG8_KT(nrot, 0) : cA + PG8_KT(rot, t + 2); const char* b2 = last ? nB + PG8_KT(nrot, 0) : cB + PG8_KT(rot, t + 2);
            const char* a3 = last ? nA + PG8_KT(nrot, 1) : cA + PG8_KT(rot, t + 3); const char* b3 = last ? nB + PG8_KT(nrot, 1) : cB + PG8_KT(rot, t + 3);
            if (last && has_next) S.a_ready(nxt);
            if constexpr (SP2) {
            PG8_LDB(B0, 0, 0); PG8_LDB(B1, 0, 1); PG8_SCHED; PG8_LDA(At, 0, 0); PG8_STAGE(PG8_SA(1, 1), a1 + hstep, voffA);
            PG8_WAIT_V8; PG8_WAIT_L(0); PG8_BAR; PG8_MMA(0, 0, At, B0); PG8_MMA(0, 1, At, B1); PG8_BAR; PG8_SCHED;
            PG8_LDA(At, 0, 1); PG8_STAGE(PG8_SB(0, 0), b2, voffB); PG8_STAGE(PG8_SB(0, 1), b2 + hstep, voffB); PG8_STAGE(PG8_SA(0, 0), a2, voffA); PG8_PREFETCH(t + PG8_PFD);
            PG8_WAIT_V8; PG8_WAIT_L(0); PG8_BAR; PG8_MMA(1, 0, At, B0); PG8_MMA(1, 1, At, B1); PG8_BAR; PG8_SCHED;
            PG8_LDB(B0, 1, 0); PG8_LDB(B1, 1, 1); PG8_SCHED; PG8_LDA(At, 1, 0); PG8_STAGE(PG8_SA(0, 1), a2 + hstep, voffA);
            PG8_WAIT_V8; PG8_WAIT_L(0); PG8_BAR; PG8_MMA(0, 0, At, B0); PG8_MMA(0, 1, At, B1); PG8_BAR; PG8_SCHED;
            PG8_LDA(At, 1, 1); PG8_STAGE(PG8_SB(1, 0), b3, voffB); PG8_STAGE(PG8_SB(1, 1), b3 + hstep, voffB); PG8_STAGE(PG8_SA(1, 0), a3, voffA); PG8_PREFETCH(t + 1 + PG8_PFD);
            PG8_WAIT_V8; PG8_WAIT_L(0); PG8_BAR; PG8_MMA(1, 0, At, B0); PG8_MMA(1, 1, At, B1); PG8_BAR; PG8_SCHED;
            } else {
            PG8_LDB(B0, 0, 0); PG8_SCHED; PG8_LDA(At, 0, 0); PG8_STAGE(PG8_SA(1, 1), a1 + hstep, voffA);
            PG8_WAIT_L(8); PG8_BAR; PG8_WAIT_L(0); PG8_MMA(0, 0, At, B0); PG8_BAR; PG8_SCHED;
            PG8_LDB(B1, 0, 1); PG8_STAGE(PG8_SB(0, 0), b2, voffB);
            PG8_BAR; PG8_WAIT_L(0); PG8_MMA(0, 1, At, B1); PG8_BAR;
            PG8_LDA(At, 0, 1); PG8_STAGE(PG8_SA(0, 0), a2, voffA);
            PG8_BAR; PG8_WAIT_L(0); PG8_MMA(1, 0, At, B0); PG8_BAR; PG8_SCHED;
            PG8_STAGE(PG8_SB(0, 1), b2 + hstep, voffB);
            PG8_WAIT_V(6); PG8_BAR; PG8_MMA(1, 1, At, B1); PG8_BAR;
            PG8_LDB(B0, 1, 0); PG8_SCHED; PG8_LDA(At, 1, 0); PG8_STAGE(PG8_SA(0, 1), a2 + hstep, voffA);
            PG8_WAIT_L(8); PG8_BAR; PG8_WAIT_L(0); PG8_MMA(0, 0, At, B0); PG8_BAR; PG8_SCHED;
            PG8_LDB(B1, 1, 1); PG8_STAGE(PG8_SB(1, 0), b3, voffB);
            PG8_BAR; PG8_WAIT_L(0); PG8_MMA(0, 1, At, B1); PG8_BAR;
            PG8_LDA(At, 1, 1); PG8_STAGE(PG8_SA(1, 0), a3, voffA);
            PG8_BAR; PG8_WAIT_L(0); PG8_MMA(1, 0, At, B0); PG8_BAR; PG8_SCHED;
            PG8_STAGE(PG8_SB(1, 1), b3 + hstep, voffB);
            PG8_WAIT_V(6); PG8_BAR; PG8_MMA(1, 1, At, B1); PG8_BAR;
            }
        }
        if constexpr (FP8) asm volatile("s_nop 15\n\ts_nop 15" ::: "memory");
        if constexpr (ALIGN_EPI) { if (wr == 0) PG8_BAR; }
        if constexpr (!Epi::AFTER_DRAIN) { E(acc, cur, wr, wc, fr, fq); S.done(cur); }
        if (!has_next) break;
#pragma unroll
        for (int a = 0; a < 2; ++a)
#pragma unroll
            for (int b = 0; b < 2; ++b)
#pragma unroll
                for (int m = 0; m < 4; ++m)
#pragma unroll
                    for (int n = 0; n < 2; ++n) acc[a][b][m][n] = (f32x4){0.f, 0.f, 0.f, 0.f};
        cur = nxt; cA = nA; cB = nB; rot = nrot; ++ui;
        if constexpr (ALIGN_EPI) { if (wr == 1) PG8_BAR; }
    }
    PG8_WAIT_V(0);
    if constexpr (!ALIGN_EPI) { if (wr == 0) PG8_BAR; }
    PG8_BAR;
    if constexpr (Epi::AFTER_DRAIN) { E.fused(acc, cur, wr, wc, fr, fq, lds, wid, lane); S.done(cur); }
#undef PG8_ROT
#undef PG8_KT
#undef PG8_SA
#undef PG8_SB
#undef PG8_STAGE
#undef PG8_LDA
#undef PG8_LDB
#undef PG8_MMA
#undef PG8_WAIT_V
#undef PG8_WAIT_V8
#undef PG8_PREFETCH
#undef PG8_WAIT_L
#undef PG8_BAR
#undef PG8_SCHED
}
}
#include <cstdlib>
#include <vector>

#define XB_TMO      128
#define XB_XCNT(j)  (256  + 64 * (j))
#define XB_XSUB(j)  (1280 + 64 * (j))
#define XB_XGEN(j)  (2304 + 64 * (j))
#define XB_TOP      3328
#define XB_TOPGEN   3392
#define XCD_BAR_WORDS 3456
#define XB_SPIN_CAP (1u << 18)
#define LAS __attribute__((address_space(3)))

__device__ __forceinline__ unsigned xb_ld(unsigned* p)              { return __hip_atomic_load(p, __ATOMIC_RELAXED, __HIP_MEMORY_SCOPE_AGENT); }
__device__ __forceinline__ unsigned xb_add(unsigned* p, unsigned v) { return __hip_atomic_fetch_add(p, v, __ATOMIC_RELAXED, __HIP_MEMORY_SCOPE_AGENT); }
__device__ __forceinline__ unsigned xb_xcc_id() { return (unsigned)__builtin_amdgcn_s_getreg((3 << 11) | 20) & 0xFu; }
#define XB_SPIN(cond, bar) do { unsigned _sp = 0; while (cond) { __builtin_amdgcn_s_sleep(1); \
    if ((++_sp & 255u) == 0u) { if (xb_ld(&(bar)[XB_TMO])) break; if (_sp > XB_SPIN_CAP) { atomicAdd(&(bar)[XB_TMO], 1u); break; } } } } while (0)

struct XcdBarrier {
    unsigned* bar; unsigned x;
    volatile LAS unsigned* st;
};

__device__ __forceinline__ XcdBarrier xcd_barrier_post(unsigned* bar, volatile LAS unsigned* st) {
    XcdBarrier b; b.bar = bar; b.x = xb_xcc_id(); b.st = st;
    if (tid_opaque() == 0) (void)xb_add(&bar[XB_XCNT(b.x)], 1u);
    return b;
}
__device__ __forceinline__ void xcd_barrier_complete(unsigned* bar, unsigned x, unsigned& nloc, unsigned& nx) {
    const unsigned G = gridDim.x * gridDim.y * gridDim.z;
    unsigned sum, cnt, mine, sp = 0u;
    for (;;) {
        sum = 0u; cnt = 0u; mine = 0u;
#pragma unroll
        for (unsigned j = 0; j < 16; ++j) { const unsigned c = xb_ld(&bar[XB_XCNT(j)]); sum += c; cnt += (c > 0u) ? 1u : 0u; mine = (j == x) ? c : mine; }
        if (sum == G) break;
        __builtin_amdgcn_s_sleep(1);
        if ((++sp & 255u) == 0u) { if (xb_ld(&bar[XB_TMO])) break; if (sp > XB_SPIN_CAP) { atomicAdd(&bar[XB_TMO], 1u); break; } }
    }
    nloc = mine > 0u ? mine : 1u; nx = cnt > 0u ? cnt : 1u;
}

__device__ __forceinline__ void xcd_barrier(const XcdBarrier& b) {
    asm volatile("s_waitcnt vmcnt(0)" ::: "memory");
    __syncthreads();
    if (tid_opaque() == 0) {
        unsigned* bar = b.bar;
        __builtin_amdgcn_s_waitcnt(0);
        unsigned nloc = b.st[0], nx = b.st[1];
        if (nloc == 0u) { xcd_barrier_complete(bar, b.x, nloc, nx); b.st[0] = nloc; b.st[1] = nx; }
        const unsigned old = xb_add(&bar[XB_XSUB(b.x)], 1u);
        const unsigned gen = old / nloc;
        if (old + 1u == (gen + 1u) * nloc) {
            __builtin_amdgcn_fence(__ATOMIC_RELEASE, "agent");
            asm volatile("s_waitcnt vmcnt(0)" ::: "memory");
            const unsigned og = xb_add(&bar[XB_TOP], 1u);
            const unsigned tg = og / nx;
            if (og + 1u == (tg + 1u) * nx) xb_add(&bar[XB_TOPGEN], 1u);
            else XB_SPIN(xb_ld(&bar[XB_TOPGEN]) == tg, bar);
            __builtin_amdgcn_fence(__ATOMIC_ACQUIRE, "agent");
            xb_add(&bar[XB_XGEN(b.x)], 1u);
            asm volatile("s_waitcnt vmcnt(0)" ::: "memory");
        } else {
            XB_SPIN(xb_ld(&bar[XB_XGEN(b.x)]) == gen, bar);
            __builtin_amdgcn_fence(__ATOMIC_ACQUIRE, "agent");
            asm volatile("s_waitcnt vmcnt(0)" ::: "memory");
        }
    }
    __syncthreads();
}

using pg8::bf16_t; using pg8::bf16x8; using pg8::f32x4; using pg8::u32x4; using pg8::Unit; using pg8::Gemm;
typedef float f32x16 __attribute__((ext_vector_type(16)));
typedef unsigned u32x2 __attribute__((ext_vector_type(2)));

constexpr int T_TOK = 16384, SEQ = 4096, DM = 1024;
constexpr int NPW = 3328;
constexpr int PW_SRC = 3120;
constexpr int PP = 3072;
constexpr int C_AQ = 0, C_AK = 512, C_AV = 640, C_IQ = 768, C_MQ = 1024, C_MK = 1536, C_MV = 2048, C_MO = 2560;
constexpr int NEXP = 32, XROWS = 65536 + 32 * 256;
constexpr int NTHREADS = 512;
constexpr int LDS_BYTES = 160 * 1024;
constexpr int RDY_WORDS = 320;
constexpr float NORM_EPS = 1e-6f;

struct Params {
    const float *x, *mix_norm_w, *w_in, *conv_w, *conv_b, *igate_b, *fgate_b, *mlstm_norm_w, *w_out, *ffn_norm_w, *router_w, *router_b, *w_gu, *b_gu, *w_dn,
        *b_dn, *final_norm_w;
    float* out;
    bf16_t *wt_in, *wt_out, *wt_gu, *wt_dn, *xn, *proj, *ikb, *vt, *cq, *ck, *cst, *mix, *xbuf, *act, *ybuf;
    float *iw, *mi, *mf, *cb, *ropea, *ropei, *nu, *bl, *mloc, *ns, *ms, *topg, *rsv;
    bf16_t* ut;
    bf16_t* x1;
    unsigned long long* mask;
    int *tope, *topp, *cnt;
    unsigned* bar; unsigned* rdy;
    unsigned char *xn8, *wt_in8;
};

#ifndef MOE_FP8
#define MOE_FP8 1
#endif
#ifndef PROJ_FP8
#define PROJ_FP8 1
#endif
constexpr float FP8_XS = 4.0f, FP8_WS = 64.0f, FP8_INV = 1.0f / (4.0f * 64.0f);
__device__ __forceinline__ unsigned pk4_fp8(float a, float b, float c, float d) { int w = 0; w = __builtin_amdgcn_cvt_pk_fp8_f32(a, b, w, false); w = __builtin_amdgcn_cvt_pk_fp8_f32(c, d, w, true); return (unsigned)w; }
#ifndef WT_EPI
#define WT_EPI 0
#endif
__device__ __forceinline__ void store16_wt(void* base, size_t byte_off, u32x4 v) {
#if WT_EPI
    const __amdgpu_buffer_rsrc_t r = __builtin_amdgcn_make_buffer_rsrc(base, 0, 0x7fffffff, 0x00020000);
    __builtin_amdgcn_raw_buffer_store_b128(v, r, (unsigned)byte_off, 0, 16);
#else
    *(u32x4*)((unsigned char*)base + byte_off) = v;
#endif
}
__device__ __forceinline__ float bf2f(unsigned short h) { return __uint_as_float(((unsigned)h) << 16); }
__device__ __forceinline__ unsigned pk2(float lo, float hi) { typedef float f2_ __attribute__((ext_vector_type(2))); typedef __bf16 b2_ __attribute__((ext_vector_type(2))); return __builtin_bit_cast(unsigned, __builtin_convertvector((f2_){lo, hi}, b2_)); }
__device__ __forceinline__ unsigned pk2c(float lo, float hi) { typedef float f2_ __attribute__((ext_vector_type(2))); typedef __bf16 b2_ __attribute__((ext_vector_type(2))); return __builtin_bit_cast(unsigned, __builtin_convertvector((f2_){lo, hi}, b2_)); }
__device__ __forceinline__ unsigned short f2bf(float f) { return (unsigned short)(pk2(f, 0.f) & 0xffffu); }
__device__ __forceinline__ f32x4 mfma16(bf16x8 a, bf16x8 b, f32x4 c) { return __builtin_amdgcn_mfma_f32_16x16x32_bf16(a, b, c, 0, 0, 0); }
__device__ __forceinline__ f32x16 mfma32(bf16x8 a, bf16x8 b, f32x16 c) { return __builtin_amdgcn_mfma_f32_32x32x16_bf16(a, b, c, 0, 0, 0); }
__device__ __forceinline__ float wave_sum(float v) {
#pragma unroll
    for (int o = 32; o > 0; o >>= 1) v += __shfl_xor(v, o);
    return v;
}
__device__ __forceinline__ float wave_max(float v) {
#pragma unroll
    for (int o = 32; o > 0; o >>= 1) v = fmaxf(v, __shfl_xor(v, o));
    return v;
}
__device__ __forceinline__ u32x4 pack8(const float* f) { u32x4 w; w.x = pk2(f[0], f[1]); w.y = pk2(f[2], f[3]); w.z = pk2(f[4], f[5]); w.w = pk2(f[6], f[7]); return w; }
__device__ __forceinline__ void unpack8(u32x4 w, float* f) {
    f[0] = __uint_as_float(w.x << 16); f[1] = __uint_as_float(w.x & 0xffff0000u); f[2] = __uint_as_float(w.y << 16); f[3] = __uint_as_float(w.y & 0xffff0000u);
    f[4] = __uint_as_float(w.z << 16); f[5] = __uint_as_float(w.z & 0xffff0000u); f[6] = __uint_as_float(w.w << 16); f[7] = __uint_as_float(w.w & 0xffff0000u);
}
__device__ __forceinline__ float sigmoidf_(float z) { return __builtin_amdgcn_rcpf(1.0f + __builtin_amdgcn_exp2f(-1.4426950408889634f * z)); }

typedef short v4i16_t __attribute__((ext_vector_type(4)));
__device__ __forceinline__ v4i16_t lds_tr16(const bf16_t* ptr) { return __builtin_amdgcn_ds_read_tr16_b64_v4i16((__attribute__((address_space(3))) v4i16_t*)ptr); }
__device__ __forceinline__ int srccol_in(int n) {
    if (n < 1024) return n;
    if (n < 2560) return n + 40;
    if (n < 3072) return n + 48;
    if (n < 3112) return n - 3072 + 1024;
    if (n < 3120) return n - 3112 + 2600;
    return -1;
}
__device__ __forceinline__ int srccol_gu(int n) { return ((n & 128) ? 1024 : 0) + 128 * (n >> 8) + (n & 127); }

#ifndef CONV_NB
#define CONV_NB 4
#endif
struct TrTile { const float* src; bf16_t* dst; int ld, k0, n0, which; unsigned char* dst8; };
__device__ __forceinline__ TrTile tr_decode_in(const Params& p, int id) { TrTile t; t.src = p.w_in; t.dst = p.wt_in; t.ld = PW_SRC; t.n0 = (id % (NPW / 64)) * 64; t.k0 = (id / (NPW / 64)) * 64; t.which = 0; t.dst8 = p.wt_in8; return t; }
__device__ __forceinline__ TrTile tr_decode_s(const Params& p, int id) {
    const bool is_out = id < 256, is_gu = id < 256 + 16384;
    const int j = is_out ? id : (is_gu ? id - 256 : id - 256 - 16384);
    const int e = is_out ? 0 : (is_gu ? (j >> 9) : (j >> 8));
    const size_t esz_src = is_gu ? (size_t)1024 * 2048 : (size_t)1024 * 1024, esz_dst = (is_gu ? (size_t)2048 * 1024 : (size_t)1024 * 1024) * (MOE_FP8 ? 1 : 2);
    const float* sb = is_out ? p.w_out : (is_gu ? p.w_gu : p.w_dn); unsigned char* db = (unsigned char*)(is_out ? p.wt_out : (is_gu ? p.wt_gu : p.wt_dn));
    TrTile t; t.src = sb + (size_t)e * esz_src; t.dst = (bf16_t*)(db + (size_t)e * esz_dst); t.ld = (!is_out && is_gu) ? 2048 : 1024;
    t.n0 = ((!is_out && is_gu) ? (j & 31) : (j & 15)) * 64; t.k0 = ((!is_out && is_gu) ? ((j >> 5) & 15) : ((j >> 4) & 15)) * 64; t.which = is_out ? 2 : (is_gu ? 1 : 3); t.dst8 = nullptr;
    return t;
}
__device__ __forceinline__ void tr_load(const TrTile& t, int tid, float4 (&v)[2]) {
#pragma unroll
    for (int i = 0; i < 2; ++i) {
        const int k = (tid >> 4) + 32 * i, dn = t.n0 + (tid & 15) * 4; const int sc = (t.which == 1) ? srccol_gu(dn) : dn;
        { const f32x4 t4 = __builtin_nontemporal_load((const f32x4*)(t.src + (size_t)(t.k0 + k) * t.ld + sc)); v[i] = make_float4(t4[0], t4[1], t4[2], t4[3]); }
    }
}
__device__ __forceinline__ void tr_load_in(const TrTile& t, int tid, float4 (&v)[2]) {
#pragma unroll
    for (int i = 0; i < 2; ++i) {
        const int k = (tid >> 4) + 32 * i, dn = t.n0 + (tid & 15) * 4; const int sc = srccol_in(dn);
        const float4 ld4 = *(const float4*)(t.src + (size_t)(t.k0 + k) * t.ld + max(sc, 0));
        v[i] = (sc >= 0) ? ld4 : make_float4(0.f, 0.f, 0.f, 0.f);
    }
}
__device__ __forceinline__ void tr_lds_write(float* tile, int tid, const float4 (&v)[2]) {
#pragma unroll
    for (int i = 0; i < 2; ++i) { float* tp = tile + ((tid >> 4) + 32 * i) * 65 + (tid & 15) * 4; tp[0] = v[i].x; tp[1] = v[i].y; tp[2] = v[i].z; tp[3] = v[i].w; }
}
__device__ __forceinline__ void tr_store(const TrTile& t, const float* tile, int tid) {
    const int n = tid >> 3, k8 = (tid & 7) * 8; float f[8];
#pragma unroll
    for (int j = 0; j < 8; ++j) f[j] = tile[(k8 + j) * 65 + n];
#if MOE_FP8
    if (t.which == 1 || t.which == 3) { u32x2 w; w.x = pk4_fp8(f[0] * FP8_WS, f[1] * FP8_WS, f[2] * FP8_WS, f[3] * FP8_WS); w.y = pk4_fp8(f[4] * FP8_WS, f[5] * FP8_WS, f[6] * FP8_WS, f[7] * FP8_WS);
        *(u32x2*)((unsigned char*)t.dst + (size_t)(t.n0 + n) * 1024 + t.k0 + k8) = w; return; }
#endif
    *(u32x4*)(t.dst + (size_t)(t.n0 + n) * 1024 + t.k0 + k8) = pack8(f);
#if PROJ_FP8
    if (t.which == 0 && t.n0 + n < PP) { u32x2 w; w.x = pk4_fp8(f[0] * FP8_WS, f[1] * FP8_WS, f[2] * FP8_WS, f[3] * FP8_WS); w.y = pk4_fp8(f[4] * FP8_WS, f[5] * FP8_WS, f[6] * FP8_WS, f[7] * FP8_WS);
        *(u32x2*)(t.dst8 + (size_t)(t.n0 + n) * 1024 + t.k0 + k8) = w; }
#endif
}

#ifndef CONV_WAVES
#define CONV_WAVES 1
#endif
__device__ __forceinline__ int streamed_tiles_of_wg() { constexpr int NT_S = (CONV_WAVES && MOE_FP8) ? 256 : 256 + 16384 + 8192; const int G = gridDim.x; return (NT_S - (int)blockIdx.x + G - 1) / G; }
__device__ __forceinline__ void convert_streamed(const Params& p, unsigned char* lds, int qbeg, int qend) {
    const int tid = tid_opaque();
    float* tiles = (float*)lds; constexpr int TB = 64 * 65; const int G = gridDim.x;
    {
        constexpr int NB = CONV_NB;
        const int nper = qend - qbeg;
        if (nper <= 0) return;
        float4 cur[NB][2], nxt[NB][2];
#pragma unroll
        for (int j = 0; j < NB; ++j) { const int q = min(j, nper - 1); tr_load(tr_decode_s(p, blockIdx.x + (qbeg + q) * G), tid, cur[j]); }
        int par = 0;
        for (int q0 = 0; q0 < nper; q0 += NB) {
#pragma unroll
            for (int j = 0; j < NB; ++j) { const int q = min(q0 + NB + j, nper - 1); tr_load(tr_decode_s(p, blockIdx.x + (qbeg + q) * G), tid, nxt[j]); }
#pragma unroll
            for (int sub = 0; sub < NB; sub += 4, par ^= 1) {
#pragma unroll
                for (int j = 0; j < 4; ++j) tr_lds_write(tiles + (par * 4 + j) * TB, tid, cur[sub + j]);
                asm volatile("s_waitcnt lgkmcnt(0)" ::: "memory"); __builtin_amdgcn_s_barrier(); asm volatile("" ::: "memory");
#pragma unroll
                for (int j = 0; j < 4; ++j) if (q0 + sub + j < nper) tr_store(tr_decode_s(p, blockIdx.x + (qbeg + q0 + sub + j) * G), tiles + (par * 4 + j) * TB, tid);
            }
#pragma unroll
            for (int j = 0; j < NB; ++j) { cur[j][0] = nxt[j][0]; cur[j][1] = nxt[j][1]; }
        }
        __syncthreads();
    }
}

constexpr int NT_W8 = 16384 + 8192;
__device__ __forceinline__ void wt8_addr(const Params& p, int id, int lane, const float*& src, unsigned char*& dst, int& ld) {
    const bool gu = id < 16384; const int j = gu ? id : id - 16384;
    const int e = gu ? (j >> 9) : (j >> 8), nb = gu ? (j & 63) : (j & 31), kb = gu ? ((j >> 6) & 7) : ((j >> 5) & 7);
    ld = gu ? 2048 : 1024;
    const int ng = lane & 7, kg = lane >> 3, dn = nb * 32 + ng * 4, sc = gu ? srccol_gu(dn) : dn;
    src = (gu ? p.w_gu : p.w_dn) + (size_t)e * 1024 * ld + (size_t)(kb * 128 + kg * 16) * ld + sc;
    dst = (unsigned char*)(gu ? p.wt_gu : p.wt_dn) + (size_t)e * ld * 1024 + (size_t)dn * 1024 + kb * 128 + kg * 16;
}
__device__ __forceinline__ void wt8_load(const Params& p, int id, int lane, f32x4 (&v)[16]) {
    const float* src; unsigned char* dst; int ld; wt8_addr(p, id, lane, src, dst, ld);
#pragma unroll
    for (int j = 0; j < 16; ++j) v[j] = __builtin_nontemporal_load((const f32x4*)(src + (size_t)j * ld));
}
__device__ __forceinline__ void wt8_store(const Params& p, int id, int lane, const f32x4 (&v)[16]) {
    const float* src; unsigned char* dst; int ld; wt8_addr(p, id, lane, src, dst, ld);
#pragma unroll
    for (int c = 0; c < 4; ++c) { u32x4 w;
#pragma unroll
        for (int d = 0; d < 4; ++d) w[d] = pk4_fp8(v[4 * d][c] * FP8_WS, v[4 * d + 1][c] * FP8_WS, v[4 * d + 2][c] * FP8_WS, v[4 * d + 3][c] * FP8_WS);
        *(u32x4*)(dst + (size_t)c * 1024) = w; }
}
__device__ __forceinline__ void wt8_cvt(const f32x4 (&v)[16], u32x4 (&w)[4]) {
#pragma unroll
    for (int c = 0; c < 4; ++c)
#pragma unroll
        for (int d = 0; d < 4; ++d) w[c][d] = pk4_fp8(v[4 * d][c] * FP8_WS, v[4 * d + 1][c] * FP8_WS, v[4 * d + 2][c] * FP8_WS, v[4 * d + 3][c] * FP8_WS);
}
__device__ __forceinline__ void wt8_put(const Params& p, int id, int lane, const u32x4 (&w)[4]) {
    const float* src; unsigned char* dst; int ld; wt8_addr(p, id, lane, src, dst, ld);
#pragma unroll
    for (int c = 0; c < 4; ++c) *(u32x4*)(dst + (size_t)c * 1024) = w[c];
}
__device__ __forceinline__ void convert_fp8_waves(const Params& p, int i0) {
    const int tid = tid_opaque(), wid = __builtin_amdgcn_readfirstlane(tid >> 6), lane = tid & 63, stride = gridDim.x * 8, first = blockIdx.x * 8 + wid + i0 * stride;
    if (first >= NT_W8) return;
    const int n = (NT_W8 - first + stride - 1) / stride;
    f32x4 a[16], b[16];
    wt8_load(p, first, lane, a);
    int i = 0;
    for (; i + 3 < n; i += 2) {
        wt8_load(p, first + (i + 1) * stride, lane, b); wt8_store(p, first + i * stride, lane, a);
        wt8_load(p, first + (i + 2) * stride, lane, a); wt8_store(p, first + (i + 1) * stride, lane, b);
    }
    if (i + 1 < n) {
        wt8_load(p, first + (i + 1) * stride, lane, b); wt8_store(p, first + i * stride, lane, a);
        if (i + 2 < n) { wt8_load(p, first + (i + 2) * stride, lane, a); wt8_store(p, first + (i + 1) * stride, lane, b); wt8_store(p, first + (i + 2) * stride, lane, a); }
        else wt8_store(p, first + (i + 1) * stride, lane, b);
    } else wt8_store(p, first + i * stride, lane, a);
}

#ifdef PROBE_LOADONLY
__device__ __forceinline__ void convert_fp8_loadonly(const Params& p) {
    const int tid = tid_opaque(), wid = __builtin_amdgcn_readfirstlane(tid >> 6), lane = tid & 63, stride = gridDim.x * 8, first = blockIdx.x * 8 + wid;
    if (first >= NT_W8) return;
    const int n = (NT_W8 - first + stride - 1) / stride;
    f32x4 a[16], b[16]; float acc = 0.f;
    wt8_load(p, first, lane, a);
    for (int i = 0; i < n; i += 2) {
        wt8_load(p, first + min(i + 1, n - 1) * stride, lane, b);
#pragma unroll
        for (int j = 0; j < 16; ++j) acc += a[j][0] + a[j][1] + a[j][2] + a[j][3];
        wt8_load(p, first + min(i + 2, n - 1) * stride, lane, a);
#pragma unroll
        for (int j = 0; j < 16; ++j) acc += b[j][0] + b[j][1] + b[j][2] + b[j][3];
    }
#pragma unroll
    for (int j = 0; j < 16; ++j) acc += a[j][0];
    asm volatile("" :: "v"(acc));
}
#endif
#ifndef TK_TILES_N
#define TK_TILES_N 0
#endif
constexpr int TK_TILES = TK_TILES_N;
__device__ __forceinline__ void wh8_addr(const Params& p, int hid, int lane, const float*& src, unsigned char*& dst, int& ld) {
    const int id = hid >> 1, kh = hid & 1; const bool gu = id < 16384; const int j = gu ? id : id - 16384;
    const int e = gu ? (j >> 9) : (j >> 8), nb = gu ? (j & 63) : (j & 31), kb = gu ? ((j >> 6) & 7) : ((j >> 5) & 7);
    ld = gu ? 2048 : 1024;
    const int ng = lane & 7, kg = lane >> 3, dn = nb * 32 + ng * 4, sc = gu ? srccol_gu(dn) : dn, k0 = kb * 128 + kh * 64 + kg * 8;
    src = (gu ? p.w_gu : p.w_dn) + (size_t)e * 1024 * ld + (size_t)k0 * ld + sc;
    dst = (unsigned char*)(gu ? p.wt_gu : p.wt_dn) + (size_t)e * ld * 1024 + (size_t)dn * 1024 + k0;
}
__device__ __forceinline__ void wh8_load(const Params& p, int hid, int lane, f32x4 (&v)[8]) {
    const float* src; unsigned char* dst; int ld; wh8_addr(p, hid, lane, src, dst, ld);
#pragma unroll
    for (int j = 0; j < 8; ++j) v[j] = __builtin_nontemporal_load((const f32x4*)(src + (size_t)j * ld));
}
__device__ __forceinline__ void wh8_store(const Params& p, int hid, int lane, const f32x4 (&v)[8]) {
    const float* src; unsigned char* dst; int ld; wh8_addr(p, hid, lane, src, dst, ld);
#pragma unroll
    for (int c = 0; c < 4; ++c) { u32x2 w; w.x = pk4_fp8(v[0][c] * FP8_WS, v[1][c] * FP8_WS, v[2][c] * FP8_WS, v[3][c] * FP8_WS); w.y = pk4_fp8(v[4][c] * FP8_WS, v[5][c] * FP8_WS, v[6][c] * FP8_WS, v[7][c] * FP8_WS);
        *(u32x2*)(dst + (size_t)c * 1024) = w; }
}
struct HostQ { int first, stride, i, n; };
__device__ __forceinline__ int hostq_id(const HostQ& q, int k) { return 2 * (q.first + (k >> 1) * q.stride) + (k & 1); }
__device__ __forceinline__ void convert_fp8_rest(const Params& p, int i0, int i1) {
    const int tid = tid_opaque(), wid = __builtin_amdgcn_readfirstlane(tid >> 6), lane = tid & 63, stride = gridDim.x * 8, first = blockIdx.x * 8 + wid;
    for (int i = i0; i < i1 && first + i * stride < NT_W8; ++i) { f32x4 v[16]; wt8_load(p, first + i * stride, lane, v); wt8_store(p, first + i * stride, lane, v); }
}
__device__ __forceinline__ void phase_prologue(const Params& p, unsigned char* lds) {
    const int tid = tid_opaque(), wid = tid >> 6, lane = tid & 63;
    float* tiles = (float*)lds;
    constexpr int TB = 64 * 65;
    const int G = gridDim.x;
    {
        constexpr int NT_IN = (NPW / 64) * 16;
        for (int id0 = blockIdx.x; id0 < NT_IN; id0 += 4 * G) {
            float4 v[4][2];
#pragma unroll
            for (int j = 0; j < 4; ++j) { const int id = (id0 + j * G < NT_IN) ? id0 + j * G : id0; tr_load_in(tr_decode_in(p, id), tid, v[j]); }
#pragma unroll
            for (int j = 0; j < 4; ++j) tr_lds_write(tiles + j * TB, tid, v[j]);
            __syncthreads();
#pragma unroll
            for (int j = 0; j < 4; ++j) if (id0 + j * G < NT_IN) tr_store(tr_decode_in(p, id0 + j * G), tiles + j * TB, tid);
            __syncthreads();
        }
    }
#ifdef PROBE_READ
    {
        constexpr int NT_S = 256 + 16384 + 8192, NB = 4;
        const int nper = (NT_S - (int)blockIdx.x + G - 1) / G; float4 acc4 = make_float4(0.f, 0.f, 0.f, 0.f);
        for (int q0 = 0; q0 < nper; q0 += NB) {
            float4 v[NB][2];
#pragma unroll
            for (int j = 0; j < NB; ++j) { const int q = min(q0 + j, nper - 1); tr_load(tr_decode_s(p, blockIdx.x + q * G), tid, v[j]); }
#pragma unroll
            for (int j = 0; j < NB; ++j) { acc4.x += v[j][0].x + v[j][1].x; acc4.y += v[j][0].y + v[j][1].y; }
        }
        asm volatile("" :: "v"(acc4.x), "v"(acc4.y));
    }
#endif
    for (int row = blockIdx.x * 8 + wid; row < T_TOK; row += gridDim.x * 8) {
        const float4* xr = (const float4*)(p.x + (size_t)row * DM); float4 v[4]; float ss = 0.f;
#pragma unroll
        for (int i = 0; i < 4; ++i) { v[i] = xr[lane + 64 * i]; ss += v[i].x * v[i].x + v[i].y * v[i].y + v[i].z * v[i].z + v[i].w * v[i].w; }
        ss = wave_sum(ss); const float rs = 1.0f / sqrtf(ss * (1.0f / DM) + NORM_EPS);
#pragma unroll
        for (int i = 0; i < 4; ++i) { const float4 w = ((const float4*)p.mix_norm_w)[lane + 64 * i];
            u32x2 o; o.x = pk2(v[i].x * rs * w.x, v[i].y * rs * w.y); o.y = pk2(v[i].z * rs * w.z, v[i].w * rs * w.w);
            *(u32x2*)(p.xn + (size_t)row * DM + (lane + 64 * i) * 4) = o;
#if PROJ_FP8
            *(unsigned*)(p.xn8 + (size_t)row * DM + (lane + 64 * i) * 4) = pk4_fp8(v[i].x * rs * w.x * FP8_XS, v[i].y * rs * w.y * FP8_XS, v[i].z * rs * w.z * FP8_XS, v[i].w * rs * w.w * FP8_XS);
#endif
        }
    }
    for (int i = blockIdx.x * NTHREADS + tid; i < SEQ * 12; i += gridDim.x * NTHREADS) {
        const float invf_tab[12] = {1.000000000e+00f, 1.939227432e-01f, 3.760603070e-02f, 7.292664610e-03f, 1.414213562e-03f, 2.742481884e-04f, 5.318295734e-05f, 1.031338525e-05f, 1.000000000e+00f, 3.760603070e-02f, 1.414213562e-03f, 5.318295734e-05f};
        const int pos = i / 12, j = i % 12; const bool att = j < 8; const int jj = att ? j : j - 8;
        float invf = invf_tab[0];
#pragma unroll
        for (int q = 1; q < 12; ++q) invf = (j == q) ? invf_tab[q] : invf;
        const float ang = (float)pos * invf; float sn, cs; sincosf(ang, &sn, &cs);
        float* dst = att ? (p.ropea + ((size_t)pos * 8 + jj) * 2) : (p.ropei + ((size_t)pos * 4 + jj) * 2);
        dst[0] = cs; dst[1] = sn;
    }
    if (blockIdx.x == 0 && tid < 64) p.cnt[tid] = 0;
    if (blockIdx.x == 1 && tid < RDY_WORDS) p.rdy[tid] = 0u;
}

template <bool F8>
struct EpiProjT {
    static constexpr bool PERM = true, AFTER_DRAIN = false;
    bf16_t* proj; bf16_t* ikb; float* iw; float* mi; float* mf; const float* ropea; const float* ropei; const float* igb; const float* fgb;
    __device__ __forceinline__ void operator()(const f32x4 (&acc)[2][2][4][2], const Unit& u, int wr, int wc, int fr, int fq) const {
        const float idx_w_scale = 0.35355339059327373f * 0.17677669529663687f;
#pragma unroll
        for (int ai = 0; ai < 2; ++ai)
#pragma unroll
            for (int m = 0; m < 4; ++m) {
                const int row = u.pm * 256 + ai * 128 + wr * 64 + m * 16 + fr; const int pos = row & (SEQ - 1);
#pragma unroll
                for (int bj = 0; bj < 2; ++bj) {
                    f32x4 v0 = acc[ai][bj][m][0], v1 = acc[ai][bj][m][1];
                    if constexpr (F8) { v0 *= FP8_INV; v1 *= FP8_INV; }
                    const int cw = u.pn * 256 + bj * 128 + wc * 32;
                    if (cw < C_AV) {
                        if ((cw & 32) == 0) {
                            f32x4 q0, q1;
#pragma unroll
                            for (int j = 0; j < 4; ++j) { q0[j] = __shfl_xor(v0[j], 16); q1[j] = __shfl_xor(v1[j], 16); }
                            if (fq < 2) {
                                const float4* cs = (const float4*)(ropea + (size_t)pos * 16);
                                const float4 c01 = cs[0], c23 = cs[1], c45 = cs[2], c67 = cs[3];
                                const float co[8] = {c01.x, c01.z, c23.x, c23.z, c45.x, c45.z, c67.x, c67.z}, si[8] = {c01.y, c01.w, c23.y, c23.w, c45.y, c45.w, c67.y, c67.w};
                                if (fq == 0) {
#pragma unroll
                                    for (int j = 0; j < 4; ++j) { v0[j] = v0[j] * co[j] - q0[j] * si[j]; v1[j] = v1[j] * co[4 + j] - q1[j] * si[4 + j]; }
                                } else {
#pragma unroll
                                    for (int j = 0; j < 4; ++j) { v0[j] = v0[j] * co[j] + q0[j] * si[j]; v1[j] = v1[j] * co[4 + j] + q1[j] * si[4 + j]; }
                                }
                            }
                        }
                    } else if (cw >= C_IQ && cw < C_MQ) {
                        if (fq == 0) {
                            const float4* cs = (const float4*)(ropei + (size_t)pos * 8); const float4 c01 = cs[0], c23 = cs[1];
                            const float co[4] = {c01.x, c01.z, c23.x, c23.z}, si[4] = {c01.y, c01.w, c23.y, c23.w};
#pragma unroll
                            for (int j = 0; j < 4; ++j) { const float a = v0[j], b = v1[j]; v0[j] = a * co[j] - b * si[j]; v1[j] = b * co[j] + a * si[j]; }
                        }
                    }
                    u32x4 w; w.x = pk2(v0[0], v0[1]); w.y = pk2(v0[2], v0[3]); w.z = pk2(v1[0], v1[1]); w.w = pk2(v1[2], v1[3]);
                    store16_wt(proj, ((size_t)row * PP + cw + fq * 8) * 2, w);
                }
            }
    }
};

struct EpiResid {
    static constexpr bool PERM = true, AFTER_DRAIN = false;
    const float* x; bf16_t* x1;
    __device__ __forceinline__ void operator()(const f32x4 (&acc)[2][2][4][2], const Unit& u, int wr, int wc, int fr, int fq) const {
#pragma unroll
        for (int ai = 0; ai < 2; ++ai)
#pragma unroll
            for (int m = 0; m < 4; ++m) {
                const int row = u.pm * 256 + ai * 128 + wr * 64 + m * 16 + fr;
#pragma unroll
                for (int bj = 0; bj < 2; ++bj) {
                    const size_t off = (size_t)row * DM + u.pn * 256 + bj * 128 + wc * 32 + fq * 8;
                    const f32x4 a = *(const f32x4*)(x + off), b = *(const f32x4*)(x + off + 4);
                    const f32x4 s0 = a + acc[ai][bj][m][0], s1 = b + acc[ai][bj][m][1];
                    u32x4 w; w.x = pk2(s0[0], s0[1]); w.y = pk2(s0[2], s0[3]); w.z = pk2(s1[0], s1[1]); w.w = pk2(s1[2], s1[3]); store16_wt(x1, off * 2, w);
                }
            }
    }
};

template <bool WT>
struct EpiSwigluT {
    static constexpr bool PERM = true, AFTER_DRAIN = false;
    const float* bgu; bf16_t* act;
    __device__ __forceinline__ void operator()(const f32x4 (&acc)[2][2][4][2], const Unit& u, int wr, int wc, int fr, int fq) const {
        typedef float f32x2 __attribute__((ext_vector_type(2)));
        const int hc = u.pn * 128 + wc * 32 + fq * 8;
        const float* bg = bgu + (size_t)u.ex * 2048 + hc;
        f32x2 bgl[4], bli[4];
#pragma unroll
        for (int j = 0; j < 4; ++j) { bgl[j] = *(const f32x2*)(bg + 2 * j); bli[j] = *(const f32x2*)(bg + 1024 + 2 * j); }
        const float inv = MOE_FP8 ? FP8_INV : 1.0f, xs = MOE_FP8 ? FP8_XS : 1.0f;
#if MOE_FP8
        typedef unsigned u32x2v __attribute__((ext_vector_type(2)));
        const __amdgpu_buffer_rsrc_t arsrc = __builtin_amdgcn_make_buffer_rsrc((void*)act, 0, XROWS * 1024, 0x00020000);
#endif
#pragma unroll
        for (int ai = 0; ai < 2; ++ai)
#pragma unroll
            for (int mp = 0; mp < 2; ++mp) {
                u32x2 w[2];
#pragma unroll
                for (int mm = 0; mm < 2; ++mm) {
                    const int m = 2 * mp + mm; f32x2 o[4];
#pragma unroll
                    for (int j = 0; j < 4; ++j) {
                        const f32x4& ga = acc[ai][0][m][j >> 1]; const f32x4& la = acc[ai][1][m][j >> 1];
                        f32x2 g = (f32x2){ga[2 * (j & 1)], ga[2 * (j & 1) + 1]} * inv + bgl[j];
                        f32x2 l = (f32x2){la[2 * (j & 1)], la[2 * (j & 1) + 1]} * inv + bli[j];
                        g = __builtin_elementwise_min(g, (f32x2){7.0f, 7.0f});
                        l = __builtin_elementwise_min(__builtin_elementwise_max(l, (f32x2){-7.0f, -7.0f}), (f32x2){7.0f, 7.0f});
                        const f32x2 t = g * (-1.702f * 1.4426950408889634f);
                        f32x2 e; e.x = __builtin_amdgcn_exp2f(t.x); e.y = __builtin_amdgcn_exp2f(t.y);
                        const f32x2 d = e + 1.0f; f32x2 r; r.x = __builtin_amdgcn_rcpf(d.x); r.y = __builtin_amdgcn_rcpf(d.y);
                        o[j] = (g * r) * (l * xs + xs);
                    }
#if MOE_FP8
                    w[mm].x = pk4_fp8(o[0].x, o[0].y, o[1].x, o[1].y); w[mm].y = pk4_fp8(o[2].x, o[2].y, o[3].x, o[3].y);
#else
                    { const int row = u.pm * 256 + ai * 128 + wr * 64 + m * 16 + fr; u32x4 ww; ww.x = pk2(o[0].x, o[0].y); ww.y = pk2(o[1].x, o[1].y); ww.z = pk2(o[2].x, o[2].y); ww.w = pk2(o[3].x, o[3].y); *(u32x4*)(act + (size_t)row * 1024 + hc) = ww; }
#endif
                }
#if MOE_FP8
                {
                    const u32x2v lo = __builtin_amdgcn_permlane16_swap(w[0].x, w[1].x, false, false), hi = __builtin_amdgcn_permlane16_swap(w[0].y, w[1].y, false, false);
                    const u32x4 v = {lo[0], hi[0], lo[1], hi[1]};
                    const int row = u.pm * 256 + ai * 128 + wr * 64 + (2 * mp + (fq & 1)) * 16 + fr;
                    __builtin_amdgcn_raw_buffer_store_b128(v, arsrc, (unsigned)(row * 1024 + hc - (fq & 1) * 8), 0, (WT || WT_EPI) ? 16 : 0);
                }
#endif
            }
    }
};

#ifndef Y_FP8
#define Y_FP8 1
#endif
constexpr float FP8_YS = 16.0f;
__device__ __forceinline__ float yq(float v) { return __builtin_amdgcn_fmed3f(v * FP8_YS, -440.0f, 440.0f); }
struct EpiBiasBf16 {
    static constexpr bool PERM = true, AFTER_DRAIN = false;
    const float* bdn; bf16_t* y;
    __device__ __forceinline__ void operator()(const f32x4 (&acc)[2][2][4][2], const Unit& u, int wr, int wc, int fr, int fq) const {
#pragma unroll
        for (int bj = 0; bj < 2; ++bj) {
            const int c8 = u.pn * 256 + bj * 128 + wc * 32 + fq * 8; const float* bb = bdn + (size_t)u.ex * 1024 + c8;
            const f32x4 b0 = *(const f32x4*)bb, b1 = *(const f32x4*)(bb + 4);
#pragma unroll
            for (int ai = 0; ai < 2; ++ai)
#pragma unroll
                for (int m = 0; m < 4; ++m) {
                    const int row = u.pm * 256 + ai * 128 + wr * 64 + m * 16 + fr;
                    const f32x4 v0 = acc[ai][bj][m][0] * (MOE_FP8 ? FP8_INV : 1.0f) + b0, v1 = acc[ai][bj][m][1] * (MOE_FP8 ? FP8_INV : 1.0f) + b1;
#if Y_FP8
                    { u32x2 w; w.x = pk4_fp8(yq(v0[0]), yq(v0[1]), yq(v0[2]), yq(v0[3])); w.y = pk4_fp8(yq(v1[0]), yq(v1[1]), yq(v1[2]), yq(v1[3])); *(u32x2*)((unsigned char*)y + (size_t)row * 1024 + c8) = w; }
#else
                    u32x4 w; w.x = pk2(v0[0], v0[1]); w.y = pk2(v0[2], v0[3]); w.z = pk2(v1[0], v1[1]); w.w = pk2(v1[2], v1[3]);
                    *(u32x4*)(y + (size_t)row * 1024 + c8) = w;
#endif
                }
        }
    }
};

template <class Base> struct OneUnit {
    Base base; int which;
    __device__ __forceinline__ bool next(int i, Unit& u) const { return i == 0 && base.next(which, u); }
    __device__ __forceinline__ void a_ready(const Unit&) const {}
    __device__ __forceinline__ void done(const Unit&) const {}
};
template <int MODE>
struct GroupOrderT {
    const int* tstart; int ncol, G, c, ibeg, iend; unsigned* rdy; int lim;
    __device__ __forceinline__ bool next(int i_, Unit& u) const {
        const int i = i_ + ibeg; if (i >= iend) return false;
        int rt, ct;
        if (G == 256) {
            const int rpx = 32 / ncol, y = c >> 3, x = (MODE == 2) ? 7 - (c & 7) : (c & 7); ct = y % ncol; rt = i * (256 / ncol) + x * rpx + y / ncol;
        } else { const int L = i * G + c; rt = L / ncol; ct = L - rt * ncol; }
        if (rt >= tstart[NEXP]) return false;
        int e = 0;
        while (tstart[e + 1] <= rt) ++e;
        u.pm = rt; u.pn = ct; u.pb = e * ncol + ct; u.ex = e; return true;
    }
    __device__ __forceinline__ void a_ready(const Unit& u) const {
        if (MODE == 2) {
            if (u.pm < lim) return;
            unsigned sp = 0;
            while ((unsigned)__builtin_amdgcn_readfirstlane((int)__hip_atomic_load(rdy + u.pm, __ATOMIC_RELAXED, __HIP_MEMORY_SCOPE_AGENT)) < 64u) { __builtin_amdgcn_s_sleep(1); if (++sp > (1u << 22)) break; }
            asm volatile("buffer_inv sc1" ::: "memory");
        }
    }
    __device__ __forceinline__ void done(const Unit& u) const {
        if (MODE == 1) {
            asm volatile("s_waitcnt vmcnt(0)" ::: "memory");
            if ((tid_opaque() & 63) == 0) __hip_atomic_fetch_add(rdy + u.pm, 1u, __ATOMIC_RELAXED, __HIP_MEMORY_SCOPE_AGENT);
        }
    }
};
typedef GroupOrderT<0> GroupOrder;
__device__ __forceinline__ void proj_small(const Params& p, int blk, unsigned char* lds) {
    const int tid = tid_opaque(), wid = tid >> 6, lane = tid & 63, fr = lane & 15, fq = lane >> 4;
    const int r0 = blk * 64 + (wid & 3) * 16, kh = wid >> 2;
    const bf16_t* ap = p.xn + (size_t)(r0 + fr) * 1024 + kh * 512 + fq * 8;
    const bf16_t* bp0 = p.wt_in + (size_t)(PP + fr) * 1024 + kh * 512 + fq * 8; const bf16_t* bp1 = bp0 + 16 * 1024; const bf16_t* bp2 = bp0 + 32 * 1024;
    f32x4 c0 = {0.f, 0.f, 0.f, 0.f}, c1 = {0.f, 0.f, 0.f, 0.f}, c2 = {0.f, 0.f, 0.f, 0.f};
#pragma unroll 8
    for (int ks = 0; ks < 16; ++ks) {
        const bf16x8 a = *(const bf16x8*)(ap + ks * 32), b0 = *(const bf16x8*)(bp0 + ks * 32), b1 = *(const bf16x8*)(bp1 + ks * 32), b2 = *(const bf16x8*)(bp2 + ks * 32);
        c0 = mfma16(a, b0, c0); c1 = mfma16(a, b1, c1); c2 = mfma16(a, b2, c2);
    }
    f32x4* red = (f32x4*)lds;
    if (kh == 1) { red[((wid & 3) * 3 + 0) * 64 + lane] = c0; red[((wid & 3) * 3 + 1) * 64 + lane] = c1; red[((wid & 3) * 3 + 2) * 64 + lane] = c2; }
    __syncthreads();
    if (kh == 0) {
        c0 += red[((wid & 3) * 3 + 0) * 64 + lane]; c1 += red[((wid & 3) * 3 + 1) * 64 + lane]; c2 += red[((wid & 3) * 3 + 2) * 64 + lane];
        const float idx_w_scale = 0.35355339059327373f * 0.17677669529663687f;
#pragma unroll
        for (int r = 0; r < 4; ++r) {
            const int row = r0 + 4 * fq + r, pos = row & (SEQ - 1); const float own = c0[r], oth = __shfl_xor(own, 4); float v = own;
            if (fr < 8) { const float2 cs = *(const float2*)(p.ropei + ((size_t)pos * 4 + (fr & 3)) * 2); v = (fr < 4) ? own * cs.x - oth * cs.y : own * cs.x + oth * cs.y; }
            p.ikb[(size_t)row * 32 + fr] = f2bf(v); p.ikb[(size_t)row * 32 + 16 + fr] = f2bf(c1[r]);
        }
#pragma unroll
        for (int r = 0; r < 4; ++r) {
            const int row = r0 + 4 * fq + r; const float v = c2[r];
            if (fr < 8) p.iw[(size_t)row * 8 + fr] = v * idx_w_scale;
            else if (fr < 12) p.mi[(size_t)row * 4 + fr - 8] = v + p.igate_b[fr - 8];
            else { const float z = v + p.fgate_b[fr - 12]; p.mf[(size_t)row * 4 + fr - 12] = fminf(z, 0.f) - log1pf(__expf(-fabsf(z))); }
        }
    }
    __syncthreads();
}

__device__ __forceinline__ bf16x8 tr_frag(const bf16_t* T, int ld, int kbase, int c0, int lane) {
    const int q = lane >> 4, qq = (lane & 15) >> 2, pp = lane & 3;
    const v4i16_t t1 = lds_tr16(T + (kbase + 8 * q + qq) * ld + c0 + 4 * pp), t2 = lds_tr16(T + (kbase + 8 * q + 4 + qq) * ld + c0 + 4 * pp);
    return (bf16x8){t1[0], t1[1], t1[2], t1[3], t2[0], t2[1], t2[2], t2[3]};
}
__device__ __forceinline__ void mlstm_local(const Params& p, int item, unsigned char* lds) {
    const int tid = tid_opaque(), wid = tid >> 6, lane = tid & 63, fr = lane & 15, fq = lane >> 4;
    const int bh = item >> 6, c = item & 63, b = bh >> 2, h = bh & 3, t0 = b * SEQ + c * 64;
    bf16_t* kw = (bf16_t*)lds;
    bf16_t* vl = kw + 64 * 136;
    float* wgt = (float*)(lds + 2 * 64 * 136 * 2);
    float* cwl = wgt + 64;
    if (wid == 0) {
        const float lf = p.mf[(size_t)(t0 + lane) * 4 + h], ii = p.mi[(size_t)(t0 + lane) * 4 + h];
        float bs = lf;
#pragma unroll
        for (int d = 1; d < 64; d <<= 1) { const float o = __shfl_up(bs, d); if (lane >= d) bs += o; }
        const float bl = __shfl(bs, 63); const float wl = bl - bs + ii; const float mx = wave_max(wl);
        wgt[lane] = __expf(wl - mx); p.cb[(size_t)(t0 + lane) * 4 + h] = bs;
        if (lane == 0) { p.bl[item] = bl; p.mloc[item] = mx; }
    } else {
        for (int i = tid - 64; i < 1280; i += 448) { const int j = i >> 8, cc = i & 255; const int src = (cc < 128 ? h * 128 + cc : 512 + h * 128 + cc - 128);
            cwl[i] = (j < 4) ? p.conv_w[j * 1024 + src] : p.conv_b[src]; }
    }
    __syncthreads();
    {
        const int tok = tid >> 3, d0 = (tid & 7) * 16, pos = c * 64 + tok; float aq[16], ak[16];
#pragma unroll
        for (int i = 0; i < 16; ++i) { aq[i] = cwl[1024 + d0 + i]; ak[i] = cwl[1024 + 128 + d0 + i]; }
#pragma unroll
        for (int j = 0; j < 4; ++j) {
            const int pp = pos - 3 + j;
            if (pp >= 0) {
                const bf16_t* rq = p.proj + (size_t)(b * SEQ + pp) * PP + C_MQ + h * 128 + d0; const bf16_t* rk = p.proj + (size_t)(b * SEQ + pp) * PP + C_MK + h * 128 + d0;
                float xq[16], xk[16]; unpack8(*(const u32x4*)rq, xq); unpack8(*(const u32x4*)(rq + 8), xq + 8); unpack8(*(const u32x4*)rk, xk); unpack8(*(const u32x4*)(rk + 8), xk + 8);
                const float* wq = cwl + j * 256 + d0; const float* wk = wq + 128;
#pragma unroll
                for (int i = 0; i < 16; ++i) { aq[i] += wq[i] * xq[i]; ak[i] += wk[i] * xk[i]; }
            }
        }
        const float wt = wgt[tok]; const float ksc = 0.08838834764831845f;
        const bf16_t* rv = p.proj + (size_t)(t0 + tok) * PP + C_MV + h * 128 + d0; const u32x4 v0 = *(const u32x4*)rv, v1 = *(const u32x4*)(rv + 8);
#pragma unroll
        for (int i = 0; i < 16; ++i) { aq[i] = aq[i] * sigmoidf_(aq[i]); ak[i] = ak[i] * sigmoidf_(ak[i]) * ksc; }
        bf16_t* oq = p.cq + (size_t)(t0 + tok) * 512 + h * 128 + d0; bf16_t* ok = p.ck + (size_t)(t0 + tok) * 512 + h * 128 + d0;
        *(u32x4*)oq = pack8(aq); *(u32x4*)(oq + 8) = pack8(aq + 8); *(u32x4*)ok = pack8(ak); *(u32x4*)(ok + 8) = pack8(ak + 8);
#pragma unroll
        for (int i = 0; i < 16; ++i) ak[i] *= wt;
        *(u32x4*)(kw + tok * 136 + d0) = pack8(ak); *(u32x4*)(kw + tok * 136 + d0 + 8) = pack8(ak + 8);
        *(u32x4*)(vl + tok * 136 + d0) = v0; *(u32x4*)(vl + tok * 136 + d0 + 8) = v1;
    }
    __syncthreads();
    {
        bf16x8 a[2];
#pragma unroll
        for (int ks = 0; ks < 2; ++ks) a[ks] = tr_frag(vl, 136, 32 * ks, 16 * wid, lane);
#pragma unroll
        for (int db = 0; db < 8; ++db) {
            f32x4 acc = {0.f, 0.f, 0.f, 0.f};
#pragma unroll
            for (int ks = 0; ks < 2; ++ks) { const bf16x8 bb = tr_frag(kw, 136, 32 * ks, 16 * db, lane); acc = mfma16(bb, a[ks], acc); }
            { u32x2 w; w.x = pk2c(acc[0], acc[1]); w.y = pk2c(acc[2], acc[3]); *(u32x2*)(p.ut + ((size_t)item * 128 + 16 * wid + fr) * 128 + 16 * db + 4 * fq) = w; }
        }
    }
    if (tid < 128) { float s = 0.f;
#pragma unroll 8
        for (int i = 0; i < 64; ++i) s += bf2f(kw[i * 136 + tid]);
        p.nu[(size_t)item * 128 + tid] = s; }
    __syncthreads();
}

__device__ __forceinline__ int slotpos(int key) { const int x = key & 15; return (key & 48) | (8 * ((x >> 2) & 1) + 4 * (x >> 3) + (x & 3)); }
__device__ __forceinline__ void vtrans(const Params& p, int item, unsigned char* lds) {
    const int tid = tid_opaque(), wid = tid >> 6, lane = tid & 63;
    const int bg = item >> 6, c = item & 63, b = bg >> 1, g = bg & 1;
    bf16_t* tl = (bf16_t*)lds;
    { const int key = lane, d8 = wid * 8; float v[8]; unpack8(*(const u32x4*)(p.proj + (size_t)(b * SEQ + c * 64 + key) * PP + C_AV + g * 64 + d8), v); const int sp = slotpos(key);
#pragma unroll
      for (int i = 0; i < 8; ++i) tl[(d8 + i) * 72 + sp] = f2bf(v[i]); }
    __syncthreads();
    { const int d = tid >> 3, ch = tid & 7; *(u32x4*)(p.vt + ((size_t)(bg * 64 + d)) * SEQ + c * 64 + ch * 8) = *(const u32x4*)(tl + d * 72 + ch * 8); }
    __syncthreads();
}

__device__ __forceinline__ void lds_add_u32(unsigned* p, unsigned v) { (void)__hip_atomic_fetch_add((__attribute__((address_space(3))) unsigned*)p, v, __ATOMIC_RELAXED, __HIP_MEMORY_SCOPE_WORKGROUP); }
__device__ __forceinline__ void lds_or_u32(unsigned* p, unsigned v) { (void)__hip_atomic_fetch_or((__attribute__((address_space(3))) unsigned*)p, v, __ATOMIC_RELAXED, __HIP_MEMORY_SCOPE_WORKGROUP); }
struct TopkPre { bf16x8 afr[2][2]; float wv[2][2][4]; bf16x8 bfr[4]; };
__device__ __forceinline__ void topk_prefetch(const Params& p, int j, TopkPre& q, int wid, int fr, int fq) {
    const int k = j >> 8, w = j & 255; const int cc = (w & 7) * 4 + (k & 3); const int c = (k < 4) ? cc : 63 - cc; const int b = (w >> 3) & 3, sub = w >> 5;
    const int t0 = b * SEQ + c * 64 + sub * 8, nkb = 4 * (c + 1);
#pragma unroll
    for (int pr = 0; pr < 2; ++pr)
#pragma unroll
        for (int hf = 0; hf < 2; ++hf) {
            const int tok = 4 * pr + (fr >> 2), head = 4 * hf + (fr & 3);
            q.afr[pr][hf] = *(const bf16x8*)(p.proj + (size_t)(t0 + tok) * PP + C_IQ + head * 32 + fq * 8);
            const f32x4 w4 = *(const f32x4*)(p.iw + (size_t)(t0 + 4 * pr + fq) * 8 + 4 * hf);
#pragma unroll
            for (int r = 0; r < 4; ++r) q.wv[pr][hf][r] = w4[r];
        }
    const bf16_t* kbp = p.ikb + (size_t)(b * SEQ + fr) * 32 + fq * 8; const int kb = (wid * 4 < nkb) ? wid * 4 : 0;
#pragma unroll
    for (int u = 0; u < 4; ++u) q.bfr[u] = *(const bf16x8*)(kbp + (size_t)(kb + u) * 16 * 32);
}
#ifndef CONV_IN_TOPK
#define CONV_IN_TOPK 1
#endif
__device__ __forceinline__ void idx_topk(const Params& p, int j, unsigned char* lds, const TopkPre& pc, TopkPre& pn, int jnext, bool has_next, bool do_b, int& qi) {
    const int tid = tid_opaque(), wid = tid >> 6, lane = tid & 63, fr = lane & 15, fq = lane >> 4;
    const int k = j >> 8, w = j & 255; const int cc = (w & 7) * 4 + (k & 3); const int c = (k < 4) ? cc : 63 - cc; const int b = (w >> 3) & 3, sub = w >> 5;
    const int t0 = b * SEQ + c * 64 + sub * 8; const int nj = c + 1, nkb = 4 * nj;
    constexpr int SCP = 4096 + 16;
    float* sc = (float*)lds;
    unsigned* hist = (unsigned*)(lds + 8 * SCP * 4) + wid * 512;
    unsigned* wsel = (unsigned*)(lds + 8 * SCP * 4 + 16384) + wid * 128;
    float* cval = (float*)(lds + 8 * SCP * 4 + 16384 + 4096) + wid * 64;
    int* cidx = (int*)(lds + 8 * SCP * 4 + 16384 + 4096 + 2048) + wid * 64;
    float* pm = (float*)(lds + 8 * SCP * 4 + 16384 + 4096 + 4096);
    {
        const bf16x8 (&afr)[2][2] = pc.afr; const float (&wv)[2][2][4] = pc.wv;
        float mn[2] = {INFINITY, INFINITY}, mx[2] = {-INFINITY, -INFINITY};
        const bf16_t* kbp = p.ikb + (size_t)(b * SEQ + fr) * 32 + fq * 8;
        bf16x8 bfr[4], nfr[4];
#pragma unroll
        for (int u = 0; u < 4; ++u) bfr[u] = pc.bfr[u];
        for (int kb0 = wid * 4; kb0 < nkb; kb0 += 32) {
            const int kn = (kb0 + 32 < nkb) ? kb0 + 32 : kb0;
#pragma unroll
            for (int u = 0; u < 4; ++u) nfr[u] = *(const bf16x8*)(kbp + (size_t)(kn + u) * 16 * 32);
#pragma unroll
            for (int u = 0; u < 4; ++u)
#pragma unroll
                for (int pr = 0; pr < 2; ++pr) {
                    f32x4 c0 = {0.f, 0.f, 0.f, 0.f}, c1 = {0.f, 0.f, 0.f, 0.f};
                    c0 = mfma16(afr[pr][0], bfr[u], c0); c1 = mfma16(afr[pr][1], bfr[u], c1);
                    float s = wv[pr][0][0] * fmaxf(c0[0], 0.f); s += wv[pr][0][1] * fmaxf(c0[1], 0.f); s += wv[pr][0][2] * fmaxf(c0[2], 0.f); s += wv[pr][0][3] * fmaxf(c0[3], 0.f);
                    s += wv[pr][1][0] * fmaxf(c1[0], 0.f); s += wv[pr][1][1] * fmaxf(c1[1], 0.f); s += wv[pr][1][2] * fmaxf(c1[2], 0.f); s += wv[pr][1][3] * fmaxf(c1[3], 0.f);
                    s += 0.0f;
                    sc[(4 * pr + fq) * SCP + (kb0 + u) * 16 + fr] = s; mn[pr] = fminf(mn[pr], s); mx[pr] = fmaxf(mx[pr], s);
                }
#pragma unroll
            for (int u = 0; u < 4; ++u) bfr[u] = nfr[u];
        }
#pragma unroll
        for (int pr = 0; pr < 2; ++pr) {
#pragma unroll
            for (int o = 1; o < 16; o <<= 1) { mn[pr] = fminf(mn[pr], __shfl_xor(mn[pr], o)); mx[pr] = fmaxf(mx[pr], __shfl_xor(mx[pr], o)); }
            if (fr == 0) { pm[(wid * 8 + 4 * pr + fq) * 2] = mn[pr]; pm[(wid * 8 + 4 * pr + fq) * 2 + 1] = mx[pr]; }
        }
    }
    __syncthreads();
    constexpr bool PRE_EARLY = !(CONV_IN_TOPK && MOE_FP8) || TK_TILES == 0;
    if (has_next && (PRE_EARLY || !do_b)) topk_prefetch(p, jnext, pn, wid, fr, fq);
#ifndef BREP
#define BREP 1
#endif
    if (do_b) for (int brep_ = 0; brep_ < BREP; ++brep_) {
        const float* row = sc + wid * SCP;
        unsigned long long word = 0ull;
#if CONV_IN_TOPK && MOE_FP8
        f32x4 cv[16]; int cid = -1;
        const int cfirst = blockIdx.x * 8 + __builtin_amdgcn_readfirstlane(wid), cstride = gridDim.x * 8, cn = min((cfirst < NT_W8) ? (NT_W8 - cfirst + cstride - 1) / cstride : 0, TK_TILES);
        qi = __builtin_amdgcn_readfirstlane(qi);
        const int slots = (nj >= 48) ? 3 : (nj >= 24) ? 2 : (nj >= 8) ? 1 : 0;
#define TK_SLOT(more) do { if (cid >= 0) { wt8_store(p, cid, lane, cv); cid = -1; } if ((more) && qi < cn) { cid = cfirst + qi * cstride; ++qi; wt8_load(p, cid, lane, cv); } } while (0)
#else
#define TK_SLOT(more) do { } while (0)
#endif
        if (nj <= 4) { if (lane < nj) word = ~0ull; }
        else {
            float lo = INFINITY, hi = -INFINITY;
#pragma unroll
            for (int i = 0; i < 8; ++i) { lo = fminf(lo, pm[(i * 8 + wid) * 2]); hi = fmaxf(hi, pm[(i * 8 + wid) * 2 + 1]); }
            int need = 256; wsel[lane * 2] = 0u; wsel[lane * 2 + 1] = 0u;
            TK_SLOT(slots >= 1);
            auto level_body = [&](auto first_) -> bool {
                constexpr bool FIRST = decltype(first_)::value;
                if (!(hi > lo)) {
                    for (int jj = 0; jj < nj; ++jj) {
                        const float s = row[jj * 64 + lane]; const unsigned long long em = __ballot(s >= lo && s <= hi);
                        const int ce = __popcll(em); unsigned long long take = em;
                        if (ce > need) { const int rank = __popcll(em & ((1ull << lane) - 1ull)); take = __ballot(((em >> lane) & 1ull) && rank < need); }
                        need -= (ce > need) ? need : ce;
                        if (lane == jj) word |= take;
                    }
                    return true;
                }
                const float scale = 1023.5f / (hi - lo);
#pragma unroll
                for (int i = 0; i < 8; ++i) hist[lane * 8 + i] = 0u;
                asm volatile("s_waitcnt lgkmcnt(0)" ::: "memory");
#pragma unroll 8
                for (int jj = 0; jj < nj; ++jj) {
                    const float s = row[jj * 64 + lane]; const bool part = (s >= lo) && (s <= hi);
                    const unsigned bn = (unsigned)fminf(fmaxf(s - lo, 0.f) * scale, 1023.0f);
                    if (part) lds_add_u32(&hist[bn >> 1], 1u << (16 * (bn & 1u)));
                }
                asm volatile("s_waitcnt lgkmcnt(0)" ::: "memory");
                if constexpr (FIRST) TK_SLOT(slots >= 2);
                unsigned cw[8]; int cl = 0;
#pragma unroll
                for (int i = 0; i < 8; ++i) { cw[i] = hist[lane * 8 + i]; cl += (int)(cw[i] & 0xffffu) + (int)(cw[i] >> 16); }
                int inc = cl;
#pragma unroll
                for (int d = 1; d < 64; d <<= 1) { const int o = __shfl_down(inc, d); if (lane + d < 64) inc += o; }
                const unsigned long long okm = __ballot(inc >= need);
                const int L = 63 - __builtin_clzll(okm);
                int bstar_v = 0, above_v = 0;
                { int run = inc - cl; bool found = false;
#pragma unroll
                  for (int bq = 15; bq >= 0; --bq) { const int cnt = (int)((cw[bq >> 1] >> (16 * (bq & 1))) & 0xffffu); if (!found && run + cnt >= need) { found = true; bstar_v = lane * 16 + bq; above_v = run; } run += cnt; } }
                const unsigned bstar = (unsigned)__shfl(bstar_v, L); const int above = __shfl(above_v, L);
                need -= above;
                int base = 0; float cmn = INFINITY, cmx = -INFINITY;
#pragma unroll 4
                for (int jj = 0; jj < nj; ++jj) {
                    const float s = row[jj * 64 + lane]; const bool part = (s >= lo) && (s <= hi);
                    const unsigned bn = (unsigned)fminf(fmaxf(s - lo, 0.f) * scale, 1023.0f);
                    const bool gt = part && bn > bstar, eq = part && bn == bstar;
                    const unsigned long long gm = __ballot(gt), em = __ballot(eq);
                    if (lane == jj) word |= gm;
                    if (em) {
                        const int pos = base + (int)__builtin_amdgcn_mbcnt_hi((unsigned)(em >> 32), __builtin_amdgcn_mbcnt_lo((unsigned)em, 0u));
                        if (eq) { cmn = fminf(cmn, s); cmx = fmaxf(cmx, s); if (pos < 64) { cval[pos] = s; cidx[pos] = jj * 64 + lane; } }
                        base += __popcll(em);
                    }
                }
                if constexpr (FIRST) TK_SLOT(slots >= 3);
                if (base <= 64) {
                    asm volatile("s_waitcnt lgkmcnt(0)" ::: "memory");
                    if (lane < base) {
                        const float v = cval[lane]; const int id = cidx[lane]; int rank = 0;
                        for (int q = 0; q < base; ++q) { const float ov = cval[q]; rank += (ov > v || (ov == v && q < lane)) ? 1 : 0; }
                        if (rank < need) lds_or_u32(&wsel[(id >> 6) * 2 + ((id >> 5) & 1)], 1u << (id & 31));
                    }
                    asm volatile("s_waitcnt lgkmcnt(0)" ::: "memory");
                    word |= ((unsigned long long)wsel[lane * 2 + 1] << 32) | (unsigned long long)wsel[lane * 2];
                    return true;
                }
#pragma unroll
                for (int o = 32; o > 0; o >>= 1) { cmn = fminf(cmn, __shfl_xor(cmn, o)); cmx = fmaxf(cmx, __shfl_xor(cmx, o)); }
                lo = cmn; hi = cmx; return false;
            };
            if (!level_body(std::integral_constant<bool, true>{})) for (int level = 1; level < 16; ++level) if (level_body(std::integral_constant<bool, false>{})) break;
        }
#if CONV_IN_TOPK && MOE_FP8
        if (!PRE_EARLY && has_next && brep_ == BREP - 1) topk_prefetch(p, jnext, pn, wid, fr, fq);
#endif
        TK_SLOT(false);
        if (lane < nj) p.mask[(size_t)(t0 + wid) * 64 + lane] = word;
#undef TK_SLOT
    }
    __syncthreads();
}

__device__ __forceinline__ void mlstm_scan(const Params& p, int item) {
    const int tid = tid_opaque(), bh = item >> 4, sl = item & 15, idx = sl * 1024 + 2 * tid;
    float C0 = 0.f, C1 = 0.f, m = 0.f, nn = 0.f; const bool don = (sl == 0 && tid < 128);
    const bf16_t* __restrict__ utp = p.ut + (size_t)bh * 64 * 16384 + idx; bf16_t* __restrict__ csp = p.cst + (size_t)bh * 64 * 16384 + idx;
    for (int c0 = 0; c0 < 64; c0 += 16) {
        unsigned uu[16]; float nu[16];
#pragma unroll
        for (int i = 0; i < 16; ++i) { uu[i] = *(const unsigned*)(utp + (size_t)(c0 + i) * 16384); nu[i] = don ? p.nu[(bh * 64 + c0 + i) * 128 + tid] : 0.f; }
#pragma unroll
        for (int i = 0; i < 16; ++i) {
            const int it = bh * 64 + c0 + i; const float bl = p.bl[it], ml = p.mloc[it];
            *(unsigned*)(csp + (size_t)(c0 + i) * 16384) = pk2(C0, C1);
            if (don) { p.ns[it * 128 + tid] = nn; if (tid == 0) p.ms[it] = m; }
            const float mnew = fmaxf(bl + m, ml); const float dec = __expf(bl + m - mnew), su = __expf(ml - mnew);
            C0 = dec * C0 + su * __uint_as_float(uu[i] << 16); C1 = dec * C1 + su * __uint_as_float(uu[i] & 0xffff0000u); nn = dec * nn + su * nu[i]; m = mnew;
        }
    }
}

typedef __bf16 bf16x2_v __attribute__((ext_vector_type(2)));
__device__ __forceinline__ float dot2_ones(unsigned pair, float acc) { return __builtin_amdgcn_fdot2_f32_bf16(__builtin_bit_cast(bf16x2_v, pair), __builtin_bit_cast(bf16x2_v, 0x3f803f80u), acc, false); }
__device__ __forceinline__ void attn_unit(const Params& p, int b, int g, int c, unsigned char* lds, HostQ& wq) {
    const int tid = tid_opaque(), wid = tid >> 6, lane = tid & 63, r32 = lane & 31, hi = lane >> 5;
    const int hq = g * 4 + (wid & 3), tq = (wid >> 2) * 32 + r32, t0 = b * SEQ + c * 64, trow = t0 + tq;
    bf16_t* ktl = (bf16_t*)lds;
    bf16_t* vtl = ktl + 2 * 64 * 72;
    const float C2 = 0.125f * 1.4426950408889634f;
    bf16x8 qf[4];
#pragma unroll
    for (int ds = 0; ds < 4; ++ds) qf[ds] = *(const bf16x8*)(p.proj + (size_t)trow * PP + C_AQ + hq * 64 + ds * 16 + hi * 8);
    f32x16 o0, o1;
#pragma unroll
    for (int r = 0; r < 16; ++r) { o0[r] = 0.f; o1[r] = 0.f; }
    float m_run = -INFINITY, lsum = 0.f;
    const int ntiles = c + 1, srow = tid >> 3, sch = tid & 7;
    const bf16_t* kbase = p.proj + (size_t)(b * SEQ + srow) * PP + C_AK + g * 64 + sch * 8;
    const bf16_t* vbase = p.vt + ((size_t)((b * 2 + g) * 64 + srow)) * SEQ + sch * 8;
    u32x4 kreg = *(const u32x4*)kbase, vreg = *(const u32x4*)vbase;
    *(u32x4*)(ktl + srow * 72 + sch * 8) = kreg; *(u32x4*)(vtl + srow * 72 + sch * 8) = vreg;
    if (ntiles > 1) { kreg = *(const u32x4*)(kbase + (size_t)64 * PP); *(u32x4*)(ktl + 64 * 72 + srow * 72 + sch * 8) = kreg; }
    __syncthreads();
    const unsigned long long* mrow = p.mask + (size_t)trow * 64;
    unsigned long long W0 = mrow[0], W1 = (ntiles > 1) ? mrow[1] : 0ull;
    f32x16 p0, p1;
#pragma unroll
    for (int r = 0; r < 16; ++r) { p0[r] = 0.f; p1[r] = 0.f; }
#pragma unroll
    for (int ds = 0; ds < 4; ++ds) {
        const bf16x8 a0 = *(const bf16x8*)(ktl + r32 * 72 + ds * 16 + hi * 8), a1 = *(const bf16x8*)(ktl + (r32 + 32) * 72 + ds * 16 + hi * 8);
        p0 = mfma32(a0, qf[ds], p0); p1 = mfma32(a1, qf[ds], p1);
    }
    f32x16 q0, q1;
    f32x4 cv[8]; (void)cv;
    auto step = [&](f32x16& p0, f32x16& p1, f32x16& n0, f32x16& n1, const int tile, auto mode_, const int hid) {
        constexpr int MODE = decltype(mode_)::value;
        const int cur = tile & 1;
        if (tile + 2 < ntiles) kreg = *(const u32x4*)(kbase + (size_t)(tile + 2) * 64 * PP);
        if (tile + 1 < ntiles) vreg = *(const u32x4*)(vbase + (tile + 1) * 64);
        const unsigned long long W = W0; W0 = W1; if (tile + 2 < ntiles) W1 = mrow[tile + 2];
        if constexpr (MODE == 1) wh8_load(p, hid, lane, cv);
        const bf16_t* vt = vtl + cur * 64 * 72;
#pragma unroll
        for (int r = 0; r < 16; ++r) { n0[r] = 0.f; n1[r] = 0.f; }
        if (tile + 1 < ntiles) {
            const bf16_t* kt = ktl + (cur ^ 1) * 64 * 72;
#pragma unroll
            for (int ds = 0; ds < 4; ++ds) {
                const bf16x8 a0 = *(const bf16x8*)(kt + r32 * 72 + ds * 16 + hi * 8), a1 = *(const bf16x8*)(kt + (r32 + 32) * 72 + ds * 16 + hi * 8);
                n0 = mfma32(a0, qf[ds], n0); n1 = mfma32(a1, qf[ds], n1);
            }
        }
#ifdef ATT_X1
        { f32x16 z0, z1;
#pragma unroll
          for (int r = 0; r < 16; ++r) { z0[r] = 0.f; z1[r] = 0.f; }
#pragma unroll
          for (int ds = 0; ds < 4; ++ds) { z0 = mfma32(qf[ds], qf[(ds + 1) & 3], z0); z1 = mfma32(qf[(ds + 2) & 3], qf[ds], z1); }
          asm volatile("" :: "v"(z0), "v"(z1)); }
#endif
#ifdef ATT_X2
        { float d0 = p0[0], d1 = p1[0];
#pragma unroll
          for (int r = 0; r < 32; ++r) { asm volatile("v_max_f32_e32 %0, %0, %1" : "+v"(d0) : "v"(p0[r & 15])); asm volatile("v_add_f32_e32 %0, %0, %1" : "+v"(d1) : "v"(p1[r & 15])); }
          asm volatile("" :: "v"(d0), "v"(d1)); }
#endif
        const unsigned wlo = (unsigned)W >> (4 * hi), whi = (unsigned)(W >> 32) >> (4 * hi);
        float mx = -INFINITY;
#pragma unroll
        for (int r = 0; r < 16; ++r) { const int kl = (r & 3) + 8 * (r >> 2);
            const unsigned m0 = (unsigned)__builtin_amdgcn_sbfe((int)wlo, kl, 1), m1 = (unsigned)__builtin_amdgcn_sbfe((int)whi, kl, 1);
            p0[r] = __uint_as_float((m0 & __float_as_uint(p0[r])) | (~m0 & 0xff800000u)); p1[r] = __uint_as_float((m1 & __float_as_uint(p1[r])) | (~m1 & 0xff800000u));
            asm("v_max3_f32 %0, %0, %1, %2" : "+v"(mx) : "v"(p0[r]), "v"(p1[r])); }
        mx = fmaxf(mx, __shfl_xor(mx, 32));
        const float mnew = fmaxf(m_run, mx); const float muse = (mnew == -INFINITY) ? 0.f : mnew;
        const float alpha = __builtin_amdgcn_exp2f((m_run - muse) * C2); m_run = mnew;
        const float ms = muse * C2; float ps = 0.f;
#pragma unroll
        for (int r = 0; r < 16; ++r) { p0[r] = __builtin_amdgcn_exp2f(p0[r] * C2 - ms); p1[r] = __builtin_amdgcn_exp2f(p1[r] * C2 - ms); ps += p0[r] + p1[r]; }
        if (__any(alpha != 1.0f)) {
#pragma unroll
            for (int r = 0; r < 16; ++r) { o0[r] *= alpha; o1[r] *= alpha; }
        }
#pragma unroll
        for (int ks = 0; ks < 4; ++ks) {
            u32x4 bw;
            if (ks == 0) { bw.x = pk2(p0[0], p0[1]); bw.y = pk2(p0[2], p0[3]); bw.z = pk2(p0[4], p0[5]); bw.w = pk2(p0[6], p0[7]); }
            else if (ks == 1) { bw.x = pk2(p0[8], p0[9]); bw.y = pk2(p0[10], p0[11]); bw.z = pk2(p0[12], p0[13]); bw.w = pk2(p0[14], p0[15]); }
            else if (ks == 2) { bw.x = pk2(p1[0], p1[1]); bw.y = pk2(p1[2], p1[3]); bw.z = pk2(p1[4], p1[5]); bw.w = pk2(p1[6], p1[7]); }
            else { bw.x = pk2(p1[8], p1[9]); bw.y = pk2(p1[10], p1[11]); bw.z = pk2(p1[12], p1[13]); bw.w = pk2(p1[14], p1[15]); }
            const bf16x8 bfrag = __builtin_bit_cast(bf16x8, bw);
            const bf16x8 a0 = *(const bf16x8*)(vt + r32 * 72 + ks * 16 + hi * 8), a1 = *(const bf16x8*)(vt + (r32 + 32) * 72 + ks * 16 + hi * 8);
            o0 = mfma32(a0, bfrag, o0); o1 = mfma32(a1, bfrag, o1);
        }
        lsum = lsum * alpha + ps;
        if constexpr (MODE == 2) { if (hid >= 0) wh8_store(p, hid, lane, cv); }
        if (tile + 2 < ntiles) *(u32x4*)(ktl + cur * 64 * 72 + srow * 72 + sch * 8) = kreg;
        if (tile + 1 < ntiles) *(u32x4*)(vtl + (cur ^ 1) * 64 * 72 + srow * 72 + sch * 8) = vreg;
        __syncthreads();
    };
    typedef std::integral_constant<int, 0> M0; typedef std::integral_constant<int, 1> M1; typedef std::integral_constant<int, 2> M2;
    for (int tile = 0; tile < ntiles; tile += 2) {
        if (tile + 1 < ntiles) {
            const bool hv = wq.i < wq.n; const int hid = hostq_id(wq, hv ? wq.i : 0); wq.i += hv ? 1 : 0;
            step(p0, p1, q0, q1, tile, M1{}, hid); step(q0, q1, p0, p1, tile + 1, M2{}, hv ? hid : -1);
        } else step(p0, p1, q0, q1, tile, M0{}, 0);
    }
    lsum += __shfl_xor(lsum, 32);
    const float inv = 1.0f / lsum;
    bf16_t* orow = p.mix + (size_t)trow * 1024 + hq * 64;
#pragma unroll
    for (int r4 = 0; r4 < 4; ++r4) {
        const int d = 8 * r4 + 4 * hi; u32x2 w0, w1;
        w0.x = pk2(o0[4 * r4] * inv, o0[4 * r4 + 1] * inv); w0.y = pk2(o0[4 * r4 + 2] * inv, o0[4 * r4 + 3] * inv);
        w1.x = pk2(o1[4 * r4] * inv, o1[4 * r4 + 1] * inv); w1.y = pk2(o1[4 * r4 + 2] * inv, o1[4 * r4 + 3] * inv);
        *(u32x2*)(orow + d) = w0; *(u32x2*)(orow + 32 + d) = w1;
    }
}


template <bool HOST>
__device__ __forceinline__ void mlstm_out(const Params& p, int item, unsigned char* lds, int wtile) {
    const int tid = tid_opaque(), wid = tid >> 6, lane = tid & 63, fr = lane & 15, fq = lane >> 4;
    const int bh = item >> 6, c = item & 63, b = bh >> 2, h = bh & 3, t0 = b * SEQ + c * 64;
    bf16_t* Ql = (bf16_t*)lds;
    bf16_t* Kl = (bf16_t*)(lds + 17408);
    bf16_t* Vl = (bf16_t*)(lds + 34816);
    bf16_t* CT = (bf16_t*)(lds + 53248);
    float* HB = (float*)(lds + 53248);
    bf16_t* SS = (bf16_t*)(lds + 88064);
    float* bsum = (float*)(lds + 97280); float* aa = bsum + 64; float* mt = aa + 64; float* iwt = mt + 64; float* den = iwt + 64; float* nvec = den + 64;
    {
        const int row = tid >> 3, ch = tid & 7;
#pragma unroll
        for (int i = 0; i < 2; ++i) { const int cch = ch + 8 * i;
            *(u32x4*)(Ql + row * 136 + cch * 8) = *(const u32x4*)(p.cq + (size_t)(t0 + row) * 512 + h * 128 + cch * 8);
            *(u32x4*)(Kl + row * 136 + cch * 8) = *(const u32x4*)(p.ck + (size_t)(t0 + row) * 512 + h * 128 + cch * 8); }
#pragma unroll
        for (int i = 0; i < 4; ++i) { const int q = tid + 512 * i, e = q >> 4, cch = q & 15; *(u32x4*)(CT + e * 136 + cch * 8) = *(const u32x4*)(p.cst + (size_t)item * 16384 + e * 128 + cch * 8); }
#pragma unroll
        for (int i = 0; i < 2; ++i) { const int cch = ch + 8 * i; *(u32x4*)(Vl + row * 136 + cch * 8) = *(const u32x4*)(p.proj + (size_t)(t0 + row) * PP + C_MV + h * 128 + cch * 8); }
        if (wid == 0) {
            const float bs = p.cb[(size_t)(t0 + lane) * 4 + h], ii = p.mi[(size_t)(t0 + lane) * 4 + h]; const float a = ii - bs; float pm = a;
#pragma unroll
            for (int d = 1; d < 64; d <<= 1) { const float o = __shfl_up(pm, d); if (lane >= d) pm = fmaxf(pm, o); }
            const float mprev = p.ms[item]; const float mtv = bs + fmaxf(mprev, pm);
            bsum[lane] = bs; aa[lane] = a; mt[lane] = mtv; iwt[lane] = __expf(bs + mprev - mtv);
        } else if (wid <= 2) { nvec[tid - 64] = p.ns[(size_t)item * 128 + tid - 64]; }
    }
    __syncthreads();
    f32x4 cv[16]; (void)cv;
    if constexpr (HOST) wt8_load(p, wtile, lane, cv);
    const int tb = wid >> 1;
    {
#pragma unroll
        for (int sbi = 0; sbi < 2; ++sbi) {
            const int sb = (wid & 1) * 2 + sbi; f32x4 acc = {0.f, 0.f, 0.f, 0.f};
#pragma unroll
            for (int ks = 0; ks < 4; ++ks) { const bf16x8 a = *(const bf16x8*)(Ql + (16 * tb + fr) * 136 + ks * 32 + fq * 8), bb = *(const bf16x8*)(Kl + (16 * sb + fr) * 136 + ks * 32 + fq * 8); acc = mfma16(a, bb, acc); }
            const int s = 16 * sb + fr; const float as = aa[s];
#pragma unroll
            for (int r = 0; r < 4; ++r) { const int t = 16 * tb + 4 * fq + r; const float v = (s <= t) ? acc[r] * __expf(bsum[t] + as - mt[t]) : 0.f; SS[t * 72 + s] = f2bf(v); }
        }
    }
    __syncthreads();
    if (wid == 0) {
        const int t = lane; float s1 = 0.f, s2 = 0.f;
        for (int s = 0; s < 64; ++s) s1 += bf2f(SS[t * 72 + s]);
        for (int d = 0; d < 128; ++d) s2 += bf2f(Ql[t * 136 + d]) * nvec[d];
        den[t] = s1 + iwt[t] * s2;
    }
    f32x4 num[4];
#pragma unroll
    for (int ebi = 0; ebi < 4; ++ebi) {
        const int eb = (wid & 1) * 4 + ebi; f32x4 a1 = {0.f, 0.f, 0.f, 0.f}, a2 = {0.f, 0.f, 0.f, 0.f};
#pragma unroll
        for (int ks = 0; ks < 2; ++ks) { const bf16x8 a = *(const bf16x8*)(SS + (16 * tb + fr) * 72 + ks * 32 + fq * 8), bb = tr_frag(Vl, 136, 32 * ks, 16 * eb, lane); a1 = mfma16(a, bb, a1); }
#pragma unroll
        for (int ks = 0; ks < 4; ++ks) { const bf16x8 a = *(const bf16x8*)(Ql + (16 * tb + fr) * 136 + ks * 32 + fq * 8), bb = *(const bf16x8*)(CT + (16 * eb + fr) * 136 + ks * 32 + fq * 8); a2 = mfma16(a, bb, a2); }
#pragma unroll
        for (int r = 0; r < 4; ++r) num[ebi][r] = a1[r] + iwt[16 * tb + 4 * fq + r] * a2[r];
    }
    __syncthreads();
#pragma unroll
    for (int ebi = 0; ebi < 4; ++ebi) {
        const int e = 16 * ((wid & 1) * 4 + ebi) + fr;
#pragma unroll
        for (int r = 0; r < 4; ++r) { const int t = 16 * tb + 4 * fq + r; const float dn = fmaxf(fabsf(den[t]), __expf(-mt[t])); HB[t * 132 + e] = num[ebi][r] / dn; }
    }
    __syncthreads();
    if constexpr (HOST) wt8_store(p, wtile, lane, cv);
    {
        const int t = tid >> 3, e16 = (tid & 7) * 16; float hv[16]; float ss = 0.f;
#pragma unroll
        for (int i = 0; i < 16; ++i) { hv[i] = HB[t * 132 + e16 + i]; ss += hv[i] * hv[i]; }
        ss += __shfl_xor(ss, 1); ss += __shfl_xor(ss, 2); ss += __shfl_xor(ss, 4);
        const float rs = 1.0f / sqrtf(ss * (1.0f / 128.0f) + NORM_EPS);
        float mo[16]; const bf16_t* rm = p.proj + (size_t)(t0 + t) * PP + C_MO + h * 128 + e16; unpack8(*(const u32x4*)rm, mo); unpack8(*(const u32x4*)(rm + 8), mo + 8);
        const float* nw = p.mlstm_norm_w + h * 128 + e16; float o[16];
#pragma unroll
        for (int i = 0; i < 16; ++i) o[i] = hv[i] * rs * nw[i] * sigmoidf_(mo[i]);
        { const size_t ob = ((size_t)(t0 + t) * 1024 + 512 + h * 128 + e16) * 2; store16_wt(p.mix, ob, pack8(o)); store16_wt(p.mix, ob + 16, pack8(o + 8)); }
    }
    __syncthreads();
}

__device__ __forceinline__ void compute_tstart(const Params& p, int* ts) {
    if (threadIdx.x == 0) { int a = 0; for (int e = 0; e < NEXP; ++e) { ts[e] = a; a += (p.cnt[e] + 255) >> 8; } ts[NEXP] = a; }
    __syncthreads();
}

__device__ __forceinline__ void scatter_tokens(const Params& p, const int* ts, int t_begin, int t_end, int wid, int lane) {
    constexpr int NTK = 4;
    float4 nw[4];
#pragma unroll
    for (int i = 0; i < 4; ++i) nw[i] = *(const float4*)(p.ffn_norm_w + i * 256 + lane * 4);
    for (int t0 = t_begin + wid; t0 < t_end; t0 += 8 * NTK) {
        int tt[NTK]; float rs[NTK]; u32x2 xa[NTK][4]; size_t dst[NTK][4];
#pragma unroll
        for (int j = 0; j < NTK; ++j) { tt[j] = min(t0 + 8 * j, t_end - 1); rs[j] = p.rsv[tt[j]];
#pragma unroll
            for (int i = 0; i < 4; ++i) xa[j][i] = *(const u32x2*)(p.x1 + (size_t)tt[j] * DM + i * 256 + lane * 4);
#pragma unroll
            for (int k = 0; k < 4; ++k) { const int e = p.tope[tt[j] * 4 + k]; dst[j][k] = (size_t)ts[e] * 256 + p.topp[tt[j] * 4 + k]; } }
#pragma unroll
        for (int j = 0; j < NTK; ++j) {
            if (t0 + 8 * j >= t_end) break;
            u32x2 h[4]; unsigned h8[4];
#pragma unroll
            for (int i = 0; i < 4; ++i) { const float4 w = nw[i];
                const float4 a = make_float4(__uint_as_float(xa[j][i].x << 16), __uint_as_float(xa[j][i].x & 0xffff0000u), __uint_as_float(xa[j][i].y << 16), __uint_as_float(xa[j][i].y & 0xffff0000u));
                h[i].x = pk2(a.x * rs[j] * w.x, a.y * rs[j] * w.y); h[i].y = pk2(a.z * rs[j] * w.z, a.w * rs[j] * w.w);
                h8[i] = pk4_fp8(a.x * rs[j] * w.x * FP8_XS, a.y * rs[j] * w.y * FP8_XS, a.z * rs[j] * w.z * FP8_XS, a.w * rs[j] * w.w * FP8_XS); }
#pragma unroll
            for (int k = 0; k < 4; ++k) {
#if MOE_FP8
#pragma unroll
                for (int i = 0; i < 4; ++i) *(unsigned*)((unsigned char*)p.xbuf + dst[j][k] * DM + i * 256 + lane * 4) = h8[i];
#else
#pragma unroll
                for (int i = 0; i < 4; ++i) *(u32x2*)(p.xbuf + dst[j][k] * DM + i * 256 + lane * 4) = h[i];
#endif
            }
        }
    }
}

__device__ __forceinline__ void router_phase(const Params& p, unsigned char* lds) {
    const int tid = tid_opaque(), wid = tid >> 6, lane = tid & 63, fr = lane & 15, fq = lane >> 4;
    constexpr int RWS = 36;
    float* rw = (float*)lds;
    unsigned char* ex = lds + 1024 * RWS * 4;
    float* lg = (float*)ex;
    float* rsq = lg + 64 * 33;
    int* lcnt = (int*)(rsq + 64); int* lbase = lcnt + 32;
    float* selv = (float*)(lbase + 32);
    int* sele = (int*)(selv + 256);
    int* info = sele + 256;
    float* ginfo = (float*)(info + 512);
    {
        float4 rv[16]; float nv[16];
#pragma unroll
        for (int q = 0; q < 16; ++q) { const int i4 = tid + q * NTHREADS; rv[q] = ((const float4*)p.router_w)[i4]; nv[q] = p.ffn_norm_w[i4 >> 3]; }
#pragma unroll
        for (int q = 0; q < 16; ++q) { const int i4 = tid + q * NTHREADS, d = i4 >> 3, e = (i4 & 7) * 4; *(float4*)(rw + d * RWS + e) = make_float4(rv[q].x * nv[q], rv[q].y * nv[q], rv[q].z * nv[q], rv[q].w * nv[q]); }
    }
    __syncthreads();
    for (int grp = blockIdx.x; grp < T_TOK / 64; grp += gridDim.x) {
        if (tid < 32) lcnt[tid] = 0;
        {
            const int tb = (wid & 3) * 16, half = wid >> 2;
            const bf16_t* xr = p.x1 + ((size_t)grp * 64 + tb + fr) * DM + fq * 8; const float* rwp = rw + (fq * 8) * RWS + half * 16 + fr;
            f32x4 acc = {0.f, 0.f, 0.f, 0.f}; float ssq = 0.f;
#pragma unroll 4
            for (int kk = 0; kk < 32; ++kk) {
                const u32x4 xa = *(const u32x4*)(xr + kk * 32); float a[8]; unpack8(xa, a);
                const float* rr = rwp + kk * 32 * RWS;
#pragma unroll
                for (int j = 0; j < 8; ++j) { ssq += a[j] * a[j]; acc = __builtin_amdgcn_mfma_f32_16x16x4f32(a[j], rr[j * RWS], acc, 0, 0, 0); }
            }
            ssq += __shfl_xor(ssq, 16); ssq += __shfl_xor(ssq, 32);
            if (half == 0 && fq == 0) { const float rs = 1.0f / sqrtf(ssq * (1.0f / DM) + NORM_EPS); rsq[tb + fr] = rs; p.rsv[(size_t)grp * 64 + tb + fr] = rs; }
#pragma unroll
            for (int r = 0; r < 4; ++r) lg[(tb + 4 * fq + r) * 33 + half * 16 + fr] = acc[r];
        }
        __syncthreads();
        for (int rd = 0; rd < 4; ++rd) {
            const int tl = wid * 8 + rd * 2 + (lane >> 5), e = lane & 31; float* l = lg + tl * 33;
            const float v = l[e] * rsq[tl] + p.router_b[e];
            l[e] = v;
            int rank = 0;
#pragma unroll
            for (int o = 0; o < 32; ++o) { const float ov = l[o]; rank += (ov > v || (ov == v && o < e)) ? 1 : 0; }
            if (rank < 4) { selv[tl * 4 + rank] = v; sele[tl * 4 + rank] = e; }
            if (e < 4) {
                const float* sv = selv + tl * 4; const float v0 = sv[0]; const float e1 = __expf(sv[1] - v0), e2 = __expf(sv[2] - v0), e3 = __expf(sv[3] - v0); const float sum = 1.0f + e1 + e2 + e3;
                const float mine = (e == 0 ? 1.0f : e == 1 ? e1 : e == 2 ? e2 : e3) / sum; const int ex_ = sele[tl * 4 + e];
                const int lp = atomicAdd(&lcnt[ex_], 1);
                info[(tl * 4 + e) * 2] = ex_; info[(tl * 4 + e) * 2 + 1] = lp; ginfo[tl * 4 + e] = mine;
            }
        }
        __syncthreads();
        if (tid < 32) lbase[tid] = atomicAdd(&p.cnt[tid], lcnt[tid]);
        __syncthreads();
        if (tid < 256) { const int e = info[tid * 2], lp = info[tid * 2 + 1]; const size_t o = (size_t)grp * 256 + tid; p.tope[o] = e; p.topp[o] = lbase[e] + lp; p.topg[o] = ginfo[tid]; }
        __syncthreads();
    }
    asm volatile("s_waitcnt vmcnt(0)" ::: "memory");
    __syncthreads();
    if (tid == 0) {
        const int mine = (T_TOK / 64 - (int)blockIdx.x + (int)gridDim.x - 1) / (int)gridDim.x;
        __builtin_amdgcn_fence(__ATOMIC_RELEASE, "agent"); asm volatile("s_waitcnt vmcnt(0)" ::: "memory");
        __hip_atomic_fetch_add((unsigned*)&p.cnt[32], (unsigned)mine, __ATOMIC_RELAXED, __HIP_MEMORY_SCOPE_AGENT);
        unsigned sp = 0;
        while (__hip_atomic_load((unsigned*)&p.cnt[32], __ATOMIC_RELAXED, __HIP_MEMORY_SCOPE_AGENT) < (unsigned)(T_TOK / 64)) { __builtin_amdgcn_s_sleep(2); if (++sp > (1u << 22)) break; }
        __builtin_amdgcn_fence(__ATOMIC_ACQUIRE, "agent"); asm volatile("s_waitcnt vmcnt(0)" ::: "memory");
    }
    __syncthreads();
    int* ts = (int*)lds;
    compute_tstart(p, ts);
    for (int grp = blockIdx.x; grp < T_TOK / 64; grp += gridDim.x) scatter_tokens(p, ts, grp * 64, grp * 64 + 64, wid, lane);
}

__device__ __forceinline__ void combine_phase(const Params& p, unsigned char* lds) {
    const int tid = tid_opaque(), wid = tid >> 6, lane = tid & 63; int* ts = (int*)lds;
    compute_tstart(p, ts);
    const unsigned char* Y = (const unsigned char*)p.ybuf;
    constexpr int NTK = 4;
    const int tstride = gridDim.x * 8;
    for (int t0 = blockIdx.x * 8 + wid; t0 < T_TOK; t0 += tstride * NTK) {
        int tt[NTK]; size_t src[NTK][4]; float gs[NTK][4];
#pragma unroll
        for (int j = 0; j < NTK; ++j) { tt[j] = min(t0 + j * tstride, T_TOK - 1);
#pragma unroll
            for (int k = 0; k < 4; ++k) { const int e = p.tope[tt[j] * 4 + k]; src[j][k] = (size_t)ts[e] * 256 + p.topp[tt[j] * 4 + k]; gs[j][k] = p.topg[tt[j] * 4 + k] * (Y_FP8 ? 1.0f / FP8_YS : 1.0f); } }
        u32x2 xa[NTK][4];
#if Y_FP8
        unsigned yw[NTK][4][4];
#else
        u32x2 yw[NTK][4][4];
#endif
#pragma unroll
        for (int j = 0; j < NTK; ++j) {
#pragma unroll
            for (int i = 0; i < 4; ++i) xa[j][i] = *(const u32x2*)(p.x1 + (size_t)tt[j] * DM + i * 256 + lane * 4);
#pragma unroll
            for (int k = 0; k < 4; ++k)
#pragma unroll
                for (int i = 0; i < 4; ++i) {
#if Y_FP8
                    yw[j][k][i] = __builtin_nontemporal_load((const unsigned*)(Y + src[j][k] * DM + i * 256 + lane * 4));
#else
                    yw[j][k][i] = __builtin_nontemporal_load((const u32x2*)(Y + (src[j][k] * DM + i * 256 + lane * 4) * 2));
#endif
                }
        }
#pragma unroll
        for (int j = 0; j < NTK; ++j) {
            float v[16];
#pragma unroll
            for (int i = 0; i < 4; ++i) { v[4 * i] = __uint_as_float(xa[j][i].x << 16); v[4 * i + 1] = __uint_as_float(xa[j][i].x & 0xffff0000u); v[4 * i + 2] = __uint_as_float(xa[j][i].y << 16); v[4 * i + 3] = __uint_as_float(xa[j][i].y & 0xffff0000u); }
#pragma unroll
            for (int k = 0; k < 4; ++k)
#pragma unroll
                for (int i = 0; i < 4; ++i) {
#if Y_FP8
                    const int w = (int)yw[j][k][i];
                    v[4 * i] += gs[j][k] * __builtin_amdgcn_cvt_f32_fp8(w, 0); v[4 * i + 1] += gs[j][k] * __builtin_amdgcn_cvt_f32_fp8(w, 1); v[4 * i + 2] += gs[j][k] * __builtin_amdgcn_cvt_f32_fp8(w, 2); v[4 * i + 3] += gs[j][k] * __builtin_amdgcn_cvt_f32_fp8(w, 3);
#else
                    const u32x2 w = yw[j][k][i];
                    v[4 * i] += gs[j][k] * __uint_as_float(w.x << 16); v[4 * i + 1] += gs[j][k] * __uint_as_float(w.x & 0xffff0000u); v[4 * i + 2] += gs[j][k] * __uint_as_float(w.y << 16); v[4 * i + 3] += gs[j][k] * __uint_as_float(w.y & 0xffff0000u);
#endif
                }
            float ss = 0.f;
#pragma unroll
            for (int i = 0; i < 16; ++i) ss += v[i] * v[i];
            ss = wave_sum(ss); const float rs = 1.0f / sqrtf(ss * (1.0f / DM) + NORM_EPS);
            if (t0 + j * tstride < T_TOK) {
#pragma unroll
                for (int i = 0; i < 4; ++i) { const float4 w = *(const float4*)(p.final_norm_w + i * 256 + lane * 4);
                    __builtin_nontemporal_store((f32x4){v[4 * i] * rs * w.x, v[4 * i + 1] * rs * w.y, v[4 * i + 2] * rs * w.z, v[4 * i + 3] * rs * w.w}, (f32x4*)(p.out + (size_t)tt[j] * DM + i * 256 + lane * 4)); }
            }
        }
    }
}

#ifndef MK_SPLIT
#define MK_SPLIT 0
#endif
constexpr int N_PHASES = 11;

__device__ __forceinline__ void run_phase(const Params& p, int ph, unsigned char* lds) {
    typedef __attribute__((address_space(3))) unsigned char* las_ptr;
    const int G = gridDim.x, c = blockIdx.x;
    switch (ph) {
    case 0: phase_prologue(p, lds); break;
    case 1: {
        Gemm g{PROJ_FP8 ? (const bf16_t*)p.xn8 : p.xn, PROJ_FP8 ? (const bf16_t*)p.wt_in8 : p.wt_in, T_TOK, PP, 1024}; pg8::StaticOrder S; S.init(T_TOK, PP, G, c);
        EpiProjT<PROJ_FP8 != 0> E{p.proj, p.ikb, p.iw, p.mi, p.mf, p.ropea, p.ropei, p.igate_b, p.fgate_b};
        const bool conv_first = ((c >> 3) & 1) != 0;
#ifdef PROBE_LOADONLY
        if (conv_first) convert_fp8_loadonly(p);
#endif
        if (conv_first) { if (CONV_WAVES && MOE_FP8 && !CONV_IN_TOPK) convert_fp8_waves(p, 0); convert_streamed(p, lds, 0, streamed_tiles_of_wg()); __syncthreads(); }
        pg8::gemm_phase<EpiProjT<PROJ_FP8 != 0>, pg8::StaticOrder, true, true, PROJ_FP8 != 0>((las_ptr)lds, g, S, E);
        for (int blk = c; blk < T_TOK / 64; blk += G) proj_small(p, blk, lds);
        if (!conv_first) { __syncthreads(); convert_streamed(p, lds, 0, streamed_tiles_of_wg()); if (CONV_WAVES && MOE_FP8 && !CONV_IN_TOPK) convert_fp8_waves(p, 0); }
#ifdef PROBE_LOADONLY
        if (!conv_first) convert_fp8_loadonly(p);
#endif
    } break;
    case 2: {
#ifndef P2A_REP
#define P2A_REP 1
#endif
#ifndef P2C_REP
#define P2C_REP 1
#endif
        for (int r_ = 0; r_ < P2A_REP; ++r_) for (int it = c; it < 1024 + 512; it += G) { if (it < 1024) mlstm_local(p, it, lds); else vtrans(p, it - 1024, lds); }
        for (int r_ = 0; r_ < P2C_REP; ++r_) {
            TopkPre tkc, tkn; const int tid_ = tid_opaque();
            if (c < 2048) topk_prefetch(p, c, tkc, tid_ >> 6, tid_ & 15, (tid_ & 63) >> 4);
            int qi = 0;
            for (int it = c; it < 2048; it += G) { idx_topk(p, it, lds, tkc, tkn, it + G, it + G < 2048, r_ == 0, qi); tkc = tkn; }
#if CONV_IN_TOPK && MOE_FP8
            if (r_ == 0) convert_fp8_rest(p, qi, TK_TILES);
#endif
        }
    } break;
    case 3: {
#ifndef ATTN_UNIT
#define ATTN_UNIT attn_unit
#endif
#ifndef P3A_REP
#define P3A_REP 1
#endif
#ifndef P3B_REP
#define P3B_REP 1
#endif
        for (int r_ = 0; r_ < P3A_REP; ++r_) for (int it = c; it < 256; it += G) mlstm_scan(p, it);
        for (int r_ = 0; r_ < P3B_REP; ++r_) {
            HostQ hq; hq.stride = G * 8; hq.first = c * 8 + __builtin_amdgcn_readfirstlane(tid_opaque() >> 6) + TK_TILES * hq.stride; hq.i = 0;
            hq.n = (CONV_IN_TOPK && MOE_FP8 && hq.first < NT_W8) ? 2 * ((NT_W8 - hq.first + hq.stride - 1) / hq.stride) : 0;
            for (int pi = c; pi < 256; pi += G) { const int b = pi >> 6, g = (pi >> 5) & 1, cp = pi & 31; for (int uu = 0; uu < 2; ++uu) ATTN_UNIT(p, b, g, uu ? cp : 63 - cp, lds, hq); }
            for (; hq.i < hq.n; ++hq.i) { f32x4 v[8]; const int lane_ = tid_opaque() & 63; wh8_load(p, hostq_id(hq, hq.i), lane_, v); wh8_store(p, hostq_id(hq, hq.i), lane_, v); }
        }
    } break;
    case 4: for (int it = c; it < 1024; it += G) mlstm_out<false>(p, it, lds, 0); break;
    case 5: {
        Gemm g{p.mix, p.wt_out, T_TOK, 1024, 1024}; pg8::StaticOrder S; S.init(T_TOK, 1024, G, c);
        EpiResid E{p.x, p.x1};
        pg8::gemm_phase<EpiResid, pg8::StaticOrder, true, true>((las_ptr)lds, g, S, E);
    } break;
    case 6: router_phase(p, lds); break;
    case 7: break;
    case 8: {
        int* ts = (int*)(lds + 131072); compute_tstart(p, ts);
        const int upr = (G == 256) ? 32 : 1, nfull = (G == 256) ? ts[NEXP] / upr : 1 << 20;
        Gemm g{p.xbuf, p.wt_gu, XROWS, 2048, 1024}; GroupOrderT<0> S{ts, 8, G, c, 0, nfull, p.rdy, 0}; EpiSwigluT<false> E{p.b_gu, p.act};
        pg8::gemm_phase<EpiSwigluT<false>, GroupOrderT<0>, true, true, MOE_FP8 != 0>((las_ptr)lds, g, S, E);
    } break;
    case 9: {
        int* ts = (int*)(lds + 131072); compute_tstart(p, ts);
        const int nfull = (G == 256) ? ts[NEXP] / 32 : 1 << 20, lim = (G == 256) ? nfull * 32 : 1 << 30;
        if (G == 256) {
            Gemm g{p.xbuf, p.wt_gu, XROWS, 2048, 1024}; GroupOrderT<1> S{ts, 8, G, c, nfull, 1 << 20, p.rdy, 0}; EpiSwigluT<true> E{p.b_gu, p.act};
            pg8::gemm_phase<EpiSwigluT<true>, GroupOrderT<1>, true, true, MOE_FP8 != 0>((las_ptr)lds, g, S, E);
        }
        Gemm g{p.act, p.wt_dn, XROWS, 1024, 1024}; GroupOrderT<2> S{ts, 4, G, c, 0, 1 << 20, p.rdy, lim}; EpiBiasBf16 E{p.b_dn, p.ybuf};
        pg8::gemm_phase<EpiBiasBf16, GroupOrderT<2>, true, true, MOE_FP8 != 0>((las_ptr)lds, g, S, E);
    } break;
    case 10: combine_phase(p, lds); break;
    }
}

#if MK_SPLIT
template <int PH> __global__ void __launch_bounds__(NTHREADS) fwd_phase_kernel(Params p) {
    extern __shared__ __attribute__((aligned(16))) unsigned char lds[];
    run_phase(p, PH, lds);
}
template <int PH> static void launch_phase(const Params& p, hipStream_t stream) {
    (void)hipFuncSetAttribute((const void*)fwd_phase_kernel<PH>, hipFuncAttributeMaxDynamicSharedMemorySize, LDS_BYTES);
    hipLaunchKernelGGL(fwd_phase_kernel<PH>, dim3(256), dim3(NTHREADS), LDS_BYTES, stream, p);
}
#else
#ifndef REP0
#define REP0 1
#endif
#ifndef REP1
#define REP1 1
#endif
#ifndef REP2
#define REP2 1
#endif
#ifndef REP3
#define REP3 1
#endif
#ifndef REP4
#define REP4 1
#endif
#ifndef REP5
#define REP5 1
#endif
#ifndef REP7
#define REP7 1
#endif
#ifndef REP8
#define REP8 1
#endif
#ifndef REP9
#define REP9 1
#endif
#ifndef REP10
#define REP10 1
#endif
__global__ void __launch_bounds__(NTHREADS) fwd_megakernel(Params p) {
    extern __shared__ __attribute__((aligned(16))) unsigned char lds[];
    cg::grid_group grid = cg::this_grid();
    volatile LAS unsigned* xbst = (volatile LAS unsigned*)(lds + LDS_BYTES - 16);
    if (tid_opaque() == 0) { xbst[0] = 0u; xbst[1] = 0u; }
    if (blockIdx.x == 0) for (int i = tid_opaque(); i < XCD_BAR_WORDS; i += NTHREADS) p.bar[i] = 0u;
    __syncthreads();
#ifdef DBG_PH
#define STAMP(k) do { if (blockIdx.x == 0 && tid_opaque() == 0) ((unsigned long long*)(p.cnt + 64))[k] = __builtin_amdgcn_s_memrealtime(); } while (0)
#else
#define STAMP(k) do { } while (0)
#endif
    STAMP(0); run_phase(p, 0, lds); __syncthreads(); grid.sync(); STAMP(1);
    const XcdBarrier xb = xcd_barrier_post(p.bar, xbst);
#define XSYNC() xcd_barrier(xb)
#define RUN(ph, rep) do { for (int r_ = 0; r_ < (rep); ++r_) { run_phase(p, ph, lds); if (r_ + 1 < (rep)) XSYNC(); } } while (0)
    RUN(1, REP1); XSYNC(); STAMP(2); RUN(2, REP2); XSYNC(); STAMP(3); RUN(3, REP3); XSYNC(); STAMP(4); RUN(4, REP4); XSYNC(); STAMP(5); RUN(5, REP5); XSYNC(); STAMP(6);
    run_phase(p, 6, lds); XSYNC(); STAMP(7); STAMP(8); RUN(8, REP8); XSYNC(); STAMP(9); RUN(9, REP9); XSYNC(); STAMP(10); RUN(10, REP10);
#undef RUN
#undef XSYNC
}
#endif

extern "C" void kernel_launch(void* const* d_in, const int* in_sizes, int n_in, void* d_out, int out_size, void* d_ws, size_t ws_size, hipStream_t stream) {
    (void)in_sizes; (void)n_in; (void)out_size;
    Params p{};
    p.x = (const float*)d_in[0]; p.mix_norm_w = (const float*)d_in[1]; p.w_in = (const float*)d_in[2]; p.conv_w = (const float*)d_in[3]; p.conv_b = (const float*)d_in[4];
    p.igate_b = (const float*)d_in[5]; p.fgate_b = (const float*)d_in[6]; p.mlstm_norm_w = (const float*)d_in[7]; p.w_out = (const float*)d_in[8]; p.ffn_norm_w = (const float*)d_in[9];
    p.router_w = (const float*)d_in[10]; p.router_b = (const float*)d_in[11]; p.w_gu = (const float*)d_in[12]; p.b_gu = (const float*)d_in[13]; p.w_dn = (const float*)d_in[14];
    p.b_dn = (const float*)d_in[15]; p.final_norm_w = (const float*)d_in[16];
    p.out = (float*)d_out;
    size_t off = 0; unsigned char* base = (unsigned char*)d_ws;
    auto take = [&](size_t bytes) { unsigned char* r = base + off; off += (bytes + 255) & ~(size_t)255; return r; };
    p.bar = (unsigned*)take(XCD_BAR_WORDS * 4); p.cnt = (int*)take(1024); p.rdy = (unsigned*)take(RDY_WORDS * 4);
    p.wt_in = (bf16_t*)take((size_t)NPW * 1024 * 2); p.wt_out = (bf16_t*)take((size_t)1024 * 1024 * 2);
    p.wt_gu = (bf16_t*)take((size_t)32 * 2048 * 1024 * (MOE_FP8 ? 1 : 2)); p.wt_dn = (bf16_t*)take((size_t)32 * 1024 * 1024 * (MOE_FP8 ? 1 : 2));
    p.xn = (bf16_t*)take((size_t)T_TOK * 1024 * 2); p.proj = (bf16_t*)take((size_t)T_TOK * PP * 2); p.ikb = (bf16_t*)take((size_t)T_TOK * 32 * 2);
    p.vt = (bf16_t*)take((size_t)4 * 2 * 64 * SEQ * 2); p.cq = (bf16_t*)take((size_t)T_TOK * 512 * 2); p.ck = (bf16_t*)take((size_t)T_TOK * 512 * 2);
    p.cst = (bf16_t*)take((size_t)1024 * 16384 * 2); p.mix = (bf16_t*)take((size_t)T_TOK * 1024 * 2);
    p.xbuf = (bf16_t*)take((size_t)XROWS * 1024 * (MOE_FP8 ? 1 : 2)); p.act = (bf16_t*)take((size_t)XROWS * 1024 * (MOE_FP8 ? 1 : 2));
    p.ybuf = (MOE_FP8 ? (bf16_t*)take((size_t)XROWS * 1024 * 2) : p.xbuf);
    p.xn8 = take((size_t)T_TOK * 1024); p.wt_in8 = take((size_t)PP * 1024);
    p.iw = (float*)take((size_t)T_TOK * 8 * 4); p.mi = (float*)take((size_t)T_TOK * 4 * 4); p.mf = (float*)take((size_t)T_TOK * 4 * 4); p.cb = (float*)take((size_t)T_TOK * 4 * 4);
    p.ropea = (float*)take((size_t)SEQ * 16 * 4); p.ropei = (float*)take((size_t)SEQ * 8 * 4);
    p.ut = (bf16_t*)take((size_t)1024 * 16384 * 2); p.nu = (float*)take((size_t)1024 * 128 * 4); p.bl = (float*)take(1024 * 4); p.mloc = (float*)take(1024 * 4);
    p.ns = (float*)take((size_t)1024 * 128 * 4); p.ms = (float*)take(1024 * 4); p.x1 = (bf16_t*)take((size_t)T_TOK * 1024 * 2); p.topg = (float*)take((size_t)T_TOK * 4 * 4); p.rsv = (float*)take((size_t)T_TOK * 4);
    p.mask = (unsigned long long*)take((size_t)T_TOK * 64 * 8); p.tope = (int*)take((size_t)T_TOK * 4 * 4); p.topp = (int*)take((size_t)T_TOK * 4 * 4);
    if (off > ws_size) { fprintf(stderr, "workspace too small: need %zu have %zu\n", off, ws_size); return; }
#if MK_SPLIT
    launch_phase<0>(p, stream); launch_phase<1>(p, stream); launch_phase<2>(p, stream); launch_phase<3>(p, stream); launch_phase<4>(p, stream); launch_phase<5>(p, stream);
    launch_phase<6>(p, stream); launch_phase<7>(p, stream); launch_phase<8>(p, stream); launch_phase<9>(p, stream); launch_phase<10>(p, stream);
#else
    static int grid_blocks = 0;
    if (!grid_blocks) {
        int dev = 0, cus = 0, per_cu = 0;
        (void)hipGetDevice(&dev); (void)hipDeviceGetAttribute(&cus, hipDeviceAttributeMultiprocessorCount, dev);
        (void)hipFuncSetAttribute((const void*)fwd_megakernel, hipFuncAttributeMaxDynamicSharedMemorySize, LDS_BYTES);
        (void)hipOccupancyMaxActiveBlocksPerMultiprocessor(&per_cu, fwd_megakernel, NTHREADS, LDS_BYTES);
        if (per_cu < 1) fprintf(stderr, "occupancy query returned %d blocks per CU\n", per_cu);
        grid_blocks = cus;
    }
    void* args[] = {&p};
    hipError_t e = hipLaunchCooperativeKernel((void*)fwd_megakernel, dim3(grid_blocks), dim3(NTHREADS), args, LDS_BYTES, stream);
    if (e != hipSuccess) fprintf(stderr, "cooperative launch failed: %s (grid %d)\n", hipGetErrorString(e), grid_blocks);
#endif
}
```

```cpp
#include <hip/hip_runtime.h>
#include <hip/hip_cooperative_groups.h>
#include <cstdio>
#include <cstdint>
namespace cg = cooperative_groups;

__device__ __forceinline__ int tid_opaque() { int t = threadIdx.x; asm volatile("" : "+v"(t)); return t; }
namespace pg8 {
#define PG8_LAS __attribute__((address_space(3)))
typedef unsigned short bf16_t;
typedef short bf16x8 __attribute__((ext_vector_type(8)));
typedef float f32x4 __attribute__((ext_vector_type(4)));
typedef unsigned u32x4 __attribute__((ext_vector_type(4)));
constexpr int BM = 256, BK = 64, HALF = 128, HTB = HALF * BK * 2  , STAGE_BYTES = 8 * HTB, NXCD = 8, WGM = 8;

__host__ __device__ __forceinline__ int lds_byte(int r, int c) { const int st = (r >> 4) * 2 + (c >> 5), rr = r & 15, cc = c & 31, ob = rr * 64 + cc * 2; return st * 1024 + (ob ^ (((ob >> 9) & 1) << 5)); }
__host__ __device__ __forceinline__ void stage_rc(int b, int& R, int& C) { const int st = b / 1024, sb = b % 1024, swz = sb ^ (((sb >> 9) & 1) << 5); R = (st >> 1) * 16 + swz / 64; C = (st & 1) * 32 + (swz % 64) / 2; }
__host__ __device__ __forceinline__ int perm32(int rho) { const int n = rho >> 4, i = rho & 15; return 8 * (i >> 2) + 4 * n + (i & 3); }

struct Unit { int pm, pn, pb, ex; };
struct Gemm { const bf16_t* A; const bf16_t* Bt; int M, N, K; };

struct StaticOrder {
    int nM, nN, nwg, G, c;
    __host__ __device__ void init(int M, int N, int G_, int c_) { nM = M / BM; nN = N / BM; nwg = nM * nN; G = G_; c = c_; }
    __host__ __device__ bool next(int i, Unit& u) const {
        const long L = (long)i * G + c; if (L >= nwg) return false;
        int wgid = (int)L; { const int q = nwg / NXCD, r = nwg % NXCD, xcd = wgid % NXCD, off = wgid / NXCD; wgid = (xcd < r ? xcd * (q + 1) : r * (q + 1) + (xcd - r) * q) + off; }
        const int nig = WGM * nN, gid = wgid / nig, fm = gid * WGM, gsz = (nM - fm) < WGM ? (nM - fm) : WGM;
        u.pm = fm + ((wgid % nig) % gsz); u.pn = (wgid % nig) / gsz; u.pb = u.pn; u.ex = 0; return true;
    }
    __device__ __forceinline__ void a_ready(const Unit&) const {}
    __device__ __forceinline__ void done(const Unit&) const {}
};

__device__ __forceinline__ unsigned cvt_pk_bf16(float lo, float hi) { unsigned r; asm volatile("v_cvt_pk_bf16_f32 %0, %1, %2" : "=v"(r) : "v"(lo), "v"(hi)); return r; }
typedef int i32x8 __attribute__((ext_vector_type(8)));
typedef int i32x4v __attribute__((ext_vector_type(4)));
__device__ __forceinline__ f32x4 mfma_fp8_128(bf16x8 a0, bf16x8 a1, bf16x8 b0, bf16x8 b1, f32x4 c) {
    const i32x4v x0 = __builtin_bit_cast(i32x4v, a0), x1 = __builtin_bit_cast(i32x4v, a1), y0 = __builtin_bit_cast(i32x4v, b0), y1 = __builtin_bit_cast(i32x4v, b1);
    const i32x8 a = {x0[0], x0[1], x0[2], x0[3], x1[0], x1[1], x1[2], x1[3]}, b = {y0[0], y0[1], y0[2], y0[3], y1[0], y1[1], y1[2], y1[3]};
    return __builtin_amdgcn_mfma_scale_f32_16x16x128_f8f6f4(a, b, c, 0, 0, 0, 0x7f7f7f7f, 0, 0x7f7f7f7f);
}
template <class Epi, class Sched, bool ALIGN_EPI = false, bool SP2 = false, bool FP8 = false>
__device__ __forceinline__ void gemm_phase(PG8_LAS unsigned char* lds, const Gemm g, const Sched& S, const Epi& E) {
    const int tid = tid_opaque(), wid = __builtin_amdgcn_readfirstlane(tid >> 6), lane = tid & 63, wr = wid >> 2, wc = wid & 3, fr = lane & 15, fq = lane >> 4;
    const int K = FP8 ? g.K / 2 : g.K, nt = K / BK;
    unsigned voffA[2], voffB[2];
#pragma unroll
    for (int i = 0; i < 2; ++i) { int R, C; stage_rc(tid * 16 + i * 8192, R, C); const int Rb = Epi::PERM ? ((R & ~31) + perm32(R & 31)) : R;
        voffA[i] = (unsigned)(R * K + C) * 2u; voffB[i] = (unsigned)(Rb * K + C) * 2u; }
    const size_t kstep = (size_t)(BK * 2);
    const size_t hstep = (size_t)HALF * K * 2;
    const size_t tstep = 2 * hstep;
    const unsigned pfoff = (unsigned)(tid & 255) * (unsigned)K * 2u;
    const unsigned ldsw = (unsigned)wid * 1024u;
    const int aoff = lds_byte(wr * 64 + fr, fq * 8), boff = lds_byte(wc * 32 + fr, fq * 8);
#define PG8_SA(b, h) (((b) * 2 + (h)) * HTB)
#define PG8_SB(b, h) ((4 + (b) * 2 + (h)) * HTB)
#define PG8_STAGE(bufoff, gbase, voff) do { _Pragma("unroll") for (int _i = 0; _i < 2; ++_i) \
        __builtin_amdgcn_global_load_lds((const unsigned*)((const char*)(gbase) + (voff)[_i]), (PG8_LAS unsigned*)(lds + (bufoff) + ldsw + _i * 8192), 16, 0, 0); } while (0)
#define PG8_LDA(dst, b, h) do { _Pragma("unroll") for (int m = 0; m < 4; ++m) { if constexpr (FP8) { dst##8[m].lo = *(const PG8_LAS i32x4v*)(lds + PG8_SA(b, h) + aoff + m * 2048); dst##8[m].hi = *(const PG8_LAS i32x4v*)(lds + PG8_SA(b, h) + aoff + m * 2048 + 1024); } \
        else { _Pragma("unroll") for (int k = 0; k < 2; ++k) dst[m][k] = *(const PG8_LAS bf16x8*)(lds + PG8_SA(b, h) + aoff + m * 2048 + k * 1024); } } } while (0)
#define PG8_LDB(dst, b, h) do { _Pragma("unroll") for (int n = 0; n < 2; ++n) { if constexpr (FP8) { dst##8[n].lo = *(const PG8_LAS i32x4v*)(lds + PG8_SB(b, h) + boff + n * 2048); dst##8[n].hi = *(const PG8_LAS i32x4v*)(lds + PG8_SB(b, h) + boff + n * 2048 + 1024); } \
        else { _Pragma("unroll") for (int k = 0; k < 2; ++k) dst[n][k] = *(const PG8_LAS bf16x8*)(lds + PG8_SB(b, h) + boff + n * 2048 + k * 1024); } } } while (0)
#define PG8_MMA(ai, bj, At, Bt) do { __builtin_amdgcn_s_setprio(1); _Pragma("unroll") for (int m = 0; m < 4; ++m) _Pragma("unroll") for (int n = 0; n < 2; ++n) _Pragma("unroll") for (int k = 0; k < 2; ++k) \
        { if constexpr (FP8) { if (k == 0) asm volatile("v_mfma_scale_f32_16x16x128_f8f6f4 %0, %1, %2, %0, %3, %3 op_sel_hi:[0,0,0]" : "+v"(acc[ai][bj][m][n]) : "v"(Bt##8[n]), "v"(At##8[m]), "v"(fp8_unit_scale)); } \
          else acc[ai][bj][m][n] = __builtin_amdgcn_mfma_f32_16x16x32_bf16(Bt[n][k], At[m][k], acc[ai][bj][m][n], 0, 0, 0); } __builtin_amdgcn_s_setprio(0); } while (0)
#define PG8_WAIT_V(n) asm volatile("s_waitcnt vmcnt(" #n ")" ::: "memory")
#ifndef PG8_PF
#define PG8_PF 0
#endif
#ifndef PG8_PFD
#define PG8_PFD 4
#endif
#if PG8_PF
#define PG8_WAIT_V8 PG8_WAIT_V(9)
#define PG8_PREFETCH(q_) do { const int q = (q_); const char* pb_ = (q < nt) ? ((wid < 4 ? cA : cB) + (size_t)q * kstep) : ((wid < 4 ? nA : nB) + (size_t)(q - nt) * kstep); \
        __builtin_amdgcn_global_load_lds((const unsigned*)(pb_ + pfoff), (PG8_LAS unsigned*)(lds + STAGE_BYTES + 2048 + wid * 256), 4, 0, 0); } while (0)
#else
#define PG8_WAIT_V8 PG8_WAIT_V(8)
#define PG8_PREFETCH(q_) do { } while (0)
#endif
#define PG8_WAIT_L(n) asm volatile("s_waitcnt lgkmcnt(" #n ")" ::: "memory")
#define PG8_BAR __builtin_amdgcn_s_barrier()
#define PG8_SCHED __builtin_amdgcn_sched_barrier(0)
    Unit cur, nxt; int ui = 0;
    if (!S.next(0, cur)) return;
#ifndef PG8_KROT
#define PG8_KROT 0
#endif
    const int ktm = nt - 1;
#define PG8_ROT(u) (PG8_KROT ? (((u).pn + 2 * (u).pm) & ktm) : 0)
#define PG8_KT(rot, t) ((size_t)(((t) + (rot)) & ktm) * kstep)
    f32x4 acc[2][2][4][2];
#pragma unroll
    for (int a = 0; a < 2; ++a)
#pragma unroll
        for (int b = 0; b < 2; ++b)
#pragma unroll
            for (int m = 0; m < 4; ++m)
#pragma unroll
                for (int n = 0; n < 2; ++n) acc[a][b][m][n] = (f32x4){0.f, 0.f, 0.f, 0.f};
    const int fp8_unit_scale = 0x7f7f7f7f; (void)fp8_unit_scale;
    bf16x8 At[4][2], B0[2][2], B1[2][2]; i32x8 At8[4], B08[2], B18[2];
    const char* cA = (const char*)g.A + (size_t)cur.pm * tstep; const char* cB = (const char*)g.Bt + (size_t)cur.pb * tstep;
    S.a_ready(cur);
    int rot = PG8_ROT(cur);
    if constexpr (SP2) {
        { const size_t k0 = PG8_KT(rot, 0), k1 = PG8_KT(rot, 1);
        PG8_STAGE(PG8_SB(0, 0), cB + k0, voffB); PG8_STAGE(PG8_SB(0, 1), cB + hstep + k0, voffB); PG8_STAGE(PG8_SA(0, 0), cA + k0, voffA); PG8_STAGE(PG8_SA(0, 1), cA + hstep + k0, voffA);
        if (wr == 1) PG8_BAR;
        PG8_WAIT_V(2); PG8_BAR;
        PG8_STAGE(PG8_SB(1, 0), cB + k1, voffB); PG8_STAGE(PG8_SA(1, 0), cA + k1, voffA); PG8_STAGE(PG8_SB(1, 1), cB + hstep + k1, voffB); }
        PG8_WAIT_V(6); PG8_BAR;
    } else {
        const size_t k0 = PG8_KT(rot, 0), k1 = PG8_KT(rot, 1);
        PG8_STAGE(PG8_SB(0, 0), cB + k0, voffB); PG8_STAGE(PG8_SA(0, 0), cA + k0, voffA); PG8_STAGE(PG8_SB(0, 1), cB + hstep + k0, voffB); PG8_STAGE(PG8_SA(0, 1), cA + hstep + k0, voffA);
        if (wr == 1) PG8_BAR;
        PG8_WAIT_V(4); PG8_BAR;
        PG8_STAGE(PG8_SB(1, 0), cB + k1, voffB); PG8_STAGE(PG8_SA(1, 0), cA + k1, voffA); PG8_STAGE(PG8_SB(1, 1), cB + hstep + k1, voffB);
        PG8_WAIT_V(6); PG8_BAR;
    }
    for (;;) {
        const bool has_next = S.next(ui + 1, nxt);
        const char* nA = has_next ? (const char*)g.A + (size_t)nxt.pm * tstep : cA; const char* nB = has_next ? (const char*)g.Bt + (size_t)nxt.pb * tstep : cB;
        const int nrot = has_next ? PG8_ROT(nxt) : rot;
        for (int t = 0; t < nt; t += 2) {
            const bool last = (t == nt - 2);
            const char* a1 = cA + PG8_KT(rot, t + 1);
            const char* a2 = last ? nA + PG8_KT(nrot, 0) : cA + PG8_KT(rot, t + 2); const char* b2 = last ? nB + PG8_KT(nrot, 0) : cB + PG8_KT(rot, t + 2);
            const char* a3 = last ? nA + PG8_KT(nrot, 1) : cA + PG8_KT(rot, t + 3); const char* b3 = last ? nB + PG8_KT(nrot, 1) : cB + PG8_KT(rot, t + 3);
            if (last && has_next) S.a_ready(nxt);
            if constexpr (SP2) {
            PG8_LDB(B0, 0, 0); PG8_LDB(B1, 0, 1); PG8_SCHED; PG8_LDA(At, 0, 0); PG8_STAGE(PG8_SA(1, 1), a1 + hstep, voffA);
            PG8_WAIT_V8; PG8_WAIT_L(0); PG8_BAR; PG8_MMA(0, 0, At, B0); PG8_MMA(0, 1, At, B1); PG8_BAR; PG8_SCHED;
            PG8_LDA(At, 0, 1); PG8_STAGE(PG8_SB(0, 0), b2, voffB); PG8_STAGE(PG8_SB(0, 1), b2 + hstep, voffB); PG8_STAGE(PG8_SA(0, 0), a2, voffA); PG8_PREFETCH(t + PG8_PFD);
            PG8_WAIT_V8; PG8_WAIT_L(0); PG8_BAR; PG8_MMA(1, 0, At, B0); PG8_MMA(1, 1, At, B1); PG8_BAR; PG8_SCHED;
            PG8_LDB(B0, 1, 0); PG8_LDB(B1, 1, 1); PG8_SCHED; PG8_LDA(At, 1, 0); PG8_STAGE(PG8_SA(0, 1), a2 + hstep, voffA);
            PG8_WAIT_V8; PG8_WAIT_L(0); PG8_BAR; PG8_MMA(0, 0, At, B0); PG8_MMA(0, 1, At, B1); PG8_BAR; PG8_SCHED;
            PG8_LDA(At, 1, 1); PG8_STAGE(PG8_SB(1, 0), b3, voffB); PG8_STAGE(PG8_SB(1, 1), b3 + hstep, voffB); PG8_STAGE(PG8_SA(1, 0), a3, voffA); PG8_PREFETCH(t + 1 + PG8_PFD);
            PG8_WAIT_V8; PG8_WAIT_L(0); PG8_BAR; PG8_MMA(1, 0, At, B0); PG8_MMA(1, 1, At, B1); PG8_BAR; PG8_SCHED;
            } else {
            PG8_LDB(B0, 0, 0); PG8_SCHED; PG8_LDA(At, 0, 0); PG8_STAGE(PG8_SA(1, 1), a1 + hstep, voffA);
            PG8_WAIT_L(8); PG8_BAR; PG8_WAIT_L(0); PG8_MMA(0, 0, At, B0); PG8_BAR; PG8_SCHED;
            PG8_LDB(B1, 0, 1); PG8_STAGE(PG8_SB(0, 0), b2, voffB);
            PG8_BAR; PG8_WAIT_L(0); PG8_MMA(0, 1, At, B1); PG8_BAR;
            PG8_LDA(At, 0, 1); PG8_STAGE(PG8_SA(0, 0), a2, voffA);
            PG8_BAR; PG8_WAIT_L(0); PG8_MMA(1, 0, At, B0); PG8_BAR; PG8_SCHED;
            PG8_STAGE(PG8_SB(0, 1), b2 + hstep, voffB);
            PG8_WAIT_V(6); PG8_BAR; PG8_MMA(1, 1, At, B1); PG8_BAR;
            PG8_LDB(B0, 1, 0); PG8_SCHED; PG8_LDA(At, 1, 0); PG8_STAGE(PG8_SA(0, 1), a2 + hstep, voffA);
            PG8_WAIT_L(8); PG8_BAR; PG8_WAIT_L(0); PG8_MMA(0, 0, At, B0); PG8_BAR; PG8_SCHED;
            PG8_LDB(B1, 1, 1); PG8_STAGE(PG8_SB(1, 0), b3, voffB);
            PG8_BAR; PG8_WAIT_L(0); PG8_MMA(0, 1, At, B1); PG8_BAR;
            PG8_LDA(At, 1, 1); PG8_STAGE(PG8_SA(1, 0), a3, voffA);
            PG8_BAR; PG8_WAIT_L(0); PG8_MMA(1, 0, At, B0); PG8_BAR; PG8_SCHED;
            PG8_STAGE(PG8_SB(1, 1), b3 + hstep, voffB);
            PG8_WAIT_V(6); PG8_BAR; PG8_MMA(1, 1, At, B1); PG8_BAR;
            }
        }
        if constexpr (FP8) asm volatile("s_nop 15\n\ts_nop 15" ::: "memory");
        if constexpr (ALIGN_EPI) { if (wr == 0) PG8_BAR; }
        if constexpr (!Epi::AFTER_DRAIN) { E(acc, cur, wr, wc, fr, fq); S.done(cur); }
        if (!has_next) break;
#pragma unroll
        for (int a = 0; a < 2; ++a)
#pragma unroll
            for (int b = 0; b < 2; ++b)
#pragma unroll
                for (int m = 0; m < 4; ++m)
#pragma unroll
                    for (int n = 0; n < 2; ++n) acc[a][b][m][n] = (f32x4){0.f, 0.f, 0.f, 0.f};
        cur = nxt; cA = nA; cB = nB; rot = nrot; ++ui;
        if constexpr (ALIGN_EPI) { if (wr == 1) PG8_BAR; }
    }
    PG8_WAIT_V(0);
    if constexpr (!ALIGN_EPI) { if (wr == 0) PG8_BAR; }
    PG8_BAR;
    if constexpr (Epi::AFTER_DRAIN) { E.fused(acc, cur, wr, wc, fr, fq, lds, wid, lane); S.done(cur); }
#undef PG8_ROT
#undef PG8_KT
#undef PG8_SA
#undef PG8_SB
#undef PG8_STAGE
#undef PG8_LDA
#undef PG8_LDB
#undef PG8_MMA
#undef PG8_WAIT_V
#undef PG8_WAIT_V8
#undef PG8_PREFETCH
#undef PG8_WAIT_L
#undef PG8_BAR
#undef PG8_SCHED
}
}
#include <cstdlib>
#include <vector>

#define XB_TMO      128
#define XB_XCNT(j)  (256  + 64 * (j))
#define XB_XSUB(j)  (1280 + 64 * (j))
#define XB_XGEN(j)  (2304 + 64 * (j))
#define XB_TOP      3328
#define XB_TOPGEN   3392
#define XCD_BAR_WORDS 3456
#define XB_SPIN_CAP (1u << 18)
#define LAS __attribute__((address_space(3)))

__device__ __forceinline__ unsigned xb_ld(unsigned* p)              { return __hip_atomic_load(p, __ATOMIC_RELAXED, __HIP_MEMORY_SCOPE_AGENT); }
__device__ __forceinline__ unsigned xb_add(unsigned* p, unsigned v) { return __hip_atomic_fetch_add(p, v, __ATOMIC_RELAXED, __HIP_MEMORY_SCOPE_AGENT); }
__device__ __forceinline__ unsigned xb_xcc_id() { return (unsigned)__builtin_amdgcn_s_getreg((3 << 11) | 20) & 0xFu; }
#define XB_SPIN(cond, bar) do { unsigned _sp = 0; while (cond) { __builtin_amdgcn_s_sleep(1); \
    if ((++_sp & 255u) == 0u) { if (xb_ld(&(bar)[XB_TMO])) break; if (_sp > XB_SPIN_CAP) { atomicAdd(&(bar)[XB_TMO], 1u); break; } } } } while (0)

struct XcdBarrier {
    unsigned* bar; unsigned x;
    volatile LAS unsigned* st;
};

__device__ __forceinline__ XcdBarrier xcd_barrier_post(unsigned* bar, volatile LAS unsigned* st) {
    XcdBarrier b; b.bar = bar; b.x = xb_xcc_id(); b.st = st;
    if (tid_opaque() == 0) (void)xb_add(&bar[XB_XCNT(b.x)], 1u);
    return b;
}
__device__ __forceinline__ void xcd_barrier_complete(unsigned* bar, unsigned x, unsigned& nloc, unsigned& nx) {
    const unsigned G = gridDim.x * gridDim.y * gridDim.z;
    unsigned sum, cnt, mine, sp = 0u;
    for (;;) {
        sum = 0u; cnt = 0u; mine = 0u;
#pragma unroll
        for (unsigned j = 0; j < 16; ++j) { const unsigned c = xb_ld(&bar[XB_XCNT(j)]); sum += c; cnt += (c > 0u) ? 1u : 0u; mine = (j == x) ? c : mine; }
        if (sum == G) break;
        __builtin_amdgcn_s_sleep(1);
        if ((++sp & 255u) == 0u) { if (xb_ld(&bar[XB_TMO])) break; if (sp > XB_SPIN_CAP) { atomicAdd(&bar[XB_TMO], 1u); break; } }
    }
    nloc = mine > 0u ? mine : 1u; nx = cnt > 0u ? cnt : 1u;
}

__device__ __forceinline__ void xcd_barrier(const XcdBarrier& b) {
    asm volatile("s_waitcnt vmcnt(0)" ::: "memory");
    __syncthreads();
    if (tid_opaque() == 0) {
        unsigned* bar = b.bar;
        __builtin_amdgcn_s_waitcnt(0);
        unsigned nloc = b.st[0], nx = b.st[1];
        if (nloc == 0u) { xcd_barrier_complete(bar, b.x, nloc, nx); b.st[0] = nloc; b.st[1] = nx; }
        const unsigned old = xb_add(&bar[XB_XSUB(b.x)], 1u);
        const unsigned gen = old / nloc;
        if (old + 1u == (gen + 1u) * nloc) {
            __builtin_amdgcn_fence(__ATOMIC_RELEASE, "agent");
            asm volatile("s_waitcnt vmcnt(0)" ::: "memory");
            const unsigned og = xb_add(&bar[XB_TOP], 1u);
            const unsigned tg = og / nx;
            if (og + 1u == (tg + 1u) * nx) xb_add(&bar[XB_TOPGEN], 1u);
            else XB_SPIN(xb_ld(&bar[XB_TOPGEN]) == tg, bar);
            __builtin_amdgcn_fence(__ATOMIC_ACQUIRE, "agent");
            xb_add(&bar[XB_XGEN(b.x)], 1u);
            asm volatile("s_waitcnt vmcnt(0)" ::: "memory");
        } else {
            XB_SPIN(xb_ld(&bar[XB_XGEN(b.x)]) == gen, bar);
            __builtin_amdgcn_fence(__ATOMIC_ACQUIRE, "agent");
            asm volatile("s_waitcnt vmcnt(0)" ::: "memory");
        }
    }
    __syncthreads();
}

using pg8::bf16_t; using pg8::bf16x8; using pg8::f32x4; using pg8::u32x4; using pg8::Unit; using pg8::Gemm;
typedef float f32x16 __attribute__((ext_vector_type(16)));
typedef unsigned u32x2 __attribute__((ext_vector_type(2)));

constexpr int T_TOK = 16384, SEQ = 4096, DM = 1024;
constexpr int NPW = 3328;
constexpr int PW_SRC = 3120;
constexpr int PP = 3072;
constexpr int C_AQ = 0, C_AK = 512, C_AV = 640, C_IQ = 768, C_MQ = 1024, C_MK = 1536, C_MV = 2048, C_MO = 2560;
constexpr int NEXP = 32, XROWS = 65536 + 32 * 256;
constexpr int NTHREADS = 512;
constexpr int LDS_BYTES = 160 * 1024;
constexpr int RDY_WORDS = 320;
constexpr float NORM_EPS = 1e-6f;

struct Params {
    const float *x, *mix_norm_w, *w_in, *conv_w, *conv_b, *igate_b, *fgate_b, *mlstm_norm_w, *w_out, *ffn_norm_w, *router_w, *router_b, *w_gu, *b_gu, *w_dn,
        *b_dn, *final_norm_w;
    float* out;
    bf16_t *wt_in, *wt_out, *wt_gu, *wt_dn, *xn, *proj, *ikb, *vt, *cq, *ck, *cst, *mix, *xbuf, *act, *ybuf;
    float *iw, *mi, *mf, *cb, *ropea, *ropei, *nu, *bl, *mloc, *ns, *ms, *topg, *rsv;
    bf16_t* ut;
    bf16_t* x1;
    unsigned long long* mask;
    int *tope, *topp, *cnt;
    unsigned* bar; unsigned* rdy;
    unsigned char *xn8, *wt_in8;
};

#ifndef MOE_FP8
#define MOE_FP8 1
#endif
#ifndef PROJ_FP8
#define PROJ_FP8 1
#endif
constexpr float FP8_XS = 4.0f, FP8_WS = 64.0f, FP8_INV = 1.0f / (4.0f * 64.0f);
__device__ __forceinline__ unsigned pk4_fp8(float a, float b, float c, float d) { int w = 0; w = __builtin_amdgcn_cvt_pk_fp8_f32(a, b, w, false); w = __builtin_amdgcn_cvt_pk_fp8_f32(c, d, w, true); return (unsigned)w; }
#ifndef WT_EPI
#define WT_EPI 0
#endif
__device__ __forceinline__ void store16_wt(void* base, size_t byte_off, u32x4 v) {
#if WT_EPI
    const __amdgpu_buffer_rsrc_t r = __builtin_amdgcn_make_buffer_rsrc(base, 0, 0x7fffffff, 0x00020000);
    __builtin_amdgcn_raw_buffer_store_b128(v, r, (unsigned)byte_off, 0, 16);
#else
    *(u32x4*)((unsigned char*)base + byte_off) = v;
#endif
}
__device__ __forceinline__ float bf2f(unsigned short h) { return __uint_as_float(((unsigned)h) << 16); }
__device__ __forceinline__ unsigned pk2(float lo, float hi) { typedef float f2_ __attribute__((ext_vector_type(2))); typedef __bf16 b2_ __attribute__((ext_vector_type(2))); return __builtin_bit_cast(unsigned, __builtin_convertvector((f2_){lo, hi}, b2_)); }
__device__ __forceinline__ unsigned pk2c(float lo, float hi) { typedef float f2_ __attribute__((ext_vector_type(2))); typedef __bf16 b2_ __attribute__((ext_vector_type(2))); return __builtin_bit_cast(unsigned, __builtin_convertvector((f2_){lo, hi}, b2_)); }
__device__ __forceinline__ unsigned short f2bf(float f) { return (unsigned short)(pk2(f, 0.f) & 0xffffu); }
__device__ __forceinline__ f32x4 mfma16(bf16x8 a, bf16x8 b, f32x4 c) { return __builtin_amdgcn_mfma_f32_16x16x32_bf16(a, b, c, 0, 0, 0); }
__device__ __forceinline__ f32x16 mfma32(bf16x8 a, bf16x8 b, f32x16 c) { return __builtin_amdgcn_mfma_f32_32x32x16_bf16(a, b, c, 0, 0, 0); }
__device__ __forceinline__ float wave_sum(float v) {
#pragma unroll
    for (int o = 32; o > 0; o >>= 1) v += __shfl_xor(v, o);
    return v;
}
__device__ __forceinline__ float wave_max(float v) {
#pragma unroll
    for (int o = 32; o > 0; o >>= 1) v = fmaxf(v, __shfl_xor(v, o));
    return v;
}
__device__ __forceinline__ u32x4 pack8(const float* f) { u32x4 w; w.x = pk2(f[0], f[1]); w.y = pk2(f[2], f[3]); w.z = pk2(f[4], f[5]); w.w = pk2(f[6], f[7]); return w; }
__device__ __forceinline__ void unpack8(u32x4 w, float* f) {
    f[0] = __uint_as_float(w.x << 16); f[1] = __uint_as_float(w.x & 0xffff0000u); f[2] = __uint_as_float(w.y << 16); f[3] = __uint_as_float(w.y & 0xffff0000u);
    f[4] = __uint_as_float(w.z << 16); f[5] = __uint_as_float(w.z & 0xffff0000u); f[6] = __uint_as_float(w.w << 16); f[7] = __uint_as_float(w.w & 0xffff0000u);
}
__device__ __forceinline__ float sigmoidf_(float z) { return __builtin_amdgcn_rcpf(1.0f + __builtin_amdgcn_exp2f(-1.4426950408889634f * z)); }

typedef short v4i16_t __attribute__((ext_vector_type(4)));
__device__ __forceinline__ v4i16_t lds_tr16(const bf16_t* ptr) { return __builtin_amdgcn_ds_read_tr16_b64_v4i16((__attribute__((address_space(3))) v4i16_t*)ptr); }
__device__ __forceinline__ int srccol_in(int n) {
    if (n < 1024) return n;
    if (n < 2560) return n + 40;
    if (n < 3072) return n + 48;
    if (n < 3112) return n - 3072 + 1024;
    if (n < 3120) return n - 3112 + 2600;
    return -1;
}
__device__ __forceinline__ int srccol_gu(int n) { return ((n & 128) ? 1024 : 0) + 128 * (n >> 8) + (n & 127); }

#ifndef CONV_NB
#define CONV_NB 4
#endif
struct TrTile { const float* src; bf16_t* dst; int ld, k0, n0, which; unsigned char* dst8; };
__device__ __forceinline__ TrTile tr_decode_in(const Params& p, int id) { TrTile t; t.src = p.w_in; t.dst = p.wt_in; t.ld = PW_SRC; t.n0 = (id % (NPW / 64)) * 64; t.k0 = (id / (NPW / 64)) * 64; t.which = 0; t.dst8 = p.wt_in8; return t; }
__device__ __forceinline__ TrTile tr_decode_s(const Params& p, int id) {
    const bool is_out = id < 256, is_gu = id < 256 + 16384;
    const int j = is_out ? id : (is_gu ? id - 256 : id - 256 - 16384);
    const int e = is_out ? 0 : (is_gu ? (j >> 9) : (j >> 8));
    const size_t esz_src = is_gu ? (size_t)1024 * 2048 : (size_t)1024 * 1024, esz_dst = (is_gu ? (size_t)2048 * 1024 : (size_t)1024 * 1024) * (MOE_FP8 ? 1 : 2);
    const float* sb = is_out ? p.w_out : (is_gu ? p.w_gu : p.w_dn); unsigned char* db = (unsigned char*)(is_out ? p.wt_out : (is_gu ? p.wt_gu : p.wt_dn));
    TrTile t; t.src = sb + (size_t)e * esz_src; t.dst = (bf16_t*)(db + (size_t)e * esz_dst); t.ld = (!is_out && is_gu) ? 2048 : 1024;
    t.n0 = ((!is_out && is_gu) ? (j & 31) : (j & 15)) * 64; t.k0 = ((!is_out && is_gu) ? ((j >> 5) & 15) : ((j >> 4) & 15)) * 64; t.which = is_out ? 2 : (is_gu ? 1 : 3); t.dst8 = nullptr;
    return t;
}
__device__ __forceinline__ void tr_load(const TrTile& t, int tid, float4 (&v)[2]) {
#pragma unroll
    for (int i = 0; i < 2; ++i) {
        const int k = (tid >> 4) + 32 * i, dn = t.n0 + (tid & 15) * 4; const int sc = (t.which == 1) ? srccol_gu(dn) : dn;
        { const f32x4 t4 = __builtin_nontemporal_load((const f32x4*)(t.src + (size_t)(t.k0 + k) * t.ld + sc)); v[i] = make_float4(t4[0], t4[1], t4[2], t4[3]); }
    }
}
__device__ __forceinline__ void tr_load_in(const TrTile& t, int tid, float4 (&v)[2]) {
#pragma unroll
    for (int i = 0; i < 2; ++i) {
        const int k = (tid >> 4) + 32 * i, dn = t.n0 + (tid & 15) * 4; const int sc = srccol_in(dn);
        const float4 ld4 = *(const float4*)(t.src + (size_t)(t.k0 + k) * t.ld + max(sc, 0));
        v[i] = (sc >= 0) ? ld4 : make_float4(0.f, 0.f, 0.f, 0.f);
    }
}
__device__ __forceinline__ void tr_lds_write(float* tile, int tid, const float4 (&v)[2]) {
#pragma unroll
    for (int i = 0; i < 2; ++i) { float* tp = tile + ((tid >> 4) + 32 * i) * 65 + (tid & 15) * 4; tp[0] = v[i].x; tp[1] = v[i].y; tp[2] = v[i].z; tp[3] = v[i].w; }
}
__device__ __forceinline__ void tr_store(const TrTile& t, const float* tile, int tid) {
    const int n = tid >> 3, k8 = (tid & 7) * 8; float f[8];
#pragma unroll
    for (int j = 0; j < 8; ++j) f[j] = tile[(k8 + j) * 65 + n];
#if MOE_FP8
    if (t.which == 1 || t.which == 3) { u32x2 w; w.x = pk4_fp8(f[0] * FP8_WS, f[1] * FP8_WS, f[2] * FP8_WS, f[3] * FP8_WS); w.y = pk4_fp8(f[4] * FP8_WS, f[5] * FP8_WS, f[6] * FP8_WS, f[7] * FP8_WS);
        *(u32x2*)((unsigned char*)t.dst + (size_t)(t.n0 + n) * 1024 + t.k0 + k8) = w; return; }
#endif
    *(u32x4*)(t.dst + (size_t)(t.n0 + n) * 1024 + t.k0 + k8) = pack8(f);
#if PROJ_FP8
    if (t.which == 0 && t.n0 + n < PP) { u32x2 w; w.x = pk4_fp8(f[0] * FP8_WS, f[1] * FP8_WS, f[2] * FP8_WS, f[3] * FP8_WS); w.y = pk4_fp8(f[4] * FP8_WS, f[5] * FP8_WS, f[6] * FP8_WS, f[7] * FP8_WS);
        *(u32x2*)(t.dst8 + (size_t)(t.n0 + n) * 1024 + t.k0 + k8) = w; }
#endif
}

#ifndef CONV_WAVES
#define CONV_WAVES 1
#endif
__device__ __forceinline__ int streamed_tiles_of_wg() { constexpr int NT_S = (CONV_WAVES && MOE_FP8) ? 256 : 256 + 16384 + 8192; const int G = gridDim.x; return (NT_S - (int)blockIdx.x + G - 1) / G; }
__device__ __forceinline__ void convert_streamed(const Params& p, unsigned char* lds, int qbeg, int qend) {
    const int tid = tid_opaque();
    float* tiles = (float*)lds; constexpr int TB = 64 * 65; const int G = gridDim.x;
    {
        constexpr int NB = CONV_NB;
        const int nper = qend - qbeg;
        if (nper <= 0) return;
        float4 cur[NB][2], nxt[NB][2];
#pragma unroll
        for (int j = 0; j < NB; ++j) { const int q = min(j, nper - 1); tr_load(tr_decode_s(p, blockIdx.x + (qbeg + q) * G), tid, cur[j]); }
        int par = 0;
        for (int q0 = 0; q0 < nper; q0 += NB) {
#pragma unroll
            for (int j = 0; j < NB; ++j) { const int q = min(q0 + NB + j, nper - 1); tr_load(tr_decode_s(p, blockIdx.x + (qbeg + q) * G), tid, nxt[j]); }
#pragma unroll
            for (int sub = 0; sub < NB; sub += 4, par ^= 1) {
#pragma unroll
                for (int j = 0; j < 4; ++j) tr_lds_write(tiles + (par * 4 + j) * TB, tid, cur[sub + j]);
                asm volatile("s_waitcnt lgkmcnt(0)" ::: "memory"); __builtin_amdgcn_s_barrier(); asm volatile("" ::: "memory");
#pragma unroll
                for (int j = 0; j < 4; ++j) if (q0 + sub + j < nper) tr_store(tr_decode_s(p, blockIdx.x + (qbeg + q0 + sub + j) * G), tiles + (par * 4 + j) * TB, tid);
            }
#pragma unroll
            for (int j = 0; j < NB; ++j) { cur[j][0] = nxt[j][0]; cur[j][1] = nxt[j][1]; }
        }
        __syncthreads();
    }
}

constexpr int NT_W8 = 16384 + 8192;
__device__ __forceinline__ void wt8_addr(const Params& p, int id, int lane, const float*& src, unsigned char*& dst, int& ld) {
    const bool gu = id < 16384; const int j = gu ? id : id - 16384;
    const int e = gu ? (j >> 9) : (j >> 8), nb = gu ? (j & 63) : (j & 31), kb = gu ? ((j >> 6) & 7) : ((j >> 5) & 7);
    ld = gu ? 2048 : 1024;
    const int ng = lane & 7, kg = lane >> 3, dn = nb * 32 + ng * 4, sc = gu ? srccol_gu(dn) : dn;
    src = (gu ? p.w_gu : p.w_dn) + (size_t)e * 1024 * ld + (size_t)(kb * 128 + kg * 16) * ld + sc;
    dst = (unsigned char*)(gu ? p.wt_gu : p.wt_dn) + (size_t)e * ld * 1024 + (size_t)dn * 1024 + kb * 128 + kg * 16;
}
__device__ __forceinline__ void wt8_load(const Params& p, int id, int lane, f32x4 (&v)[16]) {
    const float* src; unsigned char* dst; int ld; wt8_addr(p, id, lane, src, dst, ld);
#pragma unroll
    for (int j = 0; j < 16; ++j) v[j] = __builtin_nontemporal_load((const f32x4*)(src + (size_t)j * ld));
}
__device__ __forceinline__ void wt8_store(const Params& p, int id, int lane, const f32x4 (&v)[16]) {
    const float* src; unsigned char* dst; int ld; wt8_addr(p, id, lane, src, dst, ld);
#pragma unroll
    for (int c = 0; c < 4; ++c) { u32x4 w;
#pragma unroll
        for (int d = 0; d < 4; ++d) w[d] = pk4_fp8(v[4 * d][c] * FP8_WS, v[4 * d + 1][c] * FP8_WS, v[4 * d + 2][c] * FP8_WS, v[4 * d + 3][c] * FP8_WS);
        *(u32x4*)(dst + (size_t)c * 1024) = w; }
}
__device__ __forceinline__ void wt8_cvt(const f32x4 (&v)[16], u32x4 (&w)[4]) {
#pragma unroll
    for (int c = 0; c < 4; ++c)
#pragma unroll
        for (int d = 0; d < 4; ++d) w[c][d] = pk4_fp8(v[4 * d][c] * FP8_WS, v[4 * d + 1][c] * FP8_WS, v[4 * d + 2][c] * FP8_WS, v[4 * d + 3][c] * FP8_WS);
}
__device__ __forceinline__ void wt8_put(const Params& p, int id, int lane, const u32x4 (&w)[4]) {
    const float* src; unsigned char* dst; int ld; wt8_addr(p, id, lane, src, dst, ld);
#pragma unroll
    for (int c = 0; c < 4; ++c) *(u32x4*)(dst + (size_t)c * 1024) = w[c];
}
__device__ __forceinline__ void convert_fp8_waves(const Params& p, int i0) {
    const int tid = tid_opaque(), wid = __builtin_amdgcn_readfirstlane(tid >> 6), lane = tid & 63, stride = gridDim.x * 8, first = blockIdx.x * 8 + wid + i0 * stride;
    if (first >= NT_W8) return;
    const int n = (NT_W8 - first + stride - 1) / stride;
    f32x4 a[16], b[16];
    wt8_load(p, first, lane, a);
    int i = 0;
    for (; i + 3 < n; i += 2) {
        wt8_load(p, first + (i + 1) * stride, lane, b); wt8_store(p, first + i * stride, lane, a);
        wt8_load(p, first + (i + 2) * stride, lane, a); wt8_store(p, first + (i + 1) * stride, lane, b);
    }
    if (i + 1 < n) {
        wt8_load(p, first + (i + 1) * stride, lane, b); wt8_store(p, first + i * stride, lane, a);
        if (i + 2 < n) { wt8_load(p, first + (i + 2) * stride, lane, a); wt8_store(p, first + (i + 1) * stride, lane, b); wt8_store(p, first + (i + 2) * stride, lane, a); }
        else wt8_store(p, first + (i + 1) * stride, lane, b);
    } else wt8_store(p, first + i * stride, lane, a);
}

#ifdef PROBE_LOADONLY
__device__ __forceinline__ void convert_fp8_loadonly(const Params& p) {
    const int tid = tid_opaque(), wid = __builtin_amdgcn_readfirstlane(tid >> 6), lane = tid & 63, stride = gridDim.x * 8, first = blockIdx.x * 8 + wid;
    if (first >= NT_W8) return;
    const int n = (NT_W8 - first + stride - 1) / stride;
    f32x4 a[16], b[16]; float acc = 0.f;
    wt8_load(p, first, lane, a);
    for (int i = 0; i < n; i += 2) {
        wt8_load(p, first + min(i + 1, n - 1) * stride, lane, b);
#pragma unroll
        for (int j = 0; j < 16; ++j) acc += a[j][0] + a[j][1] + a[j][2] + a[j][3];
        wt8_load(p, first + min(i + 2, n - 1) * stride, lane, a);
#pragma unroll
        for (int j = 0; j < 16; ++j) acc += b[j][0] + b[j][1] + b[j][2] + b[j][3];
    }
#pragma unroll
    for (int j = 0; j < 16; ++j) acc += a[j][0];
    asm volatile("" :: "v"(acc));
}
#endif
#ifndef TK_TILES_N
#define TK_TILES_N 0
#endif
constexpr int TK_TILES = TK_TILES_N;
__device__ __forceinline__ void wh8_addr(const Params& p, int hid, int lane, const float*& src, unsigned char*& dst, int& ld) {
    const int id = hid >> 1, kh = hid & 1; const bool gu = id < 16384; const int j = gu ? id : id - 16384;
    const int e = gu ? (j >> 9) : (j >> 8), nb = gu ? (j & 63) : (j & 31), kb = gu ? ((j >> 6) & 7) : ((j >> 5) & 7);
    ld = gu ? 2048 : 1024;
    const int ng = lane & 7, kg = lane >> 3, dn = nb * 32 + ng * 4, sc = gu ? srccol_gu(dn) : dn, k0 = kb * 128 + kh * 64 + kg * 8;
    src = (gu ? p.w_gu : p.w_dn) + (size_t)e * 1024 * ld + (size_t)k0 * ld + sc;
    dst = (unsigned char*)(gu ? p.wt_gu : p.wt_dn) + (size_t)e * ld * 1024 + (size_t)dn * 1024 + k0;
}
__device__ __forceinline__ void wh8_load(const Params& p, int hid, int lane, f32x4 (&v)[8]) {
    const float* src; unsigned char* dst; int ld; wh8_addr(p, hid, lane, src, dst, ld);
#pragma unroll
    for (int j = 0; j < 8; ++j) v[j] = __builtin_nontemporal_load((const f32x4*)(src + (size_t)j * ld));
}
__device__ __forceinline__ void wh8_store(const Params& p, int hid, int lane, const f32x4 (&v)[8]) {
    const float* src; unsigned char* dst; int ld; wh8_addr(p, hid, lane, src, dst, ld);
#pragma unroll
    for (int c = 0; c < 4; ++c) { u32x2 w; w.x = pk4_fp8(v[0][c] * FP8_WS, v[1][c] * FP8_WS, v[2][c] * FP8_WS, v[3][c] * FP8_WS); w.y = pk4_fp8(v[4][c] * FP8_WS, v[5][c] * FP8_WS, v[6][c] * FP8_WS, v[7][c] * FP8_WS);
        *(u32x2*)(dst + (size_t)c * 1024) = w; }
}
struct HostQ { int first, stride, i, n; };
__device__ __forceinline__ int hostq_id(const HostQ& q, int k) { return 2 * (q.first + (k >> 1) * q.stride) + (k & 1); }
__device__ __forceinline__ void convert_fp8_rest(const Params& p, int i0, int i1) {
    const int tid = tid_opaque(), wid = __builtin_amdgcn_readfirstlane(tid >> 6), lane = tid & 63, stride = gridDim.x * 8, first = blockIdx.x * 8 + wid;
    for (int i = i0; i < i1 && first + i * stride < NT_W8; ++i) { f32x4 v[16]; wt8_load(p, first + i * stride, lane, v); wt8_store(p, first + i * stride, lane, v); }
}
__device__ __forceinline__ void phase_prologue(const Params& p, unsigned char* lds) {
    const int tid = tid_opaque(), wid = tid >> 6, lane = tid & 63;
    float* tiles = (float*)lds;
    constexpr int TB = 64 * 65;
    const int G = gridDim.x;
    {
        constexpr int NT_IN = (NPW / 64) * 16;
        for (int id0 = blockIdx.x; id0 < NT_IN; id0 += 4 * G) {
            float4 v[4][2];
#pragma unroll
            for (int j = 0; j < 4; ++j) { const int id = (id0 + j * G < NT_IN) ? id0 + j * G : id0; tr_load_in(tr_decode_in(p, id), tid, v[j]); }
#pragma unroll
            for (int j = 0; j < 4; ++j) tr_lds_write(tiles + j * TB, tid, v[j]);
            __syncthreads();
#pragma unroll
            for (int j = 0; j < 4; ++j) if (id0 + j * G < NT_IN) tr_store(tr_decode_in(p, id0 + j * G), tiles + j * TB, tid);
            __syncthreads();
        }
    }
#ifdef PROBE_READ
    {
        constexpr int NT_S = 256 + 16384 + 8192, NB = 4;
        const int nper = (NT_S - (int)blockIdx.x + G - 1) / G; float4 acc4 = make_float4(0.f, 0.f, 0.f, 0.f);
        for (int q0 = 0; q0 < nper; q0 += NB) {
            float4 v[NB][2];
#pragma unroll
            for (int j = 0; j < NB; ++j) { const int q = min(q0 + j, nper - 1); tr_load(tr_decode_s(p, blockIdx.x + q * G), tid, v[j]); }
#pragma unroll
            for (int j = 0; j < NB; ++j) { acc4.x += v[j][0].x + v[j][1].x; acc4.y += v[j][0].y + v[j][1].y; }
        }
        asm volatile("" :: "v"(acc4.x), "v"(acc4.y));
    }
#endif
    for (int row = blockIdx.x * 8 + wid; row < T_TOK; row += gridDim.x * 8) {
        const float4* xr = (const float4*)(p.x + (size_t)row * DM); float4 v[4]; float ss = 0.f;
#pragma unroll
        for (int i = 0; i < 4; ++i) { v[i] = xr[lane + 64 * i]; ss += v[i].x * v[i].x + v[i].y * v[i].y + v[i].z * v[i].z + v[i].w * v[i].w; }
        ss = wave_sum(ss); const float rs = 1.0f / sqrtf(ss * (1.0f / DM) + NORM_EPS);
#pragma unroll
        for (int i = 0; i < 4; ++i) { const float4 w = ((const float4*)p.mix_norm_w)[lane + 64 * i];
            u32x2 o; o.x = pk2(v[i].x * rs * w.x, v[i].y * rs * w.y); o.y = pk2(v[i].z * rs * w.z, v[i].w * rs * w.w);
            *(u32x2*)(p.xn + (size_t)row * DM + (lane + 64 * i) * 4) = o;
#if PROJ_FP8
            *(unsigned*)(p.xn8 + (size_t)row * DM + (lane + 64 * i) * 4) = pk4_fp8(v[i].x * rs * w.x * FP8_XS, v[i].y * rs * w.y * FP8_XS, v[i].z * rs * w.z * FP8_XS, v[i].w * rs * w.w * FP8_XS);
#endif
        }
    }
    for (int i = blockIdx.x * NTHREADS + tid; i < SEQ * 12; i += gridDim.x * NTHREADS) {
        const float invf_tab[12] = {1.000000000e+00f, 1.939227432e-01f, 3.760603070e-02f, 7.292664610e-03f, 1.414213562e-03f, 2.742481884e-04f, 5.318295734e-05f, 1.031338525e-05f, 1.000000000e+00f, 3.760603070e-02f, 1.414213562e-03f, 5.318295734e-05f};
        const int pos = i / 12, j = i % 12; const bool att = j < 8; const int jj = att ? j : j - 8;
        float invf = invf_tab[0];
#pragma unroll
        for (int q = 1; q < 12; ++q) invf = (j == q) ? invf_tab[q] : invf;
        const float ang = (float)pos * invf; float sn, cs; sincosf(ang, &sn, &cs);
        float* dst = att ? (p.ropea + ((size_t)pos * 8 + jj) * 2) : (p.ropei + ((size_t)pos * 4 + jj) * 2);
        dst[0] = cs; dst[1] = sn;
    }
    if (blockIdx.x == 0 && tid < 64) p.cnt[tid] = 0;
    if (blockIdx.x == 1 && tid < RDY_WORDS) p.rdy[tid] = 0u;
}

template <bool F8>
struct EpiProjT {
    static constexpr bool PERM = true, AFTER_DRAIN = false;
    bf16_t* proj; bf16_t* ikb; float* iw; float* mi; float* mf; const float* ropea; const float* ropei; const float* igb; const float* fgb;
    __device__ __forceinline__ void operator()(const f32x4 (&acc)[2][2][4][2], const Unit& u, int wr, int wc, int fr, int fq) const {
        const float idx_w_scale = 0.35355339059327373f * 0.17677669529663687f;
#pragma unroll
        for (int ai = 0; ai < 2; ++ai)
#pragma unroll
            for (int m = 0; m < 4; ++m) {
                const int row = u.pm * 256 + ai * 128 + wr * 64 + m * 16 + fr; const int pos = row & (SEQ - 1);
#pragma unroll
                for (int bj = 0; bj < 2; ++bj) {
                    f32x4 v0 = acc[ai][bj][m][0], v1 = acc[ai][bj][m][1];
                    if constexpr (F8) { v0 *= FP8_INV; v1 *= FP8_INV; }
                    const int cw = u.pn * 256 + bj * 128 + wc * 32;
                    if (cw < C_AV) {
                        if ((cw & 32) == 0) {
                            f32x4 q0, q1;
#pragma unroll
                            for (int j = 0; j < 4; ++j) { q0[j] = __shfl_xor(v0[j], 16); q1[j] = __shfl_xor(v1[j], 16); }
                            if (fq < 2) {
                                const float4* cs = (const float4*)(ropea + (size_t)pos * 16);
                                const float4 c01 = cs[0], c23 = cs[1], c45 = cs[2], c67 = cs[3];
                                const float co[8] = {c01.x, c01.z, c23.x, c23.z, c45.x, c45.z, c67.x, c67.z}, si[8] = {c01.y, c01.w, c23.y, c23.w, c45.y, c45.w, c67.y, c67.w};
                                if (fq == 0) {
#pragma unroll
                                    for (int j = 0; j < 4; ++j) { v0[j] = v0[j] * co[j] - q0[j] * si[j]; v1[j] = v1[j] * co[4 + j] - q1[j] * si[4 + j]; }
                                } else {
#pragma unroll
                                    for (int j = 0; j < 4; ++j) { v0[j] = v0[j] * co[j] + q0[j] * si[j]; v1[j] = v1[j] * co[4 + j] + q1[j] * si[4 + j]; }
                                }
                            }
                        }
                    } else if (cw >= C_IQ && cw < C_MQ) {
                        if (fq == 0) {
                            const float4* cs = (const float4*)(ropei + (size_t)pos * 8); const float4 c01 = cs[0], c23 = cs[1];
                            const float co[4] = {c01.x, c01.z, c23.x, c23.z}, si[4] = {c01.y, c01.w, c23.y, c23.w};
#pragma unroll
                            for (int j = 0; j < 4; ++j) { const float a = v0[j], b = v1[j]; v0[j] = a * co[j] - b * si[j]; v1[j] = b * co[j] + a * si[j]; }
                        }
                    }
                    u32x4 w; w.x = pk2(v0[0], v0[1]); w.y = pk2(v0[2], v0[3]); w.z = pk2(v1[0], v1[1]); w.w = pk2(v1[2], v1[3]);
                    store16_wt(proj, ((size_t)row * PP + cw + fq * 8) * 2, w);
                }
            }
    }
};

struct EpiResid {
    static constexpr bool PERM = true, AFTER_DRAIN = false;
    const float* x; bf16_t* x1;
    __device__ __forceinline__ void operator()(const f32x4 (&acc)[2][2][4][2], const Unit& u, int wr, int wc, int fr, int fq) const {
#pragma unroll
        for (int ai = 0; ai < 2; ++ai)
#pragma unroll
            for (int m = 0; m < 4; ++m) {
                const int row = u.pm * 256 + ai * 128 + wr * 64 + m * 16 + fr;
#pragma unroll
                for (int bj = 0; bj < 2; ++bj) {
                    const size_t off = (size_t)row * DM + u.pn * 256 + bj * 128 + wc * 32 + fq * 8;
                    const f32x4 a = *(const f32x4*)(x + off), b = *(const f32x4*)(x + off + 4);
                    const f32x4 s0 = a + acc[ai][bj][m][0], s1 = b + acc[ai][bj][m][1];
                    u32x4 w; w.x = pk2(s0[0], s0[1]); w.y = pk2(s0[2], s0[3]); w.z = pk2(s1[0], s1[1]); w.w = pk2(s1[2], s1[3]); store16_wt(x1, off * 2, w);
                }
            }
    }
};

template <bool WT>
struct EpiSwigluT {
    static constexpr bool PERM = true, AFTER_DRAIN = false;
    const float* bgu; bf16_t* act;
    __device__ __forceinline__ void operator()(const f32x4 (&acc)[2][2][4][2], const Unit& u, int wr, int wc, int fr, int fq) const {
        typedef float f32x2 __attribute__((ext_vector_type(2)));
        const int hc = u.pn * 128 + wc * 32 + fq * 8;
        const float* bg = bgu + (size_t)u.ex * 2048 + hc;
        f32x2 bgl[4], bli[4];
#pragma unroll
        for (int j = 0; j < 4; ++j) { bgl[j] = *(const f32x2*)(bg + 2 * j); bli[j] = *(const f32x2*)(bg + 1024 + 2 * j); }
        const float inv = MOE_FP8 ? FP8_INV : 1.0f, xs = MOE_FP8 ? FP8_XS : 1.0f;
#if MOE_FP8
        typedef unsigned u32x2v __attribute__((ext_vector_type(2)));
        const __amdgpu_buffer_rsrc_t arsrc = __builtin_amdgcn_make_buffer_rsrc((void*)act, 0, XROWS * 1024, 0x00020000);
#endif
#pragma unroll
        for (int ai = 0; ai < 2; ++ai)
#pragma unroll
            for (int mp = 0; mp < 2; ++mp) {
                u32x2 w[2];
#pragma unroll
                for (int mm = 0; mm < 2; ++mm) {
                    const int m = 2 * mp + mm; f32x2 o[4];
#pragma unroll
                    for (int j = 0; j < 4; ++j) {
                        const f32x4& ga = acc[ai][0][m][j >> 1]; const f32x4& la = acc[ai][1][m][j >> 1];
                        f32x2 g = (f32x2){ga[2 * (j & 1)], ga[2 * (j & 1) + 1]} * inv + bgl[j];
                        f32x2 l = (f32x2){la[2 * (j & 1)], la[2 * (j & 1) + 1]} * inv + bli[j];
                        g = __builtin_elementwise_min(g, (f32x2){7.0f, 7.0f});
                        l = __builtin_elementwise_min(__builtin_elementwise_max(l, (f32x2){-7.0f, -7.0f}), (f32x2){7.0f, 7.0f});
                        const f32x2 t = g * (-1.702f * 1.4426950408889634f);
                        f32x2 e; e.x = __builtin_amdgcn_exp2f(t.x); e.y = __builtin_amdgcn_exp2f(t.y);
                        const f32x2 d = e + 1.0f; f32x2 r; r.x = __builtin_amdgcn_rcpf(d.x); r.y = __builtin_amdgcn_rcpf(d.y);
                        o[j] = (g * r) * (l * xs + xs);
                    }
#if MOE_FP8
                    w[mm].x = pk4_fp8(o[0].x, o[0].y, o[1].x, o[1].y); w[mm].y = pk4_fp8(o[2].x, o[2].y, o[3].x, o[3].y);
#else
                    { const int row = u.pm * 256 + ai * 128 + wr * 64 + m * 16 + fr; u32x4 ww; ww.x = pk2(o[0].x, o[0].y); ww.y = pk2(o[1].x, o[1].y); ww.z = pk2(o[2].x, o[2].y); ww.w = pk2(o[3].x, o[3].y); *(u32x4*)(act + (size_t)row * 1024 + hc) = ww; }
#endif
                }
#if MOE_FP8
                {
                    const u32x2v lo = __builtin_amdgcn_permlane16_swap(w[0].x, w[1].x, false, false), hi = __builtin_amdgcn_permlane16_swap(w[0].y, w[1].y, false, false);
                    const u32x4 v = {lo[0], hi[0], lo[1], hi[1]};
                    const int row = u.pm * 256 + ai * 128 + wr * 64 + (2 * mp + (fq & 1)) * 16 + fr;
                    __builtin_amdgcn_raw_buffer_store_b128(v, arsrc, (unsigned)(row * 1024 + hc - (fq & 1) * 8), 0, (WT || WT_EPI) ? 16 : 0);
                }
#endif
            }
    }
};

#ifndef Y_FP8
#define Y_FP8 1
#endif
constexpr float FP8_YS = 16.0f;
__device__ __forceinline__ float yq(float v) { return __builtin_amdgcn_fmed3f(v * FP8_YS, -440.0f, 440.0f); }
struct EpiBiasBf16 {
    static constexpr bool PERM = true, AFTER_DRAIN = false;
    const float* bdn; bf16_t* y;
    __device__ __forceinline__ void operator()(const f32x4 (&acc)[2][2][4][2], const Unit& u, int wr, int wc, int fr, int fq) const {
#pragma unroll
        for (int bj = 0; bj < 2; ++bj) {
            const int c8 = u.pn * 256 + bj * 128 + wc * 32 + fq * 8; const float* bb = bdn + (size_t)u.ex * 1024 + c8;
            const f32x4 b0 = *(const f32x4*)bb, b1 = *(const f32x4*)(bb + 4);
#pragma unroll
            for (int ai = 0; ai < 2; ++ai)
#pragma unroll
                for (int m = 0; m < 4; ++m) {
                    const int row = u.pm * 256 + ai * 128 + wr * 64 + m * 16 + fr;
                    const f32x4 v0 = acc[ai][bj][m][0] * (MOE_FP8 ? FP8_INV : 1.0f) + b0, v1 = acc[ai][bj][m][1] * (MOE_FP8 ? FP8_INV : 1.0f) + b1;
#if Y_FP8
                    { u32x2 w; w.x = pk4_fp8(yq(v0[0]), yq(v0[1]), yq(v0[2]), yq(v0[3])); w.y = pk4_fp8(yq(v1[0]), yq(v1[1]), yq(v1[2]), yq(v1[3])); *(u32x2*)((unsigned char*)y + (size_t)row * 1024 + c8) = w; }
#else
                    u32x4 w; w.x = pk2(v0[0], v0[1]); w.y = pk2(v0[2], v0[3]); w.z = pk2(v1[0], v1[1]); w.w = pk2(v1[2], v1[3]);
                    *(u32x4*)(y + (size_t)row * 1024 + c8) = w;
#endif
                }
        }
    }
};

template <class Base> struct OneUnit {
    Base base; int which;
    __device__ __forceinline__ bool next(int i, Unit& u) const { return i == 0 && base.next(which, u); }
    __device__ __forceinline__ void a_ready(const Unit&) const {}
    __device__ __forceinline__ void done(const Unit&) const {}
};
template <int MODE>
struct GroupOrderT {
    const int* tstart; int ncol, G, c, ibeg, iend; unsigned* rdy; int lim;
    __device__ __forceinline__ bool next(int i_, Unit& u) const {
        const int i = i_ + ibeg; if (i >= iend) return false;
        int rt, ct;
        if (G == 256) {
            const int rpx = 32 / ncol, y = c >> 3, x = (MODE == 2) ? 7 - (c & 7) : (c & 7); ct = y % ncol; rt = i * (256 / ncol) + x * rpx + y / ncol;
        } else { const int L = i * G + c; rt = L / ncol; ct = L - rt * ncol; }
        if (rt >= tstart[NEXP]) return false;
        int e = 0;
        while (tstart[e + 1] <= rt) ++e;
        u.pm = rt; u.pn = ct; u.pb = e * ncol + ct; u.ex = e; return true;
    }
    __device__ __forceinline__ void a_ready(const Unit& u) const {
        if (MODE == 2) {
            if (u.pm < lim) return;
            unsigned sp = 0;
            while ((unsigned)__builtin_amdgcn_readfirstlane((int)__hip_atomic_load(rdy + u.pm, __ATOMIC_RELAXED, __HIP_MEMORY_SCOPE_AGENT)) < 64u) { __builtin_amdgcn_s_sleep(1); if (++sp > (1u << 22)) break; }
            asm volatile("buffer_inv sc1" ::: "memory");
        }
    }
    __device__ __forceinline__ void done(const Unit& u) const {
        if (MODE == 1) {
            asm volatile("s_waitcnt vmcnt(0)" ::: "memory");
            if ((tid_opaque() & 63) == 0) __hip_atomic_fetch_add(rdy + u.pm, 1u, __ATOMIC_RELAXED, __HIP_MEMORY_SCOPE_AGENT);
        }
    }
};
typedef GroupOrderT<0> GroupOrder;
__device__ __forceinline__ void proj_small(const Params& p, int blk, unsigned char* lds) {
    const int tid = tid_opaque(), wid = tid >> 6, lane = tid & 63, fr = lane & 15, fq = lane >> 4;
    const int r0 = blk * 64 + (wid & 3) * 16, kh = wid >> 2;
    const bf16_t* ap = p.xn + (size_t)(r0 + fr) * 1024 + kh * 512 + fq * 8;
    const bf16_t* bp0 = p.wt_in + (size_t)(PP + fr) * 1024 + kh * 512 + fq * 8; const bf16_t* bp1 = bp0 + 16 * 1024; const bf16_t* bp2 = bp0 + 32 * 1024;
    f32x4 c0 = {0.f, 0.f, 0.f, 0.f}, c1 = {0.f, 0.f, 0.f, 0.f}, c2 = {0.f, 0.f, 0.f, 0.f};
#pragma unroll 8
    for (int ks = 0; ks < 16; ++ks) {
        const bf16x8 a = *(const bf16x8*)(ap + ks * 32), b0 = *(const bf16x8*)(bp0 + ks * 32), b1 = *(const bf16x8*)(bp1 + ks * 32), b2 = *(const bf16x8*)(bp2 + ks * 32);
        c0 = mfma16(a, b0, c0); c1 = mfma16(a, b1, c1); c2 = mfma16(a, b2, c2);
    }
    f32x4* red = (f32x4*)lds;
    if (kh == 1) { red[((wid & 3) * 3 + 0) * 64 + lane] = c0; red[((wid & 3) * 3 + 1) * 64 + lane] = c1; red[((wid & 3) * 3 + 2) * 64 + lane] = c2; }
    __syncthreads();
    if (kh == 0) {
        c0 += red[((wid & 3) * 3 + 0) * 64 + lane]; c1 += red[((wid & 3) * 3 + 1) * 64 + lane]; c2 += red[((wid & 3) * 3 + 2) * 64 + lane];
        const float idx_w_scale = 0.35355339059327373f * 0.17677669529663687f;
#pragma unroll
        for (int r = 0; r < 4; ++r) {
            const int row = r0 + 4 * fq + r, pos = row & (SEQ - 1); const float own = c0[r], oth = __shfl_xor(own, 4); float v = own;
            if (fr < 8) { const float2 cs = *(const float2*)(p.ropei + ((size_t)pos * 4 + (fr & 3)) * 2); v = (fr < 4) ? own * cs.x - oth * cs.y : own * cs.x + oth * cs.y; }
            p.ikb[(size_t)row * 32 + fr] = f2bf(v); p.ikb[(size_t)row * 32 + 16 + fr] = f2bf(c1[r]);
        }
#pragma unroll
        for (int r = 0; r < 4; ++r) {
            const int row = r0 + 4 * fq + r; const float v = c2[r];
            if (fr < 8) p.iw[(size_t)row * 8 + fr] = v * idx_w_scale;
            else if (fr < 12) p.mi[(size_t)row * 4 + fr - 8] = v + p.igate_b[fr - 8];
            else { const float z = v + p.fgate_b[fr - 12]; p.mf[(size_t)row * 4 + fr - 12] = fminf(z, 0.f) - log1pf(__expf(-fabsf(z))); }
        }
    }
    __syncthreads();
}

__device__ __forceinline__ bf16x8 tr_frag(const bf16_t* T, int ld, int kbase, int c0, int lane) {
    const int q = lane >> 4, qq = (lane & 15) >> 2, pp = lane & 3;
    const v4i16_t t1 = lds_tr16(T + (kbase + 8 * q + qq) * ld + c0 + 4 * pp), t2 = lds_tr16(T + (kbase + 8 * q + 4 + qq) * ld + c0 + 4 * pp);
    return (bf16x8){t1[0], t1[1], t1[2], t1[3], t2[0], t2[1], t2[2], t2[3]};
}
__device__ __forceinline__ void mlstm_local(const Params& p, int item, unsigned char* lds) {
    const int tid = tid_opaque(), wid = tid >> 6, lane = tid & 63, fr = lane & 15, fq = lane >> 4;
    const int bh = item >> 6, c = item & 63, b = bh >> 2, h = bh & 3, t0 = b * SEQ + c * 64;
    bf16_t* kw = (bf16_t*)lds;
    bf16_t* vl = kw + 64 * 136;
    float* wgt = (float*)(lds + 2 * 64 * 136 * 2);
    float* cwl = wgt + 64;
    if (wid == 0) {
        const float lf = p.mf[(size_t)(t0 + lane) * 4 + h], ii = p.mi[(size_t)(t0 + lane) * 4 + h];
        float bs = lf;
#pragma unroll
        for (int d = 1; d < 64; d <<= 1) { const float o = __shfl_up(bs, d); if (lane >= d) bs += o; }
        const float bl = __shfl(bs, 63); const float wl = bl - bs + ii; const float mx = wave_max(wl);
        wgt[lane] = __expf(wl - mx); p.cb[(size_t)(t0 + lane) * 4 + h] = bs;
        if (lane == 0) { p.bl[item] = bl; p.mloc[item] = mx; }
    } else {
        for (int i = tid - 64; i < 1280; i += 448) { const int j = i >> 8, cc = i & 255; const int src = (cc < 128 ? h * 128 + cc : 512 + h * 128 + cc - 128);
            cwl[i] = (j < 4) ? p.conv_w[j * 1024 + src] : p.conv_b[src]; }
    }
    __syncthreads();
    {
        const int tok = tid >> 3, d0 = (tid & 7) * 16, pos = c * 64 + tok; float aq[16], ak[16];
#pragma unroll
        for (int i = 0; i < 16; ++i) { aq[i] = cwl[1024 + d0 + i]; ak[i] = cwl[1024 + 128 + d0 + i]; }
#pragma unroll
        for (int j = 0; j < 4; ++j) {
            const int pp = pos - 3 + j;
            if (pp >= 0) {
                const bf16_t* rq = p.proj + (size_t)(b * SEQ + pp) * PP + C_MQ + h * 128 + d0; const bf16_t* rk = p.proj + (size_t)(b * SEQ + pp) * PP + C_MK + h * 128 + d0;
                float xq[16], xk[16]; unpack8(*(const u32x4*)rq, xq); unpack8(*(const u32x4*)(rq + 8), xq + 8); unpack8(*(const u32x4*)rk, xk); unpack8(*(const u32x4*)(rk + 8), xk + 8);
                const float* wq = cwl + j * 256 + d0; const float* wk = wq + 128;
#pragma unroll
                for (int i = 0; i < 16; ++i) { aq[i] += wq[i] * xq[i]; ak[i] += wk[i] * xk[i]; }
            }
        }
        const float wt = wgt[tok]; const float ksc = 0.08838834764831845f;
        const bf16_t* rv = p.proj + (size_t)(t0 + tok) * PP + C_MV + h * 128 + d0; const u32x4 v0 = *(const u32x4*)rv, v1 = *(const u32x4*)(rv + 8);
#pragma unroll
        for (int i = 0; i < 16; ++i) { aq[i] = aq[i] * sigmoidf_(aq[i]); ak[i] = ak[i] * sigmoidf_(ak[i]) * ksc; }
        bf16_t* oq = p.cq + (size_t)(t0 + tok) * 512 + h * 128 + d0; bf16_t* ok = p.ck + (size_t)(t0 + tok) * 512 + h * 128 + d0;
        *(u32x4*)oq = pack8(aq); *(u32x4*)(oq + 8) = pack8(aq + 8); *(u32x4*)ok = pack8(ak); *(u32x4*)(ok + 8) = pack8(ak + 8);
#pragma unroll
        for (int i = 0; i < 16; ++i) ak[i] *= wt;
        *(u32x4*)(kw + tok * 136 + d0) = pack8(ak); *(u32x4*)(kw + tok * 136 + d0 + 8) = pack8(ak + 8);
        *(u32x4*)(vl + tok * 136 + d0) = v0; *(u32x4*)(vl + tok * 136 + d0 + 8) = v1;
    }
    __syncthreads();
    {
        bf16x8 a[2];
#pragma unroll
        for (int ks = 0; ks < 2; ++ks) a[ks] = tr_frag(vl, 136, 32 * ks, 16 * wid, lane);
#pragma unroll
        for (int db = 0; db < 8; ++db) {
            f32x4 acc = {0.f, 0.f, 0.f, 0.f};
#pragma unroll
            for (int ks = 0; ks < 2; ++ks) { const bf16x8 bb = tr_frag(kw, 136, 32 * ks, 16 * db, lane); acc = mfma16(bb, a[ks], acc); }
            { u32x2 w; w.x = pk2c(acc[0], acc[1]); w.y = pk2c(acc[2], acc[3]); *(u32x2*)(p.ut + ((size_t)item * 128 + 16 * wid + fr) * 128 + 16 * db + 4 * fq) = w; }
        }
    }
    if (tid < 128) { float s = 0.f;
#pragma unroll 8
        for (int i = 0; i < 64; ++i) s += bf2f(kw[i * 136 + tid]);
        p.nu[(size_t)item * 128 + tid] = s; }
    __syncthreads();
}

__device__ __forceinline__ int slotpos(int key) { const int x = key & 15; return (key & 48) | (8 * ((x >> 2) & 1) + 4 * (x >> 3) + (x & 3)); }
__device__ __forceinline__ void vtrans(const Params& p, int item, unsigned char* lds) {
    const int tid = tid_opaque(), wid = tid >> 6, lane = tid & 63;
    const int bg = item >> 6, c = item & 63, b = bg >> 1, g = bg & 1;
    bf16_t* tl = (bf16_t*)lds;
    { const int key = lane, d8 = wid * 8; float v[8]; unpack8(*(const u32x4*)(p.proj + (size_t)(b * SEQ + c * 64 + key) * PP + C_AV + g * 64 + d8), v); const int sp = slotpos(key);
#pragma unroll
      for (int i = 0; i < 8; ++i) tl[(d8 + i) * 72 + sp] = f2bf(v[i]); }
    __syncthreads();
    { const int d = tid >> 3, ch = tid & 7; *(u32x4*)(p.vt + ((size_t)(bg * 64 + d)) * SEQ + c * 64 + ch * 8) = *(const u32x4*)(tl + d * 72 + ch * 8); }
    __syncthreads();
}

__device__ __forceinline__ void lds_add_u32(unsigned* p, unsigned v) { (void)__hip_atomic_fetch_add((__attribute__((address_space(3))) unsigned*)p, v, __ATOMIC_RELAXED, __HIP_MEMORY_SCOPE_WORKGROUP); }
__device__ __forceinline__ void lds_or_u32(unsigned* p, unsigned v) { (void)__hip_atomic_fetch_or((__attribute__((address_space(3))) unsigned*)p, v, __ATOMIC_RELAXED, __HIP_MEMORY_SCOPE_WORKGROUP); }
struct TopkPre { bf16x8 afr[2][2]; float wv[2][2][4]; bf16x8 bfr[4]; };
__device__ __forceinline__ void topk_prefetch(const Params& p, int j, TopkPre& q, int wid, int fr, int fq) {
    const int k = j >> 8, w = j & 255; const int cc = (w & 7) * 4 + (k & 3); const int c = (k < 4) ? cc : 63 - cc; const int b = (w >> 3) & 3, sub = w >> 5;
    const int t0 = b * SEQ + c * 64 + sub * 8, nkb = 4 * (c + 1);
#pragma unroll
    for (int pr = 0; pr < 2; ++pr)
#pragma unroll
        for (int hf = 0; hf < 2; ++hf) {
            const int tok = 4 * pr + (fr >> 2), head = 4 * hf + (fr & 3);
            q.afr[pr][hf] = *(const bf16x8*)(p.proj + (size_t)(t0 + tok) * PP + C_IQ + head * 32 + fq * 8);
            const f32x4 w4 = *(const f32x4*)(p.iw + (size_t)(t0 + 4 * pr + fq) * 8 + 4 * hf);
#pragma unroll
            for (int r = 0; r < 4; ++r) q.wv[pr][hf][r] = w4[r];
        }
    const bf16_t* kbp = p.ikb + (size_t)(b * SEQ + fr) * 32 + fq * 8; const int kb = (wid * 4 < nkb) ? wid * 4 : 0;
#pragma unroll
    for (int u = 0; u < 4; ++u) q.bfr[u] = *(const bf16x8*)(kbp + (size_t)(kb + u) * 16 * 32);
}
#ifndef CONV_IN_TOPK
#define CONV_IN_TOPK 1
#endif
__device__ __forceinline__ void idx_topk(const Params& p, int j, unsigned char* lds, const TopkPre& pc, TopkPre& pn, int jnext, bool has_next, bool do_b, int& qi) {
    const int tid = tid_opaque(), wid = tid >> 6, lane = tid & 63, fr = lane & 15, fq = lane >> 4;
    const int k = j >> 8, w = j & 255; const int cc = (w & 7) * 4 + (k & 3); const int c = (k < 4) ? cc : 63 - cc; const int b = (w >> 3) & 3, sub = w >> 5;
    const int t0 = b * SEQ + c * 64 + sub * 8; const int nj = c + 1, nkb = 4 * nj;
    constexpr int SCP = 4096 + 16;
    float* sc = (float*)lds;
    unsigned* hist = (unsigned*)(lds + 8 * SCP * 4) + wid * 512;
    unsigned* wsel = (unsigned*)(lds + 8 * SCP * 4 + 16384) + wid * 128;
    float* cval = (float*)(lds + 8 * SCP * 4 + 16384 + 4096) + wid * 64;
    int* cidx = (int*)(lds + 8 * SCP * 4 + 16384 + 4096 + 2048) + wid * 64;
    float* pm = (float*)(lds + 8 * SCP * 4 + 16384 + 4096 + 4096);
    {
        const bf16x8 (&afr)[2][2] = pc.afr; const float (&wv)[2][2][4] = pc.wv;
        float mn[2] = {INFINITY, INFINITY}, mx[2] = {-INFINITY, -INFINITY};
        const bf16_t* kbp = p.ikb + (size_t)(b * SEQ + fr) * 32 + fq * 8;
        bf16x8 bfr[4], nfr[4];
#pragma unroll
        for (int u = 0; u < 4; ++u) bfr[u] = pc.bfr[u];
        for (int kb0 = wid * 4; kb0 < nkb; kb0 += 32) {
            const int kn = (kb0 + 32 < nkb) ? kb0 + 32 : kb0;
#pragma unroll
            for (int u = 0; u < 4; ++u) nfr[u] = *(const bf16x8*)(kbp + (size_t)(kn + u) * 16 * 32);
#pragma unroll
            for (int u = 0; u < 4; ++u)
#pragma unroll
                for (int pr = 0; pr < 2; ++pr) {
                    f32x4 c0 = {0.f, 0.f, 0.f, 0.f}, c1 = {0.f, 0.f, 0.f, 0.f};
                    c0 = mfma16(afr[pr][0], bfr[u], c0); c1 = mfma16(afr[pr][1], bfr[u], c1);
                    float s = wv[pr][0][0] * fmaxf(c0[0], 0.f); s += wv[pr][0][1] * fmaxf(c0[1], 0.f); s += wv[pr][0][2] * fmaxf(c0[2], 0.f); s += wv[pr][0][3] * fmaxf(c0[3], 0.f);
                    s += wv[pr][1][0] * fmaxf(c1[0], 0.f); s += wv[pr][1][1] * fmaxf(c1[1], 0.f); s += wv[pr][1][2] * fmaxf(c1[2], 0.f); s += wv[pr][1][3] * fmaxf(c1[3], 0.f);
                    s += 0.0f;
                    sc[(4 * pr + fq) * SCP + (kb0 + u) * 16 + fr] = s; mn[pr] = fminf(mn[pr], s); mx[pr] = fmaxf(mx[pr], s);
                }
#pragma unroll
            for (int u = 0; u < 4; ++u) bfr[u] = nfr[u];
        }
#pragma unroll
        for (int pr = 0; pr < 2; ++pr) {
#pragma unroll
            for (int o = 1; o < 16; o <<= 1) { mn[pr] = fminf(mn[pr], __shfl_xor(mn[pr], o)); mx[pr] = fmaxf(mx[pr], __shfl_xor(mx[pr], o)); }
            if (fr == 0) { pm[(wid * 8 + 4 * pr + fq) * 2] = mn[pr]; pm[(wid * 8 + 4 * pr + fq) * 2 + 1] = mx[pr]; }
        }
    }
    __syncthreads();
    constexpr bool PRE_EARLY = !(CONV_IN_TOPK && MOE_FP8) || TK_TILES == 0;
    if (has_next && (PRE_EARLY || !do_b)) topk_prefetch(p, jnext, pn, wid, fr, fq);
#ifndef BREP
#define BREP 1
#endif
    if (do_b) for (int brep_ = 0; brep_ < BREP; ++brep_) {
        const float* row = sc + wid * SCP;
        unsigned long long word = 0ull;
#if CONV_IN_TOPK && MOE_FP8
        f32x4 cv[16]; int cid = -1;
        const int cfirst = blockIdx.x * 8 + __builtin_amdgcn_readfirstlane(wid), cstride = gridDim.x * 8, cn = min((cfirst < NT_W8) ? (NT_W8 - cfirst + cstride - 1) / cstride : 0, TK_TILES);
        qi = __builtin_amdgcn_readfirstlane(qi);
        const int slots = (nj >= 48) ? 3 : (nj >= 24) ? 2 : (nj >= 8) ? 1 : 0;
#define TK_SLOT(more) do { if (cid >= 0) { wt8_store(p, cid, lane, cv); cid = -1; } if ((more) && qi < cn) { cid = cfirst + qi * cstride; ++qi; wt8_load(p, cid, lane, cv); } } while (0)
#else
#define TK_SLOT(more) do { } while (0)
#endif
        if (nj <= 4) { if (lane < nj) word = ~0ull; }
        else {
            float lo = INFINITY, hi = -INFINITY;
#pragma unroll
            for (int i = 0; i < 8; ++i) { lo = fminf(lo, pm[(i * 8 + wid) * 2]); hi = fmaxf(hi, pm[(i * 8 + wid) * 2 + 1]); }
            int need = 256; wsel[lane * 2] = 0u; wsel[lane * 2 + 1] = 0u;
            TK_SLOT(slots >= 1);
            auto level_body = [&](auto first_) -> bool {
                constexpr bool FIRST = decltype(first_)::value;
                if (!(hi > lo)) {
                    for (int jj = 0; jj < nj; ++jj) {
                        const float s = row[jj * 64 + lane]; const unsigned long long em = __ballot(s >= lo && s <= hi);
                        const int ce = __popcll(em); unsigned long long take = em;
                        if (ce > need) { const int rank = __popcll(em & ((1ull << lane) - 1ull)); take = __ballot(((em >> lane) & 1ull) && rank < need); }
                        need -= (ce > need) ? need : ce;
                        if (lane == jj) word |= take;
                    }
                    return true;
                }
                const float scale = 1023.5f / (hi - lo);
#pragma unroll
                for (int i = 0; i < 8; ++i) hist[lane * 8 + i] = 0u;
                asm volatile("s_waitcnt lgkmcnt(0)" ::: "memory");
#pragma unroll 8
                for (int jj = 0; jj < nj; ++jj) {
                    const float s = row[jj * 64 + lane]; const bool part = (s >= lo) && (s <= hi);
                    const unsigned bn = (unsigned)fminf(fmaxf(s - lo, 0.f) * scale, 1023.0f);
                    if (part) lds_add_u32(&hist[bn >> 1], 1u << (16 * (bn & 1u)));
                }
                asm volatile("s_waitcnt lgkmcnt(0)" ::: "memory");
                if constexpr (FIRST) TK_SLOT(slots >= 2);
                unsigned cw[8]; int cl = 0;
#pragma unroll
                for (int i = 0; i < 8; ++i) { cw[i] = hist[lane * 8 + i]; cl += (int)(cw[i] & 0xffffu) + (int)(cw[i] >> 16); }
                int inc = cl;
#pragma unroll
                for (int d = 1; d < 64; d <<= 1) { const int o = __shfl_down(inc, d); if (lane + d < 64) inc += o; }
                const unsigned long long okm = __ballot(inc >= need);
                const int L = 63 - __builtin_clzll(okm);
                int bstar_v = 0, above_v = 0;
                { int run = inc - cl; bool found = false;
#pragma unroll
                  for (int bq = 15; bq >= 0; --bq) { const int cnt = (int)((cw[bq >> 1] >> (16 * (bq & 1))) & 0xffffu); if (!found && run + cnt >= need) { found = true; bstar_v = lane * 16 + bq; above_v = run; } run += cnt; } }
                const unsigned bstar = (unsigned)__shfl(bstar_v, L); const int above = __shfl(above_v, L);
                need -= above;
                int base = 0; float cmn = INFINITY, cmx = -INFINITY;
#pragma unroll 4
                for (int jj = 0; jj < nj; ++jj) {
                    const float s = row[jj * 64 + lane]; const bool part = (s >= lo) && (s <= hi);
                    const unsigned bn = (unsigned)fminf(fmaxf(s - lo, 0.f) * scale, 1023.0f);
                    const bool gt = part && bn > bstar, eq = part && bn == bstar;
                    const unsigned long long gm = __ballot(gt), em = __ballot(eq);
                    if (lane == jj) word |= gm;
                    if (em) {
                        const int pos = base + (int)__builtin_amdgcn_mbcnt_hi((unsigned)(em >> 32), __builtin_amdgcn_mbcnt_lo((unsigned)em, 0u));
                        if (eq) { cmn = fminf(cmn, s); cmx = fmaxf(cmx, s); if (pos < 64) { cval[pos] = s; cidx[pos] = jj * 64 + lane; } }
                        base += __popcll(em);
                    }
                }
                if constexpr (FIRST) TK_SLOT(slots >= 3);
                if (base <= 64) {
                    asm volatile("s_waitcnt lgkmcnt(0)" ::: "memory");
                    if (lane < base) {
                        const float v = cval[lane]; const int id = cidx[lane]; int rank = 0;
                        for (int q = 0; q < base; ++q) { const float ov = cval[q]; rank += (ov > v || (ov == v && q < lane)) ? 1 : 0; }
                        if (rank < need) lds_or_u32(&wsel[(id >> 6) * 2 + ((id >> 5) & 1)], 1u << (id & 31));
                    }
                    asm volatile("s_waitcnt lgkmcnt(0)" ::: "memory");
                    word |= ((unsigned long long)wsel[lane * 2 + 1] << 32) | (unsigned long long)wsel[lane * 2];
                    return true;
                }
#pragma unroll
                for (int o = 32; o > 0; o >>= 1) { cmn = fminf(cmn, __shfl_xor(cmn, o)); cmx = fmaxf(cmx, __shfl_xor(cmx, o)); }
                lo = cmn; hi = cmx; return false;
            };
            if (!level_body(std::integral_constant<bool, true>{})) for (int level = 1; level < 16; ++level) if (level_body(std::integral_constant<bool, false>{})) break;
        }
#if CONV_IN_TOPK && MOE_FP8
        if (!PRE_EARLY && has_next && brep_ == BREP - 1) topk_prefetch(p, jnext, pn, wid, fr, fq);
#endif
        TK_SLOT(false);
        if (lane < nj) p.mask[(size_t)(t0 + wid) * 64 + lane] = word;
#undef TK_SLOT
    }
    __syncthreads();
}

__device__ __forceinline__ void mlstm_scan(const Params& p, int item) {
    const int tid = tid_opaque(), bh = item >> 4, sl = item & 15, idx = sl * 1024 + 2 * tid;
    float C0 = 0.f, C1 = 0.f, m = 0.f, nn = 0.f; const bool don = (sl == 0 && tid < 128);
    const bf16_t* __restrict__ utp = p.ut + (size_t)bh * 64 * 16384 + idx; bf16_t* __restrict__ csp = p.cst + (size_t)bh * 64 * 16384 + idx;
    for (int c0 = 0; c0 < 64; c0 += 16) {
        unsigned uu[16]; float nu[16];
#pragma unroll
        for (int i = 0; i < 16; ++i) { uu[i] = *(const unsigned*)(utp + (size_t)(c0 + i) * 16384); nu[i] = don ? p.nu[(bh * 64 + c0 + i) * 128 + tid] : 0.f; }
#pragma unroll
        for (int i = 0; i < 16; ++i) {
            const int it = bh * 64 + c0 + i; const float bl = p.bl[it], ml = p.mloc[it];
            *(unsigned*)(csp + (size_t)(c0 + i) * 16384) = pk2(C0, C1);
            if (don) { p.ns[it * 128 + tid] = nn; if (tid == 0) p.ms[it] = m; }
            const float mnew = fmaxf(bl + m, ml); const float dec = __expf(bl + m - mnew), su = __expf(ml - mnew);
            C0 = dec * C0 + su * __uint_as_float(uu[i] << 16); C1 = dec * C1 + su * __uint_as_float(uu[i] & 0xffff0000u); nn = dec * nn + su * nu[i]; m = mnew;
        }
    }
}

typedef __bf16 bf16x2_v __attribute__((ext_vector_type(2)));
__device__ __forceinline__ float dot2_ones(unsigned pair, float acc) { return __builtin_amdgcn_fdot2_f32_bf16(__builtin_bit_cast(bf16x2_v, pair), __builtin_bit_cast(bf16x2_v, 0x3f803f80u), acc, false); }
__device__ __forceinline__ void attn_unit(const Params& p, int b, int g, int c, unsigned char* lds, HostQ& wq) {
    const int tid = tid_opaque(), wid = tid >> 6, lane = tid & 63, r32 = lane & 31, hi = lane >> 5;
    const int hq = g * 4 + (wid & 3), tq = (wid >> 2) * 32 + r32, t0 = b * SEQ + c * 64, trow = t0 + tq;
    bf16_t* ktl = (bf16_t*)lds;
    bf16_t* vtl = ktl + 2 * 64 * 72;
    const float C2 = 0.125f * 1.4426950408889634f;
    bf16x8 qf[4];
#pragma unroll
    for (int ds = 0; ds < 4; ++ds) qf[ds] = *(const bf16x8*)(p.proj + (size_t)trow * PP + C_AQ + hq * 64 + ds * 16 + hi * 8);
    f32x16 o0, o1;
#pragma unroll
    for (int r = 0; r < 16; ++r) { o0[r] = 0.f; o1[r] = 0.f; }
    float m_run = -INFINITY, lsum = 0.f;
    const int ntiles = c + 1, srow = tid >> 3, sch = tid & 7;
    const bf16_t* kbase = p.proj + (size_t)(b * SEQ + srow) * PP + C_AK + g * 64 + sch * 8;
    const bf16_t* vbase = p.vt + ((size_t)((b * 2 + g) * 64 + srow)) * SEQ + sch * 8;
    u32x4 kreg = *(const u32x4*)kbase, vreg = *(const u32x4*)vbase;
    *(u32x4*)(ktl + srow * 72 + sch * 8) = kreg; *(u32x4*)(vtl + srow * 72 + sch * 8) = vreg;
    if (ntiles > 1) { kreg = *(const u32x4*)(kbase + (size_t)64 * PP); *(u32x4*)(ktl + 64 * 72 + srow * 72 + sch * 8) = kreg; }
    __syncthreads();
    const unsigned long long* mrow = p.mask + (size_t)trow * 64;
    unsigned long long W0 = mrow[0], W1 = (ntiles > 1) ? mrow[1] : 0ull;
    f32x16 p0, p1;
#pragma unroll
    for (int r = 0; r < 16; ++r) { p0[r] = 0.f; p1[r] = 0.f; }
#pragma unroll
    for (int ds = 0; ds < 4; ++ds) {
        const bf16x8 a0 = *(const bf16x8*)(ktl + r32 * 72 + ds * 16 + hi * 8), a1 = *(const bf16x8*)(ktl + (r32 + 32) * 72 + ds * 16 + hi * 8);
        p0 = mfma32(a0, qf[ds], p0); p1 = mfma32(a1, qf[ds], p1);
    }
    f32x16 q0, q1;
    f32x4 cv[8]; (void)cv;
    auto step = [&](f32x16& p0, f32x16& p1, f32x16& n0, f32x16& n1, const int tile, auto mode_, const int hid) {
        constexpr int MODE = decltype(mode_)::value;
        const int cur = tile & 1;
        if (tile + 2 < ntiles) kreg = *(const u32x4*)(kbase + (size_t)(tile + 2) * 64 * PP);
        if (tile + 1 < ntiles) vreg = *(const u32x4*)(vbase + (tile + 1) * 64);
        const unsigned long long W = W0; W0 = W1; if (tile + 2 < ntiles) W1 = mrow[tile + 2];
        if constexpr (MODE == 1) wh8_load(p, hid, lane, cv);
        const bf16_t* vt = vtl + cur * 64 * 72;
#pragma unroll
        for (int r = 0; r < 16; ++r) { n0[r] = 0.f; n1[r] = 0.f; }
        if (tile + 1 < ntiles) {
            const bf16_t* kt = ktl + (cur ^ 1) * 64 * 72;
#pragma unroll
            for (int ds = 0; ds < 4; ++ds) {
                const bf16x8 a0 = *(const bf16x8*)(kt + r32 * 72 + ds * 16 + hi * 8), a1 = *(const bf16x8*)(kt + (r32 + 32) * 72 + ds * 16 + hi * 8);
                n0 = mfma32(a0, qf[ds], n0); n1 = mfma32(a1, qf[ds], n1);
            }
        }
#ifdef ATT_X1
        { f32x16 z0, z1;
#pragma unroll
          for (int r = 0; r < 16; ++r) { z0[r] = 0.f; z1[r] = 0.f; }
#pragma unroll
          for (int ds = 0; ds < 4; ++ds) { z0 = mfma32(qf[ds], qf[(ds + 1) & 3], z0); z1 = mfma32(qf[(ds + 2) & 3], qf[ds], z1); }
          asm volatile("" :: "v"(z0), "v"(z1)); }
#endif
#ifdef ATT_X2
        { float d0 = p0[0], d1 = p1[0];
#pragma unroll
          for (int r = 0; r < 32; ++r) { asm volatile("v_max_f32_e32 %0, %0, %1" : "+v"(d0) : "v"(p0[r & 15])); asm volatile("v_add_f32_e32 %0, %0, %1" : "+v"(d1) : "v"(p1[r & 15])); }
          asm volatile("" :: "v"(d0), "v"(d1)); }
#endif
        const unsigned wlo = (unsigned)W >> (4 * hi), whi = (unsigned)(W >> 32) >> (4 * hi);
        float mx = -INFINITY;
#pragma unroll
        for (int r = 0; r < 16; ++r) { const int kl = (r & 3) + 8 * (r >> 2);
            const unsigned m0 = (unsigned)__builtin_amdgcn_sbfe((int)wlo, kl, 1), m1 = (unsigned)__builtin_amdgcn_sbfe((int)whi, kl, 1);
            p0[r] = __uint_as_float((m0 & __float_as_uint(p0[r])) | (~m0 & 0xff800000u)); p1[r] = __uint_as_float((m1 & __float_as_uint(p1[r])) | (~m1 & 0xff800000u));
            asm("v_max3_f32 %0, %0, %1, %2" : "+v"(mx) : "v"(p0[r]), "v"(p1[r])); }
        mx = fmaxf(mx, __shfl_xor(mx, 32));
        const float mnew = fmaxf(m_run, mx); const float muse = (mnew == -INFINITY) ? 0.f : mnew;
        const float alpha = __builtin_amdgcn_exp2f((m_run - muse) * C2); m_run = mnew;
        const float ms = muse * C2; float ps = 0.f;
#pragma unroll
        for (int r = 0; r < 16; ++r) { p0[r] = __builtin_amdgcn_exp2f(p0[r] * C2 - ms); p1[r] = __builtin_amdgcn_exp2f(p1[r] * C2 - ms); ps += p0[r] + p1[r]; }
        if (__any(alpha != 1.0f)) {
#pragma unroll
            for (int r = 0; r < 16; ++r) { o0[r] *= alpha; o1[r] *= alpha; }
        }
#pragma unroll
        for (int ks = 0; ks < 4; ++ks) {
            u32x4 bw;
            if (ks == 0) { bw.x = pk2(p0[0], p0[1]); bw.y = pk2(p0[2], p0[3]); bw.z = pk2(p0[4], p0[5]); bw.w = pk2(p0[6], p0[7]); }
            else if (ks == 1) { bw.x = pk2(p0[8], p0[9]); bw.y = pk2(p0[10], p0[11]); bw.z = pk2(p0[12], p0[13]); bw.w = pk2(p0[14], p0[15]); }
            else if (ks == 2) { bw.x = pk2(p1[0], p1[1]); bw.y = pk2(p1[2], p1[3]); bw.z = pk2(p1[4], p1[5]); bw.w = pk2(p1[6], p1[7]); }
            else { bw.x = pk2(p1[8], p1[9]); bw.y = pk2(p1[10], p1[11]); bw.z = pk2(p1[12], p1[13]); bw.w = pk2(p1[14], p1[15]); }
            const bf16x8 bfrag = __builtin_bit_cast(bf16x8, bw);
            const bf16x8 a0 = *(const bf16x8*)(vt + r32 * 72 + ks * 16 + hi * 8), a1 = *(const bf16x8*)(vt + (r32 + 32) * 72 + ks * 16 + hi * 8);
            o0 = mfma32(a0, bfrag, o0); o1 = mfma32(a1, bfrag, o1);
        }
        lsum = lsum * alpha + ps;
        if constexpr (MODE == 2) { if (hid >= 0) wh8_store(p, hid, lane, cv); }
        if (tile + 2 < ntiles) *(u32x4*)(ktl + cur * 64 * 72 + srow * 72 + sch * 8) = kreg;
        if (tile + 1 < ntiles) *(u32x4*)(vtl + (cur ^ 1) * 64 * 72 + srow * 72 + sch * 8) = vreg;
        __syncthreads();
    };
    typedef std::integral_constant<int, 0> M0; typedef std::integral_constant<int, 1> M1; typedef std::integral_constant<int, 2> M2;
    for (int tile = 0; tile < ntiles; tile += 2) {
        if (tile + 1 < ntiles) {
            const bool hv = wq.i < wq.n; const int hid = hostq_id(wq, hv ? wq.i : 0); wq.i += hv ? 1 : 0;
            step(p0, p1, q0, q1, tile, M1{}, hid); step(q0, q1, p0, p1, tile + 1, M2{}, hv ? hid : -1);
        } else step(p0, p1, q0, q1, tile, M0{}, 0);
    }
    lsum += __shfl_xor(lsum, 32);
    const float inv = 1.0f / lsum;
    bf16_t* orow = p.mix + (size_t)trow * 1024 + hq * 64;
#pragma unroll
    for (int r4 = 0; r4 < 4; ++r4) {
        const int d = 8 * r4 + 4 * hi; u32x2 w0, w1;
        w0.x = pk2(o0[4 * r4] * inv, o0[4 * r4 + 1] * inv); w0.y = pk2(o0[4 * r4 + 2] * inv, o0[4 * r4 + 3] * inv);
        w1.x = pk2(o1[4 * r4] * inv, o1[4 * r4 + 1] * inv); w1.y = pk2(o1[4 * r4 + 2] * inv, o1[4 * r4 + 3] * inv);
        *(u32x2*)(orow + d) = w0; *(u32x2*)(orow + 32 + d) = w1;
    }
}


struct MoPre { u32x4 q[2], k[2], c[4], v[2]; };
__device__ __forceinline__ void mout_prefetch(const Params& p, int item, MoPre& m, int tid) {
    const int bh = item >> 6, c = item & 63, b = bh >> 2, h = bh & 3, t0 = b * SEQ + c * 64, row = tid >> 3, ch = tid & 7;
#pragma unroll
    for (int i = 0; i < 2; ++i) { const int cch = ch + 8 * i;
        m.q[i] = *(const u32x4*)(p.cq + (size_t)(t0 + row) * 512 + h * 128 + cch * 8); m.k[i] = *(const u32x4*)(p.ck + (size_t)(t0 + row) * 512 + h * 128 + cch * 8);
        m.v[i] = *(const u32x4*)(p.proj + (size_t)(t0 + row) * PP + C_MV + h * 128 + cch * 8); }
#pragma unroll
    for (int i = 0; i < 4; ++i) { const int q = tid + 512 * i, e = q >> 4, cch = q & 15; m.c[i] = *(const u32x4*)(p.cst + (size_t)item * 16384 + e * 128 + cch * 8); }
}
template <bool HOST>
__device__ __forceinline__ void mlstm_out(const Params& p, int item, unsigned char* lds, int wtile, const MoPre& mc, MoPre& mn, int next_item, bool has_next) {
    const int tid = tid_opaque(), wid = tid >> 6, lane = tid & 63, fr = lane & 15, fq = lane >> 4;
    const int bh = item >> 6, c = item & 63, b = bh >> 2, h = bh & 3, t0 = b * SEQ + c * 64;
    bf16_t* Ql = (bf16_t*)lds;
    bf16_t* Kl = (bf16_t*)(lds + 17408);
    bf16_t* Vl = (bf16_t*)(lds + 34816);
    bf16_t* CT = (bf16_t*)(lds + 53248);
    float* HB = (float*)(lds + 53248);
    bf16_t* SS = (bf16_t*)(lds + 88064);
    float* bsum = (float*)(lds + 97280); float* aa = bsum + 64; float* mt = aa + 64; float* iwt = mt + 64; float* den = iwt + 64; float* nvec = den + 64;
    {
        const int row = tid >> 3, ch = tid & 7;
#pragma unroll
        for (int i = 0; i < 2; ++i) { const int cch = ch + 8 * i;
            *(u32x4*)(Ql + row * 136 + cch * 8) = mc.q[i]; *(u32x4*)(Kl + row * 136 + cch * 8) = mc.k[i]; *(u32x4*)(Vl + row * 136 + cch * 8) = mc.v[i]; }
#pragma unroll
        for (int i = 0; i < 4; ++i) { const int q = tid + 512 * i, e = q >> 4, cch = q & 15; *(u32x4*)(CT + e * 136 + cch * 8) = mc.c[i]; }
        if (wid == 0) {
            const float bs = p.cb[(size_t)(t0 + lane) * 4 + h], ii = p.mi[(size_t)(t0 + lane) * 4 + h]; const float a = ii - bs; float pm = a;
#pragma unroll
            for (int d = 1; d < 64; d <<= 1) { const float o = __shfl_up(pm, d); if (lane >= d) pm = fmaxf(pm, o); }
            const float mprev = p.ms[item]; const float mtv = bs + fmaxf(mprev, pm);
            bsum[lane] = bs; aa[lane] = a; mt[lane] = mtv; iwt[lane] = __expf(bs + mprev - mtv);
        } else if (wid <= 2) { nvec[tid - 64] = p.ns[(size_t)item * 128 + tid - 64]; }
    }
    __syncthreads();
    if (has_next) mout_prefetch(p, next_item, mn, tid);
    f32x4 cv[16]; (void)cv;
    if constexpr (HOST) wt8_load(p, wtile, lane, cv);
    const int tb = wid >> 1;
    {
#pragma unroll
        for (int sbi = 0; sbi < 2; ++sbi) {
            const int sb = (wid & 1) * 2 + sbi; f32x4 acc = {0.f, 0.f, 0.f, 0.f};
#pragma unroll
            for (int ks = 0; ks < 4; ++ks) { const bf16x8 a = *(const bf16x8*)(Ql + (16 * tb + fr) * 136 + ks * 32 + fq * 8), bb = *(const bf16x8*)(Kl + (16 * sb + fr) * 136 + ks * 32 + fq * 8); acc = mfma16(a, bb, acc); }
            const int s = 16 * sb + fr; const float as = aa[s];
#pragma unroll
            for (int r = 0; r < 4; ++r) { const int t = 16 * tb + 4 * fq + r; const float v = (s <= t) ? acc[r] * __expf(bsum[t] + as - mt[t]) : 0.f; SS[t * 72 + s] = f2bf(v); }
        }
    }
    __syncthreads();
    if (wid == 0) {
        const int t = lane; float s1 = 0.f, s2 = 0.f;
        for (int s = 0; s < 64; ++s) s1 += bf2f(SS[t * 72 + s]);
        for (int d = 0; d < 128; ++d) s2 += bf2f(Ql[t * 136 + d]) * nvec[d];
        den[t] = s1 + iwt[t] * s2;
    }
    f32x4 num[4];
#pragma unroll
    for (int ebi = 0; ebi < 4; ++ebi) {
        const int eb = (wid & 1) * 4 + ebi; f32x4 a1 = {0.f, 0.f, 0.f, 0.f}, a2 = {0.f, 0.f, 0.f, 0.f};
#pragma unroll
        for (int ks = 0; ks < 2; ++ks) { const bf16x8 a = *(const bf16x8*)(SS + (16 * tb + fr) * 72 + ks * 32 + fq * 8), bb = tr_frag(Vl, 136, 32 * ks, 16 * eb, lane); a1 = mfma16(a, bb, a1); }
#pragma unroll
        for (int ks = 0; ks < 4; ++ks) { const bf16x8 a = *(const bf16x8*)(Ql + (16 * tb + fr) * 136 + ks * 32 + fq * 8), bb = *(const bf16x8*)(CT + (16 * eb + fr) * 136 + ks * 32 + fq * 8); a2 = mfma16(a, bb, a2); }
#pragma unroll
        for (int r = 0; r < 4; ++r) num[ebi][r] = a1[r] + iwt[16 * tb + 4 * fq + r] * a2[r];
    }
    __syncthreads();
#pragma unroll
    for (int ebi = 0; ebi < 4; ++ebi) {
        const int e = 16 * ((wid & 1) * 4 + ebi) + fr;
#pragma unroll
        for (int r = 0; r < 4; ++r) { const int t = 16 * tb + 4 * fq + r; const float dn = fmaxf(fabsf(den[t]), __expf(-mt[t])); HB[t * 132 + e] = num[ebi][r] / dn; }
    }
    __syncthreads();
    if constexpr (HOST) wt8_store(p, wtile, lane, cv);
    {
        const int t = tid >> 3, e16 = (tid & 7) * 16; float hv[16]; float ss = 0.f;
#pragma unroll
        for (int i = 0; i < 16; ++i) { hv[i] = HB[t * 132 + e16 + i]; ss += hv[i] * hv[i]; }
        ss += __shfl_xor(ss, 1); ss += __shfl_xor(ss, 2); ss += __shfl_xor(ss, 4);
        const float rs = 1.0f / sqrtf(ss * (1.0f / 128.0f) + NORM_EPS);
        float mo[16]; const bf16_t* rm = p.proj + (size_t)(t0 + t) * PP + C_MO + h * 128 + e16; unpack8(*(const u32x4*)rm, mo); unpack8(*(const u32x4*)(rm + 8), mo + 8);
        const float* nw = p.mlstm_norm_w + h * 128 + e16; float o[16];
#pragma unroll
        for (int i = 0; i < 16; ++i) o[i] = hv[i] * rs * nw[i] * sigmoidf_(mo[i]);
        { const size_t ob = ((size_t)(t0 + t) * 1024 + 512 + h * 128 + e16) * 2; store16_wt(p.mix, ob, pack8(o)); store16_wt(p.mix, ob + 16, pack8(o + 8)); }
    }
    __syncthreads();
}

__device__ __forceinline__ void compute_tstart(const Params& p, int* ts) {
    if (threadIdx.x == 0) { int a = 0; for (int e = 0; e < NEXP; ++e) { ts[e] = a; a += (p.cnt[e] + 255) >> 8; } ts[NEXP] = a; }
    __syncthreads();
}

__device__ __forceinline__ void scatter_tokens(const Params& p, const int* ts, int t_begin, int t_end, int wid, int lane) {
    constexpr int NTK = 4;
    float4 nw[4];
#pragma unroll
    for (int i = 0; i < 4; ++i) nw[i] = *(const float4*)(p.ffn_norm_w + i * 256 + lane * 4);
    for (int t0 = t_begin + wid; t0 < t_end; t0 += 8 * NTK) {
        int tt[NTK]; float rs[NTK]; u32x2 xa[NTK][4]; size_t dst[NTK][4];
#pragma unroll
        for (int j = 0; j < NTK; ++j) { tt[j] = min(t0 + 8 * j, t_end - 1); rs[j] = p.rsv[tt[j]];
#pragma unroll
            for (int i = 0; i < 4; ++i) xa[j][i] = *(const u32x2*)(p.x1 + (size_t)tt[j] * DM + i * 256 + lane * 4);
#pragma unroll
            for (int k = 0; k < 4; ++k) { const int e = p.tope[tt[j] * 4 + k]; dst[j][k] = (size_t)ts[e] * 256 + p.topp[tt[j] * 4 + k]; } }
#pragma unroll
        for (int j = 0; j < NTK; ++j) {
            if (t0 + 8 * j >= t_end) break;
            u32x2 h[4]; unsigned h8[4];
#pragma unroll
            for (int i = 0; i < 4; ++i) { const float4 w = nw[i];
                const float4 a = make_float4(__uint_as_float(xa[j][i].x << 16), __uint_as_float(xa[j][i].x & 0xffff0000u), __uint_as_float(xa[j][i].y << 16), __uint_as_float(xa[j][i].y & 0xffff0000u));
                h[i].x = pk2(a.x * rs[j] * w.x, a.y * rs[j] * w.y); h[i].y = pk2(a.z * rs[j] * w.z, a.w * rs[j] * w.w);
                h8[i] = pk4_fp8(a.x * rs[j] * w.x * FP8_XS, a.y * rs[j] * w.y * FP8_XS, a.z * rs[j] * w.z * FP8_XS, a.w * rs[j] * w.w * FP8_XS); }
#pragma unroll
            for (int k = 0; k < 4; ++k) {
#if MOE_FP8
#pragma unroll
                for (int i = 0; i < 4; ++i) *(unsigned*)((unsigned char*)p.xbuf + dst[j][k] * DM + i * 256 + lane * 4) = h8[i];
#else
#pragma unroll
                for (int i = 0; i < 4; ++i) *(u32x2*)(p.xbuf + dst[j][k] * DM + i * 256 + lane * 4) = h[i];
#endif
            }
        }
    }
}

__device__ __forceinline__ void router_phase(const Params& p, unsigned char* lds) {
    const int tid = tid_opaque(), wid = tid >> 6, lane = tid & 63, fr = lane & 15, fq = lane >> 4;
    constexpr int RWS = 36;
    float* rw = (float*)lds;
    unsigned char* ex = lds + 1024 * RWS * 4;
    float* lg = (float*)ex;
    float* rsq = lg + 64 * 33;
    int* lcnt = (int*)(rsq + 64); int* lbase = lcnt + 32;
    float* selv = (float*)(lbase + 32);
    int* sele = (int*)(selv + 256);
    int* info = sele + 256;
    float* ginfo = (float*)(info + 512);
    {
        float4 rv[16]; float nv[16];
#pragma unroll
        for (int q = 0; q < 16; ++q) { const int i4 = tid + q * NTHREADS; rv[q] = ((const float4*)p.router_w)[i4]; nv[q] = p.ffn_norm_w[i4 >> 3]; }
#pragma unroll
        for (int q = 0; q < 16; ++q) { const int i4 = tid + q * NTHREADS, d = i4 >> 3, e = (i4 & 7) * 4; *(float4*)(rw + d * RWS + e) = make_float4(rv[q].x * nv[q], rv[q].y * nv[q], rv[q].z * nv[q], rv[q].w * nv[q]); }
    }
    __syncthreads();
    for (int grp = blockIdx.x; grp < T_TOK / 64; grp += gridDim.x) {
        if (tid < 32) lcnt[tid] = 0;
        {
            const int tb = (wid & 3) * 16, half = wid >> 2;
            const bf16_t* xr = p.x1 + ((size_t)grp * 64 + tb + fr) * DM + fq * 8; const float* rwp = rw + (fq * 8) * RWS + half * 16 + fr;
            f32x4 acc = {0.f, 0.f, 0.f, 0.f}; float ssq = 0.f;
#pragma unroll 4
            for (int kk = 0; kk < 32; ++kk) {
                const u32x4 xa = *(const u32x4*)(xr + kk * 32); float a[8]; unpack8(xa, a);
                const float* rr = rwp + kk * 32 * RWS;
#pragma unroll
                for (int j = 0; j < 8; ++j) { ssq += a[j] * a[j]; acc = __builtin_amdgcn_mfma_f32_16x16x4f32(a[j], rr[j * RWS], acc, 0, 0, 0); }
            }
            ssq += __shfl_xor(ssq, 16); ssq += __shfl_xor(ssq, 32);
            if (half == 0 && fq == 0) { const float rs = 1.0f / sqrtf(ssq * (1.0f / DM) + NORM_EPS); rsq[tb + fr] = rs; p.rsv[(size_t)grp * 64 + tb + fr] = rs; }
#pragma unroll
            for (int r = 0; r < 4; ++r) lg[(tb + 4 * fq + r) * 33 + half * 16 + fr] = acc[r];
        }
        __syncthreads();
        for (int rd = 0; rd < 4; ++rd) {
            const int tl = wid * 8 + rd * 2 + (lane >> 5), e = lane & 31; float* l = lg + tl * 33;
            const float v = l[e] * rsq[tl] + p.router_b[e];
            l[e] = v;
            int rank = 0;
#pragma unroll
            for (int o = 0; o < 32; ++o) { const float ov = l[o]; rank += (ov > v || (ov == v && o < e)) ? 1 : 0; }
            if (rank < 4) { selv[tl * 4 + rank] = v; sele[tl * 4 + rank] = e; }
            if (e < 4) {
                const float* sv = selv + tl * 4; const float v0 = sv[0]; const float e1 = __expf(sv[1] - v0), e2 = __expf(sv[2] - v0), e3 = __expf(sv[3] - v0); const float sum = 1.0f + e1 + e2 + e3;
                const float mine = (e == 0 ? 1.0f : e == 1 ? e1 : e == 2 ? e2 : e3) / sum; const int ex_ = sele[tl * 4 + e];
                const int lp = atomicAdd(&lcnt[ex_], 1);
                info[(tl * 4 + e) * 2] = ex_; info[(tl * 4 + e) * 2 + 1] = lp; ginfo[tl * 4 + e] = mine;
            }
        }
        __syncthreads();
        if (tid < 32) lbase[tid] = atomicAdd(&p.cnt[tid], lcnt[tid]);
        __syncthreads();
        if (tid < 256) { const int e = info[tid * 2], lp = info[tid * 2 + 1]; const size_t o = (size_t)grp * 256 + tid; p.tope[o] = e; p.topp[o] = lbase[e] + lp; p.topg[o] = ginfo[tid]; }
        __syncthreads();
    }
    asm volatile("s_waitcnt vmcnt(0)" ::: "memory");
    __syncthreads();
    if (tid == 0) {
        const int mine = (T_TOK / 64 - (int)blockIdx.x + (int)gridDim.x - 1) / (int)gridDim.x;
        __builtin_amdgcn_fence(__ATOMIC_RELEASE, "agent"); asm volatile("s_waitcnt vmcnt(0)" ::: "memory");
        __hip_atomic_fetch_add((unsigned*)&p.cnt[32], (unsigned)mine, __ATOMIC_RELAXED, __HIP_MEMORY_SCOPE_AGENT);
        unsigned sp = 0;
        while (__hip_atomic_load((unsigned*)&p.cnt[32], __ATOMIC_RELAXED, __HIP_MEMORY_SCOPE_AGENT) < (unsigned)(T_TOK / 64)) { __builtin_amdgcn_s_sleep(2); if (++sp > (1u << 22)) break; }
        __builtin_amdgcn_fence(__ATOMIC_ACQUIRE, "agent"); asm volatile("s_waitcnt vmcnt(0)" ::: "memory");
    }
    __syncthreads();
    int* ts = (int*)lds;
    compute_tstart(p, ts);
    for (int grp = blockIdx.x; grp < T_TOK / 64; grp += gridDim.x) scatter_tokens(p, ts, grp * 64, grp * 64 + 64, wid, lane);
}

__device__ __forceinline__ void combine_phase(const Params& p, unsigned char* lds) {
    const int tid = tid_opaque(), wid = tid >> 6, lane = tid & 63; int* ts = (int*)lds;
    compute_tstart(p, ts);
    const unsigned char* Y = (const unsigned char*)p.ybuf;
    constexpr int NTK = 4;
    const int tstride = gridDim.x * 8;
    for (int t0 = blockIdx.x * 8 + wid; t0 < T_TOK; t0 += tstride * NTK) {
        int tt[NTK]; size_t src[NTK][4]; float gs[NTK][4];
#pragma unroll
        for (int j = 0; j < NTK; ++j) { tt[j] = min(t0 + j * tstride, T_TOK - 1);
#pragma unroll
            for (int k = 0; k < 4; ++k) { const int e = p.tope[tt[j] * 4 + k]; src[j][k] = (size_t)ts[e] * 256 + p.topp[tt[j] * 4 + k]; gs[j][k] = p.topg[tt[j] * 4 + k] * (Y_FP8 ? 1.0f / FP8_YS : 1.0f); } }
        u32x2 xa[NTK][4];
#if Y_FP8
        unsigned yw[NTK][4][4];
#else
        u32x2 yw[NTK][4][4];
#endif
#pragma unroll
        for (int j = 0; j < NTK; ++j) {
#pragma unroll
            for (int i = 0; i < 4; ++i) xa[j][i] = *(const u32x2*)(p.x1 + (size_t)tt[j] * DM + i * 256 + lane * 4);
#pragma unroll
            for (int k = 0; k < 4; ++k)
#pragma unroll
                for (int i = 0; i < 4; ++i) {
#if Y_FP8
                    yw[j][k][i] = __builtin_nontemporal_load((const unsigned*)(Y + src[j][k] * DM + i * 256 + lane * 4));
#else
                    yw[j][k][i] = __builtin_nontemporal_load((const u32x2*)(Y + (src[j][k] * DM + i * 256 + lane * 4) * 2));
#endif
                }
        }
#pragma unroll
        for (int j = 0; j < NTK; ++j) {
            float v[16];
#pragma unroll
            for (int i = 0; i < 4; ++i) { v[4 * i] = __uint_as_float(xa[j][i].x << 16); v[4 * i + 1] = __uint_as_float(xa[j][i].x & 0xffff0000u); v[4 * i + 2] = __uint_as_float(xa[j][i].y << 16); v[4 * i + 3] = __uint_as_float(xa[j][i].y & 0xffff0000u); }
#pragma unroll
            for (int k = 0; k < 4; ++k)
#pragma unroll
                for (int i = 0; i < 4; ++i) {
#if Y_FP8
                    const int w = (int)yw[j][k][i];
                    v[4 * i] += gs[j][k] * __builtin_amdgcn_cvt_f32_fp8(w, 0); v[4 * i + 1] += gs[j][k] * __builtin_amdgcn_cvt_f32_fp8(w, 1); v[4 * i + 2] += gs[j][k] * __builtin_amdgcn_cvt_f32_fp8(w, 2); v[4 * i + 3] += gs[j][k] * __builtin_amdgcn_cvt_f32_fp8(w, 3);
#else
                    const u32x2 w = yw[j][k][i];
                    v[4 * i] += gs[j][k] * __uint_as_float(w.x << 16); v[4 * i + 1] += gs[j][k] * __uint_as_float(w.x & 0xffff0000u); v[4 * i + 2] += gs[j][k] * __uint_as_float(w.y << 16); v[4 * i + 3] += gs[j][k] * __uint_as_float(w.y & 0xffff0000u);
#endif
                }
            float ss = 0.f;
#pragma unroll
            for (int i = 0; i < 16; ++i) ss += v[i] * v[i];
            ss = wave_sum(ss); const float rs = 1.0f / sqrtf(ss * (1.0f / DM) + NORM_EPS);
            if (t0 + j * tstride < T_TOK) {
#pragma unroll
                for (int i = 0; i < 4; ++i) { const float4 w = *(const float4*)(p.final_norm_w + i * 256 + lane * 4);
                    __builtin_nontemporal_store((f32x4){v[4 * i] * rs * w.x, v[4 * i + 1] * rs * w.y, v[4 * i + 2] * rs * w.z, v[4 * i + 3] * rs * w.w}, (f32x4*)(p.out + (size_t)tt[j] * DM + i * 256 + lane * 4)); }
            }
        }
    }
}

#ifndef MK_SPLIT
#define MK_SPLIT 0
#endif
constexpr int N_PHASES = 11;

__device__ __forceinline__ void run_phase(const Params& p, int ph, unsigned char* lds) {
    typedef __attribute__((address_space(3))) unsigned char* las_ptr;
    const int G = gridDim.x, c = blockIdx.x;
    switch (ph) {
    case 0: phase_prologue(p, lds); break;
    case 1: {
        Gemm g{PROJ_FP8 ? (const bf16_t*)p.xn8 : p.xn, PROJ_FP8 ? (const bf16_t*)p.wt_in8 : p.wt_in, T_TOK, PP, 1024}; pg8::StaticOrder S; S.init(T_TOK, PP, G, c);
        EpiProjT<PROJ_FP8 != 0> E{p.proj, p.ikb, p.iw, p.mi, p.mf, p.ropea, p.ropei, p.igate_b, p.fgate_b};
        const bool conv_first = ((c >> 3) & 1) != 0;
#ifdef PROBE_LOADONLY
        if (conv_first) convert_fp8_loadonly(p);
#endif
        if (conv_first) { if (CONV_WAVES && MOE_FP8 && !CONV_IN_TOPK) convert_fp8_waves(p, 0); convert_streamed(p, lds, 0, streamed_tiles_of_wg()); __syncthreads(); }
        pg8::gemm_phase<EpiProjT<PROJ_FP8 != 0>, pg8::StaticOrder, true, true, PROJ_FP8 != 0>((las_ptr)lds, g, S, E);
        for (int blk = c; blk < T_TOK / 64; blk += G) proj_small(p, blk, lds);
        if (!conv_first) { __syncthreads(); convert_streamed(p, lds, 0, streamed_tiles_of_wg()); if (CONV_WAVES && MOE_FP8 && !CONV_IN_TOPK) convert_fp8_waves(p, 0); }
#ifdef PROBE_LOADONLY
        if (!conv_first) convert_fp8_loadonly(p);
#endif
    } break;
    case 2: {
#ifndef P2A_REP
#define P2A_REP 1
#endif
#ifndef P2C_REP
#define P2C_REP 1
#endif
        for (int r_ = 0; r_ < P2A_REP; ++r_) for (int it = c; it < 1024 + 512; it += G) { if (it < 1024) mlstm_local(p, it, lds); else vtrans(p, it - 1024, lds); }
        for (int r_ = 0; r_ < P2C_REP; ++r_) {
            TopkPre tkc, tkn; const int tid_ = tid_opaque();
            if (c < 2048) topk_prefetch(p, c, tkc, tid_ >> 6, tid_ & 15, (tid_ & 63) >> 4);
            int qi = 0;
            for (int it = c; it < 2048; it += G) { idx_topk(p, it, lds, tkc, tkn, it + G, it + G < 2048, r_ == 0, qi); tkc = tkn; }
#if CONV_IN_TOPK && MOE_FP8
            if (r_ == 0) convert_fp8_rest(p, qi, TK_TILES);
#endif
        }
    } break;
    case 3: {
#ifndef ATTN_UNIT
#define ATTN_UNIT attn_unit
#endif
#ifndef P3A_REP
#define P3A_REP 1
#endif
#ifndef P3B_REP
#define P3B_REP 1
#endif
        for (int r_ = 0; r_ < P3A_REP; ++r_) for (int it = c; it < 256; it += G) mlstm_scan(p, it);
        for (int r_ = 0; r_ < P3B_REP; ++r_) {
            HostQ hq; hq.stride = G * 8; hq.first = c * 8 + __builtin_amdgcn_readfirstlane(tid_opaque() >> 6) + TK_TILES * hq.stride; hq.i = 0;
            hq.n = (CONV_IN_TOPK && MOE_FP8 && hq.first < NT_W8) ? 2 * ((NT_W8 - hq.first + hq.stride - 1) / hq.stride) : 0;
            for (int pi = c; pi < 256; pi += G) { const int b = pi >> 6, g = (pi >> 5) & 1, cp = pi & 31; for (int uu = 0; uu < 2; ++uu) ATTN_UNIT(p, b, g, uu ? cp : 63 - cp, lds, hq); }
            for (; hq.i < hq.n; ++hq.i) { f32x4 v[8]; const int lane_ = tid_opaque() & 63; wh8_load(p, hostq_id(hq, hq.i), lane_, v); wh8_store(p, hostq_id(hq, hq.i), lane_, v); }
        }
    } break;
    case 4: {
        MoPre mc, mn; if (c < 1024) mout_prefetch(p, c, mc, tid_opaque());
        for (int it = c; it < 1024; it += G) { mlstm_out<false>(p, it, lds, 0, mc, mn, it + G, it + G < 1024); mc = mn; }
    } break;
    case 5: {
        Gemm g{p.mix, p.wt_out, T_TOK, 1024, 1024}; pg8::StaticOrder S; S.init(T_TOK, 1024, G, c);
        EpiResid E{p.x, p.x1};
        pg8::gemm_phase<EpiResid, pg8::StaticOrder, true, true>((las_ptr)lds, g, S, E);
    } break;
    case 6: router_phase(p, lds); break;
    case 7: break;
    case 8: {
        int* ts = (int*)(lds + 131072); compute_tstart(p, ts);
        const int upr = (G == 256) ? 32 : 1, nfull = (G == 256) ? ts[NEXP] / upr : 1 << 20;
        Gemm g{p.xbuf, p.wt_gu, XROWS, 2048, 1024}; GroupOrderT<0> S{ts, 8, G, c, 0, nfull, p.rdy, 0}; EpiSwigluT<false> E{p.b_gu, p.act};
        pg8::gemm_phase<EpiSwigluT<false>, GroupOrderT<0>, true, true, MOE_FP8 != 0>((las_ptr)lds, g, S, E);
    } break;
    case 9: {
        int* ts = (int*)(lds + 131072); compute_tstart(p, ts);
        const int nfull = (G == 256) ? ts[NEXP] / 32 : 1 << 20, lim = (G == 256) ? nfull * 32 : 1 << 30;
        if (G == 256) {
            Gemm g{p.xbuf, p.wt_gu, XROWS, 2048, 1024}; GroupOrderT<1> S{ts, 8, G, c, nfull, 1 << 20, p.rdy, 0}; EpiSwigluT<true> E{p.b_gu, p.act};
            pg8::gemm_phase<EpiSwigluT<true>, GroupOrderT<1>, true, true, MOE_FP8 != 0>((las_ptr)lds, g, S, E);
        }
        Gemm g{p.act, p.wt_dn, XROWS, 1024, 1024}; GroupOrderT<2> S{ts, 4, G, c, 0, 1 << 20, p.rdy, lim}; EpiBiasBf16 E{p.b_dn, p.ybuf};
        pg8::gemm_phase<EpiBiasBf16, GroupOrderT<2>, true, true, MOE_FP8 != 0>((las_ptr)lds, g, S, E);
    } break;
    case 10: combine_phase(p, lds); break;
    }
}

#if MK_SPLIT
template <int PH> __global__ void __launch_bounds__(NTHREADS) fwd_phase_kernel(Params p) {
    extern __shared__ __attribute__((aligned(16))) unsigned char lds[];
    run_phase(p, PH, lds);
}
template <int PH> static void launch_phase(const Params& p, hipStream_t stream) {
    (void)hipFuncSetAttribute((const void*)fwd_phase_kernel<PH>, hipFuncAttributeMaxDynamicSharedMemorySize, LDS_BYTES);
    hipLaunchKernelGGL(fwd_phase_kernel<PH>, dim3(256), dim3(NTHREADS), LDS_BYTES, stream, p);
}
#else
#ifndef REP0
#define REP0 1
#endif
#ifndef REP1
#define REP1 1
#endif
#ifndef REP2
#define REP2 1
#endif
#ifndef REP3
#define REP3 1
#endif
#ifndef REP4
#define REP4 1
#endif
#ifndef REP5
#define REP5 1
#endif
#ifndef REP7
#define REP7 1
#endif
#ifndef REP8
#define REP8 1
#endif
#ifndef REP9
#define REP9 1
#endif
#ifndef REP10
#define REP10 1
#endif
__global__ void __launch_bounds__(NTHREADS) fwd_megakernel(Params p) {
    extern __shared__ __attribute__((aligned(16))) unsigned char lds[];
    cg::grid_group grid = cg::this_grid();
    volatile LAS unsigned* xbst = (volatile LAS unsigned*)(lds + LDS_BYTES - 16);
    if (tid_opaque() == 0) { xbst[0] = 0u; xbst[1] = 0u; }
    if (blockIdx.x == 0) for (int i = tid_opaque(); i < XCD_BAR_WORDS; i += NTHREADS) p.bar[i] = 0u;
    __syncthreads();
#ifdef DBG_PH
#define STAMP(k) do { if (blockIdx.x == 0 && tid_opaque() == 0) ((unsigned long long*)(p.cnt + 64))[k] = __builtin_amdgcn_s_memrealtime(); } while (0)
#else
#define STAMP(k) do { } while (0)
#endif
    STAMP(0); run_phase(p, 0, lds); __syncthreads(); grid.sync(); STAMP(1);
    const XcdBarrier xb = xcd_barrier_post(p.bar, xbst);
#define XSYNC() xcd_barrier(xb)
#define RUN(ph, rep) do { for (int r_ = 0; r_ < (rep); ++r_) { run_phase(p, ph, lds); if (r_ + 1 < (rep)) XSYNC(); } } while (0)
    RUN(1, REP1); XSYNC(); STAMP(2); RUN(2, REP2); XSYNC(); STAMP(3); RUN(3, REP3); XSYNC(); STAMP(4); RUN(4, REP4); XSYNC(); STAMP(5); RUN(5, REP5); XSYNC(); STAMP(6);
    run_phase(p, 6, lds); XSYNC(); STAMP(7); STAMP(8); RUN(8, REP8); XSYNC(); STAMP(9); RUN(9, REP9); XSYNC(); STAMP(10); RUN(10, REP10);
#undef RUN
#undef XSYNC
}
#endif

extern "C" void kernel_launch(void* const* d_in, const int* in_sizes, int n_in, void* d_out, int out_size, void* d_ws, size_t ws_size, hipStream_t stream) {
    (void)in_sizes; (void)n_in; (void)out_size;
    Params p{};
    p.x = (const float*)d_in[0]; p.mix_norm_w = (const float*)d_in[1]; p.w_in = (const float*)d_in[2]; p.conv_w = (const float*)d_in[3]; p.conv_b = (const float*)d_in[4];
    p.igate_b = (const float*)d_in[5]; p.fgate_b = (const float*)d_in[6]; p.mlstm_norm_w = (const float*)d_in[7]; p.w_out = (const float*)d_in[8]; p.ffn_norm_w = (const float*)d_in[9];
    p.router_w = (const float*)d_in[10]; p.router_b = (const float*)d_in[11]; p.w_gu = (const float*)d_in[12]; p.b_gu = (const float*)d_in[13]; p.w_dn = (const float*)d_in[14];
    p.b_dn = (const float*)d_in[15]; p.final_norm_w = (const float*)d_in[16];
    p.out = (float*)d_out;
    size_t off = 0; unsigned char* base = (unsigned char*)d_ws;
    auto take = [&](size_t bytes) { unsigned char* r = base + off; off += (bytes + 255) & ~(size_t)255; return r; };
    p.bar = (unsigned*)take(XCD_BAR_WORDS * 4); p.cnt = (int*)take(1024); p.rdy = (unsigned*)take(RDY_WORDS * 4);
    p.wt_in = (bf16_t*)take((size_t)NPW * 1024 * 2); p.wt_out = (bf16_t*)take((size_t)1024 * 1024 * 2);
    p.wt_gu = (bf16_t*)take((size_t)32 * 2048 * 1024 * (MOE_FP8 ? 1 : 2)); p.wt_dn = (bf16_t*)take((size_t)32 * 1024 * 1024 * (MOE_FP8 ? 1 : 2));
    p.xn = (bf16_t*)take((size_t)T_TOK * 1024 * 2); p.proj = (bf16_t*)take((size_t)T_TOK * PP * 2); p.ikb = (bf16_t*)take((size_t)T_TOK * 32 * 2);
    p.vt = (bf16_t*)take((size_t)4 * 2 * 64 * SEQ * 2); p.cq = (bf16_t*)take((size_t)T_TOK * 512 * 2); p.ck = (bf16_t*)take((size_t)T_TOK * 512 * 2);
    p.cst = (bf16_t*)take((size_t)1024 * 16384 * 2); p.mix = (bf16_t*)take((size_t)T_TOK * 1024 * 2);
    p.xbuf = (bf16_t*)take((size_t)XROWS * 1024 * (MOE_FP8 ? 1 : 2)); p.act = (bf16_t*)take((size_t)XROWS * 1024 * (MOE_FP8 ? 1 : 2));
    p.ybuf = (MOE_FP8 ? (bf16_t*)take((size_t)XROWS * 1024 * 2) : p.xbuf);
    p.xn8 = take((size_t)T_TOK * 1024); p.wt_in8 = take((size_t)PP * 1024);
    p.iw = (float*)take((size_t)T_TOK * 8 * 4); p.mi = (float*)take((size_t)T_TOK * 4 * 4); p.mf = (float*)take((size_t)T_TOK * 4 * 4); p.cb = (float*)take((size_t)T_TOK * 4 * 4);
    p.ropea = (float*)take((size_t)SEQ * 16 * 4); p.ropei = (float*)take((size_t)SEQ * 8 * 4);
    p.ut = (bf16_t*)take((size_t)1024 * 16384 * 2); p.nu = (float*)take((size_t)1024 * 128 * 4); p.bl = (float*)take(1024 * 4); p.mloc = (float*)take(1024 * 4);
    p.ns = (float*)take((size_t)1024 * 128 * 4); p.ms = (float*)take(1024 * 4); p.x1 = (bf16_t*)take((size_t)T_TOK * 1024 * 2); p.topg = (float*)take((size_t)T_TOK * 4 * 4); p.rsv = (float*)take((size_t)T_TOK * 4);
    p.mask = (unsigned long long*)take((size_t)T_TOK * 64 * 8); p.tope = (int*)take((size_t)T_TOK * 4 * 4); p.topp = (int*)take((size_t)T_TOK * 4 * 4);
    if (off > ws_size) { fprintf(stderr, "workspace too small: need %zu have %zu\n", off, ws_size); return; }
#if MK_SPLIT
    launch_phase<0>(p, stream); launch_phase<1>(p, stream); launch_phase<2>(p, stream); launch_phase<3>(p, stream); launch_phase<4>(p, stream); launch_phase<5>(p, stream);
    launch_phase<6>(p, stream); launch_phase<7>(p, stream); launch_phase<8>(p, stream); launch_phase<9>(p, stream); launch_phase<10>(p, stream);
#else
    static int grid_blocks = 0;
    if (!grid_blocks) {
        int dev = 0, cus = 0, per_cu = 0;
        (void)hipGetDevice(&dev); (void)hipDeviceGetAttribute(&cus, hipDeviceAttributeMultiprocessorCount, dev);
        (void)hipFuncSetAttribute((const void*)fwd_megakernel, hipFuncAttributeMaxDynamicSharedMemorySize, LDS_BYTES);
        (void)hipOccupancyMaxActiveBlocksPerMultiprocessor(&per_cu, fwd_megakernel, NTHREADS, LDS_BYTES);
        if (per_cu < 1) fprintf(stderr, "occupancy query returned %d blocks per CU\n", per_cu);
        grid_blocks = cus;
    }
    void* args[] = {&p};
    hipError_t e = hipLaunchCooperativeKernel((void*)fwd_megakernel, dim3(grid_blocks), dim3(NTHREADS), args, LDS_BYTES, stream);
    if (e != hipSuccess) fprintf(stderr, "cooperative launch failed: %s (grid %d)\n", hipGetErrorString(e), grid_blocks);
#endif
}
```

```cpp
#include <hip/hip_runtime.h>
#include <hip/hip_cooperative_groups.h>
#include <cstdio>
#include <cstdint>
namespace cg = cooperative_groups;

__device__ __forceinline__ int tid_opaque() { int t = threadIdx.x; asm volatile("" : "+v"(t)); return t; }
namespace pg8 {
#define PG8_LAS __attribute__((address_space(3)))
typedef unsigned short bf16_t;
typedef short bf16x8 __attribute__((ext_vector_type(8)));
typedef float f32x4 __attribute__((ext_vector_type(4)));
typedef unsigned u32x4 __attribute__((ext_vector_type(4)));
constexpr int BM = 256, BK = 64, HALF = 128, HTB = HALF * BK * 2  , STAGE_BYTES = 8 * HTB, NXCD = 8, WGM = 8;

__host__ __device__ __forceinline__ int lds_byte(int r, int c) { const int st = (r >> 4) * 2 + (c >> 5), rr = r & 15, cc = c & 31, ob = rr * 64 + cc * 2; return st * 1024 + (ob ^ (((ob >> 9) & 1) << 5)); }
__host__ __device__ __forceinline__ void stage_rc(int b, int& R, int& C) { const int st = b / 1024, sb = b % 1024, swz = sb ^ (((sb >> 9) & 1) << 5); R = (st >> 1) * 16 + swz / 64; C = (st & 1) * 32 + (swz % 64) / 2; }
__host__ __device__ __forceinline__ int perm32(int rho) { const int n = rho >> 4, i = rho & 15; return 8 * (i >> 2) + 4 * n + (i & 3); }

struct Unit { int pm, pn, pb, ex; };
struct Gemm { const bf16_t* A; const bf16_t* Bt; int M, N, K; };

struct StaticOrder {
    int nM, nN, nwg, G, c;
    __host__ __device__ void init(int M, int N, int G_, int c_) { nM = M / BM; nN = N / BM; nwg = nM * nN; G = G_; c = c_; }
    __host__ __device__ bool next(int i, Unit& u) const {
        const long L = (long)i * G + c; if (L >= nwg) return false;
        int wgid = (int)L; { const int q = nwg / NXCD, r = nwg % NXCD, xcd = wgid % NXCD, off = wgid / NXCD; wgid = (xcd < r ? xcd * (q + 1) : r * (q + 1) + (xcd - r) * q) + off; }
        const int nig = WGM * nN, gid = wgid / nig, fm = gid * WGM, gsz = (nM - fm) < WGM ? (nM - fm) : WGM;
        u.pm = fm + ((wgid % nig) % gsz); u.pn = (wgid % nig) / gsz; u.pb = u.pn; u.ex = 0; return true;
    }
    __device__ __forceinline__ void a_ready(const Unit&) const {}
    __device__ __forceinline__ void done(const Unit&) const {}
};

__device__ __forceinline__ unsigned cvt_pk_bf16(float lo, float hi) { unsigned r; asm volatile("v_cvt_pk_bf16_f32 %0, %1, %2" : "=v"(r) : "v"(lo), "v"(hi)); return r; }
typedef int i32x8 __attribute__((ext_vector_type(8)));
typedef int i32x4v __attribute__((ext_vector_type(4)));
__device__ __forceinline__ f32x4 mfma_fp8_128(bf16x8 a0, bf16x8 a1, bf16x8 b0, bf16x8 b1, f32x4 c) {
    const i32x4v x0 = __builtin_bit_cast(i32x4v, a0), x1 = __builtin_bit_cast(i32x4v, a1), y0 = __builtin_bit_cast(i32x4v, b0), y1 = __builtin_bit_cast(i32x4v, b1);
    const i32x8 a = {x0[0], x0[1], x0[2], x0[3], x1[0], x1[1], x1[2], x1[3]}, b = {y0[0], y0[1], y0[2], y0[3], y1[0], y1[1], y1[2], y1[3]};
    return __builtin_amdgcn_mfma_scale_f32_16x16x128_f8f6f4(a, b, c, 0, 0, 0, 0x7f7f7f7f, 0, 0x7f7f7f7f);
}
template <class Epi, class Sched, bool ALIGN_EPI = false, bool SP2 = false, bool FP8 = false>
__device__ __forceinline__ void gemm_phase(PG8_LAS unsigned char* lds, const Gemm g, const Sched& S, const Epi& E) {
    const int tid = tid_opaque(), wid = __builtin_amdgcn_readfirstlane(tid >> 6), lane = tid & 63, wr = wid >> 2, wc = wid & 3, fr = lane & 15, fq = lane >> 4;
    const int K = FP8 ? g.K / 2 : g.K, nt = K / BK;
    unsigned voffA[2], voffB[2];
#pragma unroll
    for (int i = 0; i < 2; ++i) { int R, C; stage_rc(tid * 16 + i * 8192, R, C); const int Rb = Epi::PERM ? ((R & ~31) + perm32(R & 31)) : R;
        voffA[i] = (unsigned)(R * K + C) * 2u; voffB[i] = (unsigned)(Rb * K + C) * 2u; }
    const size_t kstep = (size_t)(BK * 2);
    const size_t hstep = (size_t)HALF * K * 2;
    const size_t tstep = 2 * hstep;
    const unsigned pfoff = (unsigned)(tid & 255) * (unsigned)K * 2u;
    const unsigned ldsw = (unsigned)wid * 1024u;
    const int aoff = lds_byte(wr * 64 + fr, fq * 8), boff = lds_byte(wc * 32 + fr, fq * 8);
#define PG8_SA(b, h) (((b) * 2 + (h)) * HTB)
#define PG8_SB(b, h) ((4 + (b) * 2 + (h)) * HTB)
#define PG8_STAGE(bufoff, gbase, voff) do { _Pragma("unroll") for (int _i = 0; _i < 2; ++_i) \
        __builtin_amdgcn_global_load_lds((const unsigned*)((const char*)(gbase) + (voff)[_i]), (PG8_LAS unsigned*)(lds + (bufoff) + ldsw + _i * 8192), 16, 0, 0); } while (0)
#define PG8_LDA(dst, b, h) do { _Pragma("unroll") for (int m = 0; m < 4; ++m) { if constexpr (FP8) { dst##8[m].lo = *(const PG8_LAS i32x4v*)(lds + PG8_SA(b, h) + aoff + m * 2048); dst##8[m].hi = *(const PG8_LAS i32x4v*)(lds + PG8_SA(b, h) + aoff + m * 2048 + 1024); } \
        else { _Pragma("unroll") for (int k = 0; k < 2; ++k) dst[m][k] = *(const PG8_LAS bf16x8*)(lds + PG8_SA(b, h) + aoff + m * 2048 + k * 1024); } } } while (0)
#define PG8_LDB(dst, b, h) do { _Pragma("unroll") for (int n = 0; n < 2; ++n) { if constexpr (FP8) { dst##8[n].lo = *(const PG8_LAS i32x4v*)(lds + PG8_SB(b, h) + boff + n * 2048); dst##8[n].hi = *(const PG8_LAS i32x4v*)(lds + PG8_SB(b, h) + boff + n * 2048 + 1024); } \
        else { _Pragma("unroll") for (int k = 0; k < 2; ++k) dst[n][k] = *(const PG8_LAS bf16x8*)(lds + PG8_SB(b, h) + boff + n * 2048 + k * 1024); } } } while (0)
#define PG8_MMA(ai, bj, At, Bt) do { __builtin_amdgcn_s_setprio(1); _Pragma("unroll") for (int m = 0; m < 4; ++m) _Pragma("unroll") for (int n = 0; n < 2; ++n) _Pragma("unroll") for (int k = 0; k < 2; ++k) \
        { if constexpr (FP8) { if (k == 0) asm volatile("v_mfma_scale_f32_16x16x128_f8f6f4 %0, %1, %2, %0, %3, %3 op_sel_hi:[0,0,0]" : "+v"(acc[ai][bj][m][n]) : "v"(Bt##8[n]), "v"(At##8[m]), "v"(fp8_unit_scale)); } \
          else acc[ai][bj][m][n] = __builtin_amdgcn_mfma_f32_16x16x32_bf16(Bt[n][k], At[m][k], acc[ai][bj][m][n], 0, 0, 0); } __builtin_amdgcn_s_setprio(0); } while (0)
#define PG8_WAIT_V(n) asm volatile("s_waitcnt vmcnt(" #n ")" ::: "memory")
#ifndef PG8_PF
#define PG8_PF 0
#endif
#ifndef PG8_PFD
#define PG8_PFD 4
#endif
#ifndef PG8_EPIW
#define PG8_EPIW 1
#endif
#define PG8_WAIT_VE do { if constexpr (Epi::NSTORES == 4) PG8_WAIT_V(12); else if constexpr (Epi::NSTORES == 8) PG8_WAIT_V(16); else if constexpr (Epi::NSTORES == 16) PG8_WAIT_V(24); else { static_assert(Epi::NSTORES == 0, "add the wait for this store count"); PG8_WAIT_V(8); } } while (0)
#if PG8_PF
#define PG8_WAIT_V8 PG8_WAIT_V(9)
#define PG8_PREFETCH(q_) do { const int q = (q_); const char* pb_ = (q < nt) ? ((wid < 4 ? cA : cB) + (size_t)q * kstep) : ((wid < 4 ? nA : nB) + (size_t)(q - nt) * kstep); \
        __builtin_amdgcn_global_load_lds((const unsigned*)(pb_ + pfoff), (PG8_LAS unsigned*)(lds + STAGE_BYTES + 2048 + wid * 256), 4, 0, 0); } while (0)
#else
#define PG8_WAIT_V8 PG8_WAIT_V(8)
#define PG8_PREFETCH(q_) do { } while (0)
#endif
#define PG8_WAIT_L(n) asm volatile("s_waitcnt lgkmcnt(" #n ")" ::: "memory")
#define PG8_BAR __builtin_amdgcn_s_barrier()
#define PG8_SCHED __builtin_amdgcn_sched_barrier(0)
    Unit cur, nxt; int ui = 0;
    if (!S.next(0, cur)) return;
#ifndef PG8_KROT
#define PG8_KROT 0
#endif
    const int ktm = nt - 1;
#define PG8_ROT(u) (PG8_KROT ? (((u).pn + 2 * (u).pm) & ktm) : 0)
#define PG8_KT(rot, t) ((size_t)(((t) + (rot)) & ktm) * kstep)
    f32x4 acc[2][2][4][2];
#pragma unroll
    for (int a = 0; a < 2; ++a)
#pragma unroll
        for (int b = 0; b < 2; ++b)
#pragma unroll
            for (int m = 0; m < 4; ++m)
#pragma unroll
                for (int n = 0; n < 2; ++n) acc[a][b][m][n] = (f32x4){0.f, 0.f, 0.f, 0.f};
    const int fp8_unit_scale = 0x7f7f7f7f; (void)fp8_unit_scale;
    bf16x8 At[4][2], B0[2][2], B1[2][2]; i32x8 At8[4], B08[2], B18[2];
    const char* cA = (const char*)g.A + (size_t)cur.pm * tstep; const char* cB = (const char*)g.Bt + (size_t)cur.pb * tstep;
    S.a_ready(cur);
    int rot = PG8_ROT(cur);
    if constexpr (SP2) {
        { const size_t k0 = PG8_KT(rot, 0), k1 = PG8_KT(rot, 1);
        PG8_STAGE(PG8_SB(0, 0), cB + k0, voffB); PG8_STAGE(PG8_SB(0, 1), cB + hstep + k0, voffB); PG8_STAGE(PG8_SA(0, 0), cA + k0, voffA); PG8_STAGE(PG8_SA(0, 1), cA + hstep + k0, voffA);
        if (wr == 1) PG8_BAR;
        PG8_WAIT_V(2); PG8_BAR;
        PG8_STAGE(PG8_SB(1, 0), cB + k1, voffB); PG8_STAGE(PG8_SA(1, 0), cA + k1, voffA); PG8_STAGE(PG8_SB(1, 1), cB + hstep + k1, voffB); }
        PG8_WAIT_V(6); PG8_BAR;
        if constexpr (PG8_EPIW != 0) {
#pragma unroll
            for (int q = 0; q < Epi::NSTORES; ++q) __builtin_amdgcn_global_load_lds((const unsigned*)cA, (PG8_LAS unsigned*)(lds + STAGE_BYTES + 2048 + wid * 256), 4, 0, 0);
        }
    } else {
        const size_t k0 = PG8_KT(rot, 0), k1 = PG8_KT(rot, 1);
        PG8_STAGE(PG8_SB(0, 0), cB + k0, voffB); PG8_STAGE(PG8_SA(0, 0), cA + k0, voffA); PG8_STAGE(PG8_SB(0, 1), cB + hstep + k0, voffB); PG8_STAGE(PG8_SA(0, 1), cA + hstep + k0, voffA);
        if (wr == 1) PG8_BAR;
        PG8_WAIT_V(4); PG8_BAR;
        PG8_STAGE(PG8_SB(1, 0), cB + k1, voffB); PG8_STAGE(PG8_SA(1, 0), cA + k1, voffA); PG8_STAGE(PG8_SB(1, 1), cB + hstep + k1, voffB);
        PG8_WAIT_V(6); PG8_BAR;
    }
    for (;;) {
        const bool has_next = S.next(ui + 1, nxt);
        const char* nA = has_next ? (const char*)g.A + (size_t)nxt.pm * tstep : cA; const char* nB = has_next ? (const char*)g.Bt + (size_t)nxt.pb * tstep : cB;
        const int nrot = has_next ? PG8_ROT(nxt) : rot;
#define PG8_ITER(WVA, WVB) do { \
            const bool last = (t == nt - 2); \
            const char* a1 = cA + PG8_KT(rot, t + 1); \
            const char* a2 = last ? nA + PG8_KT(nrot, 0) : cA + PG8_KT(rot, t + 2); const char* b2 = last ? nB + PG8_KT(nrot, 0) : cB + PG8_KT(rot, t + 2); \
            const char* a3 = last ? nA + PG8_KT(nrot, 1) : cA + PG8_KT(rot, t + 3); const char* b3 = last ? nB + PG8_KT(nrot, 1) : cB + PG8_KT(rot, t + 3); \
            if (last && has_next) S.a_ready(nxt); \
            if constexpr (SP2) { \
            PG8_LDB(B0, 0, 0); PG8_LDB(B1, 0, 1); PG8_SCHED; PG8_LDA(At, 0, 0); PG8_STAGE(PG8_SA(1, 1), a1 + hstep, voffA); \
            WVA; PG8_WAIT_L(0); PG8_BAR; PG8_MMA(0, 0, At, B0); PG8_MMA(0, 1, At, B1); PG8_BAR; PG8_SCHED; \
            PG8_LDA(At, 0, 1); PG8_STAGE(PG8_SB(0, 0), b2, voffB); PG8_STAGE(PG8_SB(0, 1), b2 + hstep, voffB); PG8_STAGE(PG8_SA(0, 0), a2, voffA); PG8_PREFETCH(t + PG8_PFD); \
            WVB; PG8_WAIT_L(0); PG8_BAR; PG8_MMA(1, 0, At, B0); PG8_MMA(1, 1, At, B1); PG8_BAR; PG8_SCHED; \
            PG8_LDB(B0, 1, 0); PG8_LDB(B1, 1, 1); PG8_SCHED; PG8_LDA(At, 1, 0); PG8_STAGE(PG8_SA(0, 1), a2 + hstep, voffA); \
            PG8_WAIT_V8; PG8_WAIT_L(0); PG8_BAR; PG8_MMA(0, 0, At, B0); PG8_MMA(0, 1, At, B1); PG8_BAR; PG8_SCHED; \
            PG8_LDA(At, 1, 1); PG8_STAGE(PG8_SB(1, 0), b3, voffB); PG8_STAGE(PG8_SB(1, 1), b3 + hstep, voffB); PG8_STAGE(PG8_SA(1, 0), a3, voffA); PG8_PREFETCH(t + 1 + PG8_PFD); \
            PG8_WAIT_V8; PG8_WAIT_L(0); PG8_BAR; PG8_MMA(1, 0, At, B0); PG8_MMA(1, 1, At, B1); PG8_BAR; PG8_SCHED; \
            } else { \
            PG8_LDB(B0, 0, 0); PG8_SCHED; PG8_LDA(At, 0, 0); PG8_STAGE(PG8_SA(1, 1), a1 + hstep, voffA); \
            PG8_WAIT_L(8); PG8_BAR; PG8_WAIT_L(0); PG8_MMA(0, 0, At, B0); PG8_BAR; PG8_SCHED; \
            PG8_LDB(B1, 0, 1); PG8_STAGE(PG8_SB(0, 0), b2, voffB); \
            PG8_BAR; PG8_WAIT_L(0); PG8_MMA(0, 1, At, B1); PG8_BAR; \
            PG8_LDA(At, 0, 1); PG8_STAGE(PG8_SA(0, 0), a2, voffA); \
            PG8_BAR; PG8_WAIT_L(0); PG8_MMA(1, 0, At, B0); PG8_BAR; PG8_SCHED; \
            PG8_STAGE(PG8_SB(0, 1), b2 + hstep, voffB); \
            PG8_WAIT_V(6); PG8_BAR; PG8_MMA(1, 1, At, B1); PG8_BAR; \
            PG8_LDB(B0, 1, 0); PG8_SCHED; PG8_LDA(At, 1, 0); PG8_STAGE(PG8_SA(0, 1), a2 + hstep, voffA); \
            PG8_WAIT_L(8); PG8_BAR; PG8_WAIT_L(0); PG8_MMA(0, 0, At, B0); PG8_BAR; PG8_SCHED; \
            PG8_LDB(B1, 1, 1); PG8_STAGE(PG8_SB(1, 0), b3, voffB); \
            PG8_BAR; PG8_WAIT_L(0); PG8_MMA(0, 1, At, B1); PG8_BAR; \
            PG8_LDA(At, 1, 1); PG8_STAGE(PG8_SA(1, 0), a3, voffA); \
            PG8_BAR; PG8_WAIT_L(0); PG8_MMA(1, 0, At, B0); PG8_BAR; PG8_SCHED; \
            PG8_STAGE(PG8_SB(1, 1), b3 + hstep, voffB); \
            PG8_WAIT_V(6); PG8_BAR; PG8_MMA(1, 1, At, B1); PG8_BAR; \
            } \
        } while (0)
        if constexpr (PG8_EPIW != 0 && SP2) {
            { const int t = 0; PG8_ITER(PG8_WAIT_VE, PG8_WAIT_VE); }
            for (int t = 2; t < nt; t += 2) PG8_ITER(PG8_WAIT_V8, PG8_WAIT_V8);
        } else { for (int t = 0; t < nt; t += 2) PG8_ITER(PG8_WAIT_V8, PG8_WAIT_V8); }
#undef PG8_ITER
        if constexpr (FP8) asm volatile("s_nop 15\n\ts_nop 15" ::: "memory");
        if constexpr (ALIGN_EPI) { if (wr == 0) PG8_BAR; }
        if constexpr (!Epi::AFTER_DRAIN) { E(acc, cur, wr, wc, fr, fq); S.done(cur); }
        if (!has_next) break;
#pragma unroll
        for (int a = 0; a < 2; ++a)
#pragma unroll
            for (int b = 0; b < 2; ++b)
#pragma unroll
                for (int m = 0; m < 4; ++m)
#pragma unroll
                    for (int n = 0; n < 2; ++n) acc[a][b][m][n] = (f32x4){0.f, 0.f, 0.f, 0.f};
        cur = nxt; cA = nA; cB = nB; rot = nrot; ++ui;
        if constexpr (ALIGN_EPI) { if (wr == 1) PG8_BAR; }
    }
    PG8_WAIT_V(0);
    if constexpr (!ALIGN_EPI) { if (wr == 0) PG8_BAR; }
    PG8_BAR;
    if constexpr (Epi::AFTER_DRAIN) { E.fused(acc, cur, wr, wc, fr, fq, lds, wid, lane); S.done(cur); }
#undef PG8_ROT
#undef PG8_KT
#undef PG8_SA
#undef PG8_SB
#undef PG8_STAGE
#undef PG8_LDA
#undef PG8_LDB
#undef PG8_MMA
#undef PG8_WAIT_V
#undef PG8_WAIT_V8
#undef PG8_WAIT_VE
#undef PG8_PREFETCH
#undef PG8_WAIT_L
#undef PG8_BAR
#undef PG8_SCHED
}
}
#include <cstdlib>
#include <vector>

#define XB_TMO      128
#define XB_XCNT(j)  (256  + 64 * (j))
#define XB_XSUB(j)  (1280 + 64 * (j))
#define XB_XGEN(j)  (2304 + 64 * (j))
#define XB_TOP      3328
#define XB_TOPGEN   3392
#define XCD_BAR_WORDS 3456
#define XB_SPIN_CAP (1u << 18)
#define LAS __attribute__((address_space(3)))

__device__ __forceinline__ unsigned xb_ld(unsigned* p)              { return __hip_atomic_load(p, __ATOMIC_RELAXED, __HIP_MEMORY_SCOPE_AGENT); }
__device__ __forceinline__ unsigned xb_add(unsigned* p, unsigned v) { return __hip_atomic_fetch_add(p, v, __ATOMIC_RELAXED, __HIP_MEMORY_SCOPE_AGENT); }
__device__ __forceinline__ unsigned xb_xcc_id() { return (unsigned)__builtin_amdgcn_s_getreg((3 << 11) | 20) & 0xFu; }
#define XB_SPIN(cond, bar) do { unsigned _sp = 0; while (cond) { __builtin_amdgcn_s_sleep(1); \
    if ((++_sp & 255u) == 0u) { if (xb_ld(&(bar)[XB_TMO])) break; if (_sp > XB_SPIN_CAP) { atomicAdd(&(bar)[XB_TMO], 1u); break; } } } } while (0)

struct XcdBarrier {
    unsigned* bar; unsigned x;
    volatile LAS unsigned* st;
};

__device__ __forceinline__ XcdBarrier xcd_barrier_post(unsigned* bar, volatile LAS unsigned* st) {
    XcdBarrier b; b.bar = bar; b.x = xb_xcc_id(); b.st = st;
    if (tid_opaque() == 0) (void)xb_add(&bar[XB_XCNT(b.x)], 1u);
    return b;
}
__device__ __forceinline__ void xcd_barrier_complete(unsigned* bar, unsigned x, unsigned& nloc, unsigned& nx) {
    const unsigned G = gridDim.x * gridDim.y * gridDim.z;
    unsigned sum, cnt, mine, sp = 0u;
    for (;;) {
        sum = 0u; cnt = 0u; mine = 0u;
#pragma unroll
        for (unsigned j = 0; j < 16; ++j) { const unsigned c = xb_ld(&bar[XB_XCNT(j)]); sum += c; cnt += (c > 0u) ? 1u : 0u; mine = (j == x) ? c : mine; }
        if (sum == G) break;
        __builtin_amdgcn_s_sleep(1);
        if ((++sp & 255u) == 0u) { if (xb_ld(&bar[XB_TMO])) break; if (sp > XB_SPIN_CAP) { atomicAdd(&bar[XB_TMO], 1u); break; } }
    }
    nloc = mine > 0u ? mine : 1u; nx = cnt > 0u ? cnt : 1u;
}

__device__ __forceinline__ void xcd_barrier(const XcdBarrier& b) {
    asm volatile("s_waitcnt vmcnt(0)" ::: "memory");
    __syncthreads();
    if (tid_opaque() == 0) {
        unsigned* bar = b.bar;
        __builtin_amdgcn_s_waitcnt(0);
        unsigned nloc = b.st[0], nx = b.st[1];
        if (nloc == 0u) { xcd_barrier_complete(bar, b.x, nloc, nx); b.st[0] = nloc; b.st[1] = nx; }
        const unsigned old = xb_add(&bar[XB_XSUB(b.x)], 1u);
        const unsigned gen = old / nloc;
        if (old + 1u == (gen + 1u) * nloc) {
            __builtin_amdgcn_fence(__ATOMIC_RELEASE, "agent");
            asm volatile("s_waitcnt vmcnt(0)" ::: "memory");
            const unsigned og = xb_add(&bar[XB_TOP], 1u);
            const unsigned tg = og / nx;
#ifndef XB_TOP_DIRECT
#define XB_TOP_DIRECT 1
#endif
#if XB_TOP_DIRECT
            if (og + 1u != (tg + 1u) * nx) XB_SPIN(xb_ld(&bar[XB_TOP]) < (tg + 1u) * nx, bar);
#else
            if (og + 1u == (tg + 1u) * nx) xb_add(&bar[XB_TOPGEN], 1u);
            else XB_SPIN(xb_ld(&bar[XB_TOPGEN]) == tg, bar);
#endif
            __builtin_amdgcn_fence(__ATOMIC_ACQUIRE, "agent");
            xb_add(&bar[XB_XGEN(b.x)], 1u);
            asm volatile("s_waitcnt vmcnt(0)" ::: "memory");
        } else {
#ifndef XB_EARLY_INV
#define XB_EARLY_INV 1
#endif
#if XB_EARLY_INV
            asm volatile("buffer_inv sc1" ::: "memory");
#endif
            XB_SPIN(xb_ld(&bar[XB_XGEN(b.x)]) == gen, bar);
#if !XB_EARLY_INV
            __builtin_amdgcn_fence(__ATOMIC_ACQUIRE, "agent");
#endif
            asm volatile("s_waitcnt vmcnt(0)" ::: "memory");
        }
    }
    __syncthreads();
}
using pg8::bf16_t; using pg8::bf16x8; using pg8::f32x4; using pg8::u32x4; using pg8::Unit; using pg8::Gemm;
typedef float f32x16 __attribute__((ext_vector_type(16)));
typedef unsigned u32x2 __attribute__((ext_vector_type(2)));

constexpr int T_TOK = 16384, SEQ = 4096, DM = 1024;
constexpr int NPW = 3328;
constexpr int PW_SRC = 3120;
constexpr int PP = 3072;
constexpr int C_AQ = 0, C_AK = 512, C_AV = 640, C_IQ = 768, C_MQ = 1024, C_MK = 1536, C_MV = 2048, C_MO = 2560;
constexpr int NEXP = 32, XROWS = 65536 + 32 * 256;
constexpr int NTHREADS = 512;
constexpr int LDS_BYTES = 160 * 1024;
constexpr int RDY_WORDS = 320;
constexpr float NORM_EPS = 1e-6f;

struct Params {
    const float *x, *mix_norm_w, *w_in, *conv_w, *conv_b, *igate_b, *fgate_b, *mlstm_norm_w, *w_out, *ffn_norm_w, *router_w, *router_b, *w_gu, *b_gu, *w_dn,
        *b_dn, *final_norm_w;
    float* out;
    bf16_t *wt_in, *wt_out, *wt_gu, *wt_dn, *xn, *proj, *ikb, *vt, *cq, *ck, *cst, *mix, *xbuf, *act, *ybuf;
    float *iw, *mi, *mf, *cb, *ropea, *ropei, *nu, *bl, *mloc, *ns, *ms, *topg, *rsv;
    bf16_t* ut;
    bf16_t* x1;
    unsigned long long* mask;
    int *tope, *topp, *cnt;
    unsigned* bar; unsigned* rdy;
    unsigned long long cg_first;
    unsigned char *xn8, *wt_in8;
};

#ifndef MOE_FP8
#define MOE_FP8 1
#endif
#ifndef PROJ_FP8
#define PROJ_FP8 1
#endif
constexpr float FP8_XS = 4.0f, FP8_WS = 64.0f, FP8_INV = 1.0f / (4.0f * 64.0f);
__device__ __forceinline__ unsigned pk4_fp8(float a, float b, float c, float d) { int w = 0; w = __builtin_amdgcn_cvt_pk_fp8_f32(a, b, w, false); w = __builtin_amdgcn_cvt_pk_fp8_f32(c, d, w, true); return (unsigned)w; }
#ifndef WT_ACT
#define WT_ACT 0
#endif
#ifndef WT_EPI
#define WT_EPI 0
#endif
__device__ __forceinline__ void store16_wt(void* base, size_t byte_off, u32x4 v) {
#if WT_EPI
    const __amdgpu_buffer_rsrc_t r = __builtin_amdgcn_make_buffer_rsrc(base, 0, 0x7fffffff, 0x00020000);
    __builtin_amdgcn_raw_buffer_store_b128(v, r, (unsigned)byte_off, 0, 16);
#else
    *(u32x4*)((unsigned char*)base + byte_off) = v;
#endif
}
__device__ __forceinline__ float bf2f(unsigned short h) { return __uint_as_float(((unsigned)h) << 16); }
__device__ __forceinline__ unsigned pk2(float lo, float hi) { typedef float f2_ __attribute__((ext_vector_type(2))); typedef __bf16 b2_ __attribute__((ext_vector_type(2))); return __builtin_bit_cast(unsigned, __builtin_convertvector((f2_){lo, hi}, b2_)); }
__device__ __forceinline__ unsigned pk2c(float lo, float hi) { typedef float f2_ __attribute__((ext_vector_type(2))); typedef __bf16 b2_ __attribute__((ext_vector_type(2))); return __builtin_bit_cast(unsigned, __builtin_convertvector((f2_){lo, hi}, b2_)); }
__device__ __forceinline__ unsigned short f2bf(float f) { return (unsigned short)(pk2(f, 0.f) & 0xffffu); }
__device__ __forceinline__ f32x4 mfma16(bf16x8 a, bf16x8 b, f32x4 c) { return __builtin_amdgcn_mfma_f32_16x16x32_bf16(a, b, c, 0, 0, 0); }
__device__ __forceinline__ f32x16 mfma32(bf16x8 a, bf16x8 b, f32x16 c) { return __builtin_amdgcn_mfma_f32_32x32x16_bf16(a, b, c, 0, 0, 0); }
__device__ __forceinline__ float wave_sum(float v) {
#pragma unroll
    for (int o = 32; o > 0; o >>= 1) v += __shfl_xor(v, o);
    return v;
}
__device__ __forceinline__ float wave_max(float v) {
#pragma unroll
    for (int o = 32; o > 0; o >>= 1) v = fmaxf(v, __shfl_xor(v, o));
    return v;
}
__device__ __forceinline__ u32x4 pack8(const float* f) { u32x4 w; w.x = pk2(f[0], f[1]); w.y = pk2(f[2], f[3]); w.z = pk2(f[4], f[5]); w.w = pk2(f[6], f[7]); return w; }
__device__ __forceinline__ void unpack8(u32x4 w, float* f) {
    f[0] = __uint_as_float(w.x << 16); f[1] = __uint_as_float(w.x & 0xffff0000u); f[2] = __uint_as_float(w.y << 16); f[3] = __uint_as_float(w.y & 0xffff0000u);
    f[4] = __uint_as_float(w.z << 16); f[5] = __uint_as_float(w.z & 0xffff0000u); f[6] = __uint_as_float(w.w << 16); f[7] = __uint_as_float(w.w & 0xffff0000u);
}
__device__ __forceinline__ float sigmoidf_(float z) { return __builtin_amdgcn_rcpf(1.0f + __builtin_amdgcn_exp2f(-1.4426950408889634f * z)); }

typedef short v4i16_t __attribute__((ext_vector_type(4)));
__device__ __forceinline__ v4i16_t lds_tr16(const bf16_t* ptr) { return __builtin_amdgcn_ds_read_tr16_b64_v4i16((__attribute__((address_space(3))) v4i16_t*)ptr); }
__device__ __forceinline__ int srccol_in(int n) {
    if (n < 1024) return n;
    if (n < 2560) return n + 40;
    if (n < 3072) return n + 48;
    if (n < 3112) return n - 3072 + 1024;
    if (n < 3120) return n - 3112 + 2600;
    return -1;
}
__device__ __forceinline__ int srccol_dn(int n) { const int c = n & 255; return (n & ~255) + 64 * ((c >> 5) & 3) + 16 * ((c >> 3) & 3) + 8 * (c >> 7) + (c & 7); }
__device__ __forceinline__ int dstrow_dn(int s) { const int f = s & 255; return (s & ~255) + 128 * ((f >> 3) & 1) + 32 * ((f >> 6) & 3) + 8 * ((f >> 4) & 3) + (f & 7); }
__device__ __forceinline__ int srccol_gu(int n) { return ((n & 128) ? 1024 : 0) + 128 * (n >> 8) + (n & 127); }

#ifndef CONV_NB
#define CONV_NB 4
#endif
struct TrTile { const float* src; bf16_t* dst; int ld, k0, n0, which; unsigned char* dst8; };
__device__ __forceinline__ TrTile tr_decode_in(const Params& p, int id) { TrTile t; t.src = p.w_in; t.dst = p.wt_in; t.ld = PW_SRC; t.n0 = (id % (NPW / 64)) * 64; t.k0 = (id / (NPW / 64)) * 64; t.which = 0; t.dst8 = p.wt_in8; return t; }
__device__ __forceinline__ TrTile tr_decode_s(const Params& p, int id) {
    const bool is_out = id < 256, is_gu = id < 256 + 16384;
    const int j = is_out ? id : (is_gu ? id - 256 : id - 256 - 16384);
    const int e = is_out ? 0 : (is_gu ? (j >> 9) : (j >> 8));
    const size_t esz_src = is_gu ? (size_t)1024 * 2048 : (size_t)1024 * 1024, esz_dst = (is_gu ? (size_t)2048 * 1024 : (size_t)1024 * 1024) * (MOE_FP8 ? 1 : 2);
    const float* sb = is_out ? p.w_out : (is_gu ? p.w_gu : p.w_dn); unsigned char* db = (unsigned char*)(is_out ? p.wt_out : (is_gu ? p.wt_gu : p.wt_dn));
    TrTile t; t.src = sb + (size_t)e * esz_src; t.dst = (bf16_t*)(db + (size_t)e * esz_dst); t.ld = (!is_out && is_gu) ? 2048 : 1024;
    t.n0 = ((!is_out && is_gu) ? (j & 31) : (j & 15)) * 64; t.k0 = ((!is_out && is_gu) ? ((j >> 5) & 15) : ((j >> 4) & 15)) * 64; t.which = is_out ? 2 : (is_gu ? 1 : 3); t.dst8 = nullptr;
    return t;
}
__device__ __forceinline__ void tr_load(const TrTile& t, int tid, float4 (&v)[2]) {
#pragma unroll
    for (int i = 0; i < 2; ++i) {
        const int k = (tid >> 4) + 32 * i, dn = t.n0 + (tid & 15) * 4; const int sc = (t.which == 1) ? srccol_gu(dn) : dn;
        { const f32x4 t4 = __builtin_nontemporal_load((const f32x4*)(t.src + (size_t)(t.k0 + k) * t.ld + sc)); v[i] = make_float4(t4[0], t4[1], t4[2], t4[3]); }
    }
}
__device__ __forceinline__ void tr_load_in(const TrTile& t, int tid, float4 (&v)[2]) {
#pragma unroll
    for (int i = 0; i < 2; ++i) {
        const int k = (tid >> 4) + 32 * i, dn = t.n0 + (tid & 15) * 4; const int sc = srccol_in(dn);
        const f32x4 l4_ = __builtin_nontemporal_load((const f32x4*)(t.src + (size_t)(t.k0 + k) * t.ld + max(sc, 0)));
        const float4 ld4 = make_float4(l4_[0], l4_[1], l4_[2], l4_[3]);
        v[i] = (sc >= 0) ? ld4 : make_float4(0.f, 0.f, 0.f, 0.f);
    }
}
__device__ __forceinline__ void tr_lds_write(float* tile, int tid, const float4 (&v)[2]) {
#pragma unroll
    for (int i = 0; i < 2; ++i) { float* tp = tile + ((tid >> 4) + 32 * i) * 65 + (tid & 15) * 4; tp[0] = v[i].x; tp[1] = v[i].y; tp[2] = v[i].z; tp[3] = v[i].w; }
}
__device__ __forceinline__ void tr_store(const TrTile& t, const float* tile, int tid) {
    const int n = tid >> 3, k8 = (tid & 7) * 8; float f[8];
#pragma unroll
    for (int j = 0; j < 8; ++j) f[j] = tile[(k8 + j) * 65 + n];
#if MOE_FP8
    if (t.which == 1 || t.which == 3) { u32x2 w; w.x = pk4_fp8(f[0] * FP8_WS, f[1] * FP8_WS, f[2] * FP8_WS, f[3] * FP8_WS); w.y = pk4_fp8(f[4] * FP8_WS, f[5] * FP8_WS, f[6] * FP8_WS, f[7] * FP8_WS);
        *(u32x2*)((unsigned char*)t.dst + (size_t)(t.n0 + n) * 1024 + t.k0 + k8) = w; return; }
#endif
    *(u32x4*)(t.dst + (size_t)(t.n0 + n) * 1024 + t.k0 + k8) = pack8(f);
#if PROJ_FP8
    if (t.which == 0 && t.n0 + n < PP) { u32x2 w; w.x = pk4_fp8(f[0] * FP8_WS, f[1] * FP8_WS, f[2] * FP8_WS, f[3] * FP8_WS); w.y = pk4_fp8(f[4] * FP8_WS, f[5] * FP8_WS, f[6] * FP8_WS, f[7] * FP8_WS);
        *(u32x2*)(t.dst8 + (size_t)(t.n0 + n) * 1024 + t.k0 + k8) = w; }
#endif
}

#ifndef CONV_WAVES
#define CONV_WAVES 1
#endif
__device__ __forceinline__ int streamed_tiles_of_wg() { constexpr int NT_S = (CONV_WAVES && MOE_FP8) ? 256 : 256 + 16384 + 8192; const int G = gridDim.x; return (NT_S - (int)blockIdx.x + G - 1) / G; }
__device__ __forceinline__ void convert_streamed(const Params& p, unsigned char* lds, int qbeg, int qend) {
    const int tid = tid_opaque();
    float* tiles = (float*)lds; constexpr int TB = 64 * 65; const int G = gridDim.x;
    {
        constexpr int NB = CONV_NB;
        const int nper = qend - qbeg;
        if (nper <= 0) return;
        float4 cur[NB][2], nxt[NB][2];
#pragma unroll
        for (int j = 0; j < NB; ++j) { const int q = min(j, nper - 1); tr_load(tr_decode_s(p, blockIdx.x + (qbeg + q) * G), tid, cur[j]); }
        int par = 0;
        for (int q0 = 0; q0 < nper; q0 += NB) {
#pragma unroll
            for (int j = 0; j < NB; ++j) { const int q = min(q0 + NB + j, nper - 1); tr_load(tr_decode_s(p, blockIdx.x + (qbeg + q) * G), tid, nxt[j]); }
#pragma unroll
            for (int sub = 0; sub < NB; sub += 4, par ^= 1) {
#pragma unroll
                for (int j = 0; j < 4; ++j) tr_lds_write(tiles + (par * 4 + j) * TB, tid, cur[sub + j]);
                asm volatile("s_waitcnt lgkmcnt(0)" ::: "memory"); __builtin_amdgcn_s_barrier(); asm volatile("" ::: "memory");
#pragma unroll
                for (int j = 0; j < 4; ++j) if (q0 + sub + j < nper) tr_store(tr_decode_s(p, blockIdx.x + (qbeg + q0 + sub + j) * G), tiles + (par * 4 + j) * TB, tid);
            }
#pragma unroll
            for (int j = 0; j < NB; ++j) { cur[j][0] = nxt[j][0]; cur[j][1] = nxt[j][1]; }
        }
        __syncthreads();
    }
}

constexpr int NT_W8 = 16384 + 8192;
__device__ __forceinline__ void wt8_addr(const Params& p, int id, int lane, const float*& src, unsigned char*& dst, int& ld) {
    const bool gu = id < 16384; const int j = gu ? id : id - 16384;
    const int e = gu ? (j >> 9) : (j >> 8), nb = gu ? (j & 63) : (j & 31), kb = gu ? ((j >> 6) & 7) : ((j >> 5) & 7);
    ld = gu ? 2048 : 1024;
    const int ng = lane & 7, kg = lane >> 3, n0_ = nb * 32 + ng * 4, dn = gu ? n0_ : dstrow_dn(n0_), sc = gu ? srccol_gu(n0_) : n0_;
    src = (gu ? p.w_gu : p.w_dn) + (size_t)e * 1024 * ld + (size_t)(kb * 128 + kg * 16) * ld + sc;
    dst = (unsigned char*)(gu ? p.wt_gu : p.wt_dn) + (size_t)e * ld * 1024 + (size_t)dn * 1024 + kb * 128 + kg * 16;
}
__device__ __forceinline__ void wt8_load(const Params& p, int id, int lane, f32x4 (&v)[16]) {
    const float* src; unsigned char* dst; int ld; wt8_addr(p, id, lane, src, dst, ld);
#pragma unroll
    for (int j = 0; j < 16; ++j) v[j] = __builtin_nontemporal_load((const f32x4*)(src + (size_t)j * ld));
}
__device__ __forceinline__ void wt8_store(const Params& p, int id, int lane, const f32x4 (&v)[16]) {
    const float* src; unsigned char* dst; int ld; wt8_addr(p, id, lane, src, dst, ld);
#pragma unroll
    for (int c = 0; c < 4; ++c) { u32x4 w;
#pragma unroll
        for (int d = 0; d < 4; ++d) w[d] = pk4_fp8(v[4 * d][c] * FP8_WS, v[4 * d + 1][c] * FP8_WS, v[4 * d + 2][c] * FP8_WS, v[4 * d + 3][c] * FP8_WS);
        *(u32x4*)(dst + (size_t)c * 1024) = w; }
}
__device__ __forceinline__ void wt8_cvt(const f32x4 (&v)[16], u32x4 (&w)[4]) {
#pragma unroll
    for (int c = 0; c < 4; ++c)
#pragma unroll
        for (int d = 0; d < 4; ++d) w[c][d] = pk4_fp8(v[4 * d][c] * FP8_WS, v[4 * d + 1][c] * FP8_WS, v[4 * d + 2][c] * FP8_WS, v[4 * d + 3][c] * FP8_WS);
}
__device__ __forceinline__ void wt8_put(const Params& p, int id, int lane, const u32x4 (&w)[4]) {
    const float* src; unsigned char* dst; int ld; wt8_addr(p, id, lane, src, dst, ld);
#pragma unroll
    for (int c = 0; c < 4; ++c) *(u32x4*)(dst + (size_t)c * 1024) = w[c];
}
__device__ __forceinline__ void convert_fp8_waves(const Params& p, int i0) {
    const int tid = tid_opaque(), wid = __builtin_amdgcn_readfirstlane(tid >> 6), lane = tid & 63, stride = gridDim.x * 8, first = blockIdx.x * 8 + wid + i0 * stride;
    if (first >= NT_W8) return;
    const int n = (NT_W8 - first + stride - 1) / stride;
    f32x4 a[16], b[16];
    wt8_load(p, first, lane, a);
    int i = 0;
    for (; i + 3 < n; i += 2) {
        wt8_load(p, first + (i + 1) * stride, lane, b); wt8_store(p, first + i * stride, lane, a);
        wt8_load(p, first + (i + 2) * stride, lane, a); wt8_store(p, first + (i + 1) * stride, lane, b);
    }
    if (i + 1 < n) {
        wt8_load(p, first + (i + 1) * stride, lane, b); wt8_store(p, first + i * stride, lane, a);
        if (i + 2 < n) { wt8_load(p, first + (i + 2) * stride, lane, a); wt8_store(p, first + (i + 1) * stride, lane, b); wt8_store(p, first + (i + 2) * stride, lane, a); }
        else wt8_store(p, first + (i + 1) * stride, lane, b);
    } else wt8_store(p, first + i * stride, lane, a);
}

#ifdef PROBE_LOADONLY
__device__ __forceinline__ void convert_fp8_loadonly(const Params& p) {
    const int tid = tid_opaque(), wid = __builtin_amdgcn_readfirstlane(tid >> 6), lane = tid & 63, stride = gridDim.x * 8, first = blockIdx.x * 8 + wid;
    if (first >= NT_W8) return;
    const int n = (NT_W8 - first + stride - 1) / stride;
    f32x4 a[16], b[16]; float acc = 0.f;
    wt8_load(p, first, lane, a);
    for (int i = 0; i < n; i += 2) {
        wt8_load(p, first + min(i + 1, n - 1) * stride, lane, b);
#pragma unroll
        for (int j = 0; j < 16; ++j) acc += a[j][0] + a[j][1] + a[j][2] + a[j][3];
        wt8_load(p, first + min(i + 2, n - 1) * stride, lane, a);
#pragma unroll
        for (int j = 0; j < 16; ++j) acc += b[j][0] + b[j][1] + b[j][2] + b[j][3];
    }
#pragma unroll
    for (int j = 0; j < 16; ++j) acc += a[j][0];
    asm volatile("" :: "v"(acc));
}
#endif
#ifndef TK_TILES_N
#define TK_TILES_N 0
#endif
constexpr int TK_TILES = TK_TILES_N;
__device__ __forceinline__ void wh8_addr(const Params& p, int hid, int lane, const float*& src, unsigned char*& dst, int& ld) {
    const int id = hid >> 1, kh = hid & 1; const bool gu = id < 16384; const int j = gu ? id : id - 16384;
    const int e = gu ? (j >> 9) : (j >> 8), nb = gu ? (j & 63) : (j & 31), kb = gu ? ((j >> 6) & 7) : ((j >> 5) & 7);
    ld = gu ? 2048 : 1024;
    const int ng = lane & 7, kg = lane >> 3, n0_ = nb * 32 + ng * 4, dn = gu ? n0_ : dstrow_dn(n0_), sc = gu ? srccol_gu(n0_) : n0_, k0 = kb * 128 + kg * 16 + kh * 8;
    src = (gu ? p.w_gu : p.w_dn) + (size_t)e * 1024 * ld + (size_t)k0 * ld + sc;
    dst = (unsigned char*)(gu ? p.wt_gu : p.wt_dn) + (size_t)e * ld * 1024 + (size_t)dn * 1024 + k0;
}
__device__ __forceinline__ void wh8_load(const Params& p, int hid, int lane, f32x4 (&v)[8]) {
    const float* src; unsigned char* dst; int ld; wh8_addr(p, hid, lane, src, dst, ld);
#pragma unroll
    for (int j = 0; j < 8; ++j) v[j] = __builtin_nontemporal_load((const f32x4*)(src + (size_t)j * ld));
}
__device__ __forceinline__ void wh8_store(const Params& p, int hid, int lane, const f32x4 (&v)[8]) {
    const float* src; unsigned char* dst; int ld; wh8_addr(p, hid, lane, src, dst, ld);
#pragma unroll
    for (int c = 0; c < 4; ++c) { u32x2 w; w.x = pk4_fp8(v[0][c] * FP8_WS, v[1][c] * FP8_WS, v[2][c] * FP8_WS, v[3][c] * FP8_WS); w.y = pk4_fp8(v[4][c] * FP8_WS, v[5][c] * FP8_WS, v[6][c] * FP8_WS, v[7][c] * FP8_WS);
        *(u32x2*)(dst + (size_t)c * 1024) = w; }
}
__device__ __forceinline__ void wh8_cvt(const f32x4 (&v)[8], u32x2 (&w)[4]) {
#pragma unroll
    for (int c = 0; c < 4; ++c) { w[c].x = pk4_fp8(v[0][c] * FP8_WS, v[1][c] * FP8_WS, v[2][c] * FP8_WS, v[3][c] * FP8_WS); w[c].y = pk4_fp8(v[4][c] * FP8_WS, v[5][c] * FP8_WS, v[6][c] * FP8_WS, v[7][c] * FP8_WS); }
}
__device__ __forceinline__ void wh8_store_pair(const Params& p, int hid_odd, int lane, const u32x2 (&we)[4], const u32x2 (&wo)[4]) {
    const float* src; unsigned char* dst; int ld; wh8_addr(p, hid_odd & ~1, lane, src, dst, ld);
#pragma unroll
    for (int c = 0; c < 4; ++c) *(u32x4*)(dst + (size_t)c * 1024) = (u32x4){we[c].x, we[c].y, wo[c].x, wo[c].y};
}
struct HostQ { int first, stride, i, n; };
__device__ __forceinline__ int hostq_id(const HostQ& q, int k) { return 2 * (q.first + (k >> 1) * q.stride) + (k & 1); }
__device__ __forceinline__ void convert_fp8_rest(const Params& p, int i0, int i1) {
    const int tid = tid_opaque(), wid = __builtin_amdgcn_readfirstlane(tid >> 6), lane = tid & 63, stride = gridDim.x * 8, first = blockIdx.x * 8 + wid;
    for (int i = i0; i < i1 && first + i * stride < NT_W8; ++i) { f32x4 v[16]; wt8_load(p, first + i * stride, lane, v); wt8_store(p, first + i * stride, lane, v); }
}
__device__ __forceinline__ void phase_prologue(const Params& p, unsigned char* lds) {
    const int tid = tid_opaque(), wid = tid >> 6, lane = tid & 63;
    float* tiles = (float*)lds;
    constexpr int TB = 64 * 65;
    const int G = gridDim.x;
    {
        constexpr int NT_IN = (NPW / 64) * 16;
        for (int id0 = blockIdx.x; id0 < NT_IN; id0 += 4 * G) {
            float4 v[4][2];
#pragma unroll
            for (int j = 0; j < 4; ++j) { const int id = (id0 + j * G < NT_IN) ? id0 + j * G : id0; tr_load_in(tr_decode_in(p, id), tid, v[j]); }
#pragma unroll
            for (int j = 0; j < 4; ++j) tr_lds_write(tiles + j * TB, tid, v[j]);
            __syncthreads();
#pragma unroll
            for (int j = 0; j < 4; ++j) if (id0 + j * G < NT_IN) tr_store(tr_decode_in(p, id0 + j * G), tiles + j * TB, tid);
            __syncthreads();
        }
    }
#ifdef PROBE_READ
    {
        constexpr int NT_S = 256 + 16384 + 8192, NB = 4;
        const int nper = (NT_S - (int)blockIdx.x + G - 1) / G; float4 acc4 = make_float4(0.f, 0.f, 0.f, 0.f);
        for (int q0 = 0; q0 < nper; q0 += NB) {
            float4 v[NB][2];
#pragma unroll
            for (int j = 0; j < NB; ++j) { const int q = min(q0 + j, nper - 1); tr_load(tr_decode_s(p, blockIdx.x + q * G), tid, v[j]); }
#pragma unroll
            for (int j = 0; j < NB; ++j) { acc4.x += v[j][0].x + v[j][1].x; acc4.y += v[j][0].y + v[j][1].y; }
        }
        asm volatile("" :: "v"(acc4.x), "v"(acc4.y));
    }
#endif
#ifndef PRO_NR
#define PRO_NR 4
#endif
    for (int row0 = blockIdx.x * 8 + wid; row0 < T_TOK; row0 += gridDim.x * 8 * PRO_NR) {
        float4 v[PRO_NR][4];
#pragma unroll
        for (int q = 0; q < PRO_NR; ++q) { const int row = (row0 + q * (int)gridDim.x * 8 < T_TOK) ? row0 + q * (int)gridDim.x * 8 : row0; const float4* xr = (const float4*)(p.x + (size_t)row * DM);
#pragma unroll
            for (int i = 0; i < 4; ++i) { const f32x4 t_ = __builtin_nontemporal_load((const f32x4*)(xr + lane + 64 * i)); v[q][i] = make_float4(t_[0], t_[1], t_[2], t_[3]); } }
#pragma unroll
        for (int q = 0; q < PRO_NR; ++q) {
            const int row = row0 + q * (int)gridDim.x * 8;
            if (row < T_TOK) {
                float ss = 0.f;
#pragma unroll
                for (int i = 0; i < 4; ++i) ss += v[q][i].x * v[q][i].x + v[q][i].y * v[q][i].y + v[q][i].z * v[q][i].z + v[q][i].w * v[q][i].w;
                ss = wave_sum(ss); const float rs = 1.0f / sqrtf(ss * (1.0f / DM) + NORM_EPS);
#pragma unroll
                for (int i = 0; i < 4; ++i) { const float4 w = ((const float4*)p.mix_norm_w)[lane + 64 * i];
                    u32x2 o; o.x = pk2(v[q][i].x * rs * w.x, v[q][i].y * rs * w.y); o.y = pk2(v[q][i].z * rs * w.z, v[q][i].w * rs * w.w);
                    __builtin_nontemporal_store(o, (u32x2*)(p.xn + (size_t)row * DM + (lane + 64 * i) * 4));
#if PROJ_FP8
                    *(unsigned*)(p.xn8 + (size_t)row * DM + (lane + 64 * i) * 4) = pk4_fp8(v[q][i].x * rs * w.x * FP8_XS, v[q][i].y * rs * w.y * FP8_XS, v[q][i].z * rs * w.z * FP8_XS, v[q][i].w * rs * w.w * FP8_XS);
#endif
                }
            }
        }
    }
    for (int i = blockIdx.x * NTHREADS + tid; i < SEQ * 12; i += gridDim.x * NTHREADS) {
        const float invf_tab[12] = {1.000000000e+00f, 1.939227432e-01f, 3.760603070e-02f, 7.292664610e-03f, 1.414213562e-03f, 2.742481884e-04f, 5.318295734e-05f, 1.031338525e-05f, 1.000000000e+00f, 3.760603070e-02f, 1.414213562e-03f, 5.318295734e-05f};
        const int pos = i / 12, j = i % 12; const bool att = j < 8; const int jj = att ? j : j - 8;
        float invf = invf_tab[0];
#pragma unroll
        for (int q = 1; q < 12; ++q) invf = (j == q) ? invf_tab[q] : invf;
        const float ang = (float)pos * invf; float sn, cs; sincosf(ang, &sn, &cs);
        float* dst = att ? (p.ropea + ((size_t)pos * 8 + jj) * 2) : (p.ropei + ((size_t)pos * 4 + jj) * 2);
        dst[0] = cs; dst[1] = sn;
    }
    if (blockIdx.x == 0 && tid < 64) p.cnt[tid] = 0;
    if (blockIdx.x == 1 && tid < RDY_WORDS) p.rdy[tid] = 0u;
}

template <bool F8>
struct EpiProjT {
    static constexpr bool PERM = true, AFTER_DRAIN = false; static constexpr int NSTORES = 16;
    bf16_t* proj; bf16_t* ikb; float* iw; float* mi; float* mf; const float* ropea; const float* ropei; const float* igb; const float* fgb;
    __device__ __forceinline__ void operator()(const f32x4 (&acc)[2][2][4][2], const Unit& u, int wr, int wc, int fr, int fq) const {
        const float idx_w_scale = 0.35355339059327373f * 0.17677669529663687f;
#pragma unroll
        for (int ai = 0; ai < 2; ++ai)
#pragma unroll
            for (int m = 0; m < 4; ++m) {
                const int row = u.pm * 256 + ai * 128 + wr * 64 + m * 16 + fr; const int pos = row & (SEQ - 1);
#pragma unroll
                for (int bj = 0; bj < 2; ++bj) {
                    f32x4 v0 = acc[ai][bj][m][0], v1 = acc[ai][bj][m][1];
                    if constexpr (F8) { v0 *= FP8_INV; v1 *= FP8_INV; }
                    const int cw = u.pn * 256 + bj * 128 + wc * 32;
                    if (cw < C_AV) {
                        if ((cw & 32) == 0) {
                            f32x4 q0, q1;
#pragma unroll
                            for (int j = 0; j < 4; ++j) { q0[j] = __shfl_xor(v0[j], 16); q1[j] = __shfl_xor(v1[j], 16); }
                            if (fq < 2) {
                                const float4* cs = (const float4*)(ropea + (size_t)pos * 16);
                                const float4 c01 = cs[0], c23 = cs[1], c45 = cs[2], c67 = cs[3];
                                const float co[8] = {c01.x, c01.z, c23.x, c23.z, c45.x, c45.z, c67.x, c67.z}, si[8] = {c01.y, c01.w, c23.y, c23.w, c45.y, c45.w, c67.y, c67.w};
                                if (fq == 0) {
#pragma unroll
                                    for (int j = 0; j < 4; ++j) { v0[j] = v0[j] * co[j] - q0[j] * si[j]; v1[j] = v1[j] * co[4 + j] - q1[j] * si[4 + j]; }
                                } else {
#pragma unroll
                                    for (int j = 0; j < 4; ++j) { v0[j] = v0[j] * co[j] + q0[j] * si[j]; v1[j] = v1[j] * co[4 + j] + q1[j] * si[4 + j]; }
                                }
                            }
                        }
                    } else if (cw >= C_IQ && cw < C_MQ) {
                        if (fq == 0) {
                            const float4* cs = (const float4*)(ropei + (size_t)pos * 8); const float4 c01 = cs[0], c23 = cs[1];
                            const float co[4] = {c01.x, c01.z, c23.x, c23.z}, si[4] = {c01.y, c01.w, c23.y, c23.w};
#pragma unroll
                            for (int j = 0; j < 4; ++j) { const float a = v0[j], b = v1[j]; v0[j] = a * co[j] - b * si[j]; v1[j] = b * co[j] + a * si[j]; }
                        }
                    }
                    u32x4 w; w.x = pk2(v0[0], v0[1]); w.y = pk2(v0[2], v0[3]); w.z = pk2(v1[0], v1[1]); w.w = pk2(v1[2], v1[3]);
                    store16_wt(proj, ((size_t)row * PP + cw + fq * 8) * 2, w);
                }
            }
    }
};

struct EpiResid {
    static constexpr bool PERM = true, AFTER_DRAIN = false; static constexpr int NSTORES = 0;
    const float* x; bf16_t* x1;
    __device__ __forceinline__ void operator()(const f32x4 (&acc)[2][2][4][2], const Unit& u, int wr, int wc, int fr, int fq) const {
#pragma unroll
        for (int ai = 0; ai < 2; ++ai)
#pragma unroll
            for (int m = 0; m < 4; ++m) {
                const int row = u.pm * 256 + ai * 128 + wr * 64 + m * 16 + fr;
#pragma unroll
                for (int bj = 0; bj < 2; ++bj) {
                    const size_t off = (size_t)row * DM + u.pn * 256 + bj * 128 + wc * 32 + fq * 8;
                    const f32x4 a = __builtin_nontemporal_load((const f32x4*)(x + off)), b = __builtin_nontemporal_load((const f32x4*)(x + off + 4));
                    const f32x4 s0 = a + acc[ai][bj][m][0], s1 = b + acc[ai][bj][m][1];
                    u32x4 w; w.x = pk2(s0[0], s0[1]); w.y = pk2(s0[2], s0[3]); w.z = pk2(s1[0], s1[1]); w.w = pk2(s1[2], s1[3]); store16_wt(x1, off * 2, w);
                }
            }
    }
};

template <bool WT>
struct EpiSwigluT {
    static constexpr bool PERM = true, AFTER_DRAIN = false; static constexpr int NSTORES = MOE_FP8 ? 4 : 0;
    const float* bgu; bf16_t* act;
    __device__ __forceinline__ void operator()(const f32x4 (&acc)[2][2][4][2], const Unit& u, int wr, int wc, int fr, int fq) const {
        typedef float f32x2 __attribute__((ext_vector_type(2)));
        const int hc = u.pn * 128 + wc * 32 + fq * 8;
        const float* bg = bgu + (size_t)u.ex * 2048 + hc;
        f32x2 bgl[4], bli[4];
#pragma unroll
        for (int j = 0; j < 4; ++j) { bgl[j] = *(const f32x2*)(bg + 2 * j); bli[j] = *(const f32x2*)(bg + 1024 + 2 * j); }
        const float inv = MOE_FP8 ? FP8_INV : 1.0f, xs = MOE_FP8 ? FP8_XS : 1.0f;
#if MOE_FP8
        typedef unsigned u32x2v __attribute__((ext_vector_type(2)));
        const __amdgpu_buffer_rsrc_t arsrc = __builtin_amdgcn_make_buffer_rsrc((void*)act, 0, XROWS * 1024, 0x00020000);
#endif
#pragma unroll
        for (int ai = 0; ai < 2; ++ai)
#pragma unroll
            for (int mp = 0; mp < 2; ++mp) {
                u32x2 w[2];
#pragma unroll
                for (int mm = 0; mm < 2; ++mm) {
                    const int m = 2 * mp + mm; f32x2 o[4];
#pragma unroll
                    for (int j = 0; j < 4; ++j) {
                        const f32x4& ga = acc[ai][0][m][j >> 1]; const f32x4& la = acc[ai][1][m][j >> 1];
                        f32x2 g = (f32x2){ga[2 * (j & 1)], ga[2 * (j & 1) + 1]} * inv + bgl[j];
                        f32x2 l = (f32x2){la[2 * (j & 1)], la[2 * (j & 1) + 1]} * inv + bli[j];
                        g = __builtin_elementwise_min(g, (f32x2){7.0f, 7.0f});
                        l = __builtin_elementwise_min(__builtin_elementwise_max(l, (f32x2){-7.0f, -7.0f}), (f32x2){7.0f, 7.0f});
                        const f32x2 t = g * (-1.702f * 1.4426950408889634f);
                        f32x2 e; e.x = __builtin_amdgcn_exp2f(t.x); e.y = __builtin_amdgcn_exp2f(t.y);
                        const f32x2 d = e + 1.0f; f32x2 r; r.x = __builtin_amdgcn_rcpf(d.x); r.y = __builtin_amdgcn_rcpf(d.y);
                        o[j] = (g * r) * (l * xs + xs);
                    }
#if MOE_FP8
                    w[mm].x = pk4_fp8(o[0].x, o[0].y, o[1].x, o[1].y); w[mm].y = pk4_fp8(o[2].x, o[2].y, o[3].x, o[3].y);
#else
                    { const int row = u.pm * 256 + ai * 128 + wr * 64 + m * 16 + fr; u32x4 ww; ww.x = pk2(o[0].x, o[0].y); ww.y = pk2(o[1].x, o[1].y); ww.z = pk2(o[2].x, o[2].y); ww.w = pk2(o[3].x, o[3].y); *(u32x4*)(act + (size_t)row * 1024 + hc) = ww; }
#endif
                }
#if MOE_FP8
                {
                    const u32x2v lo = __builtin_amdgcn_permlane16_swap(w[0].x, w[1].x, false, false), hi = __builtin_amdgcn_permlane16_swap(w[0].y, w[1].y, false, false);
                    const u32x4 v = {lo[0], hi[0], lo[1], hi[1]};
                    const int row = u.pm * 256 + ai * 128 + wr * 64 + (2 * mp + (fq & 1)) * 16 + fr;
                    __builtin_amdgcn_raw_buffer_store_b128(v, arsrc, (unsigned)(row * 1024 + hc - (fq & 1) * 8), 0, (WT || WT_EPI || WT_ACT) ? 16 : 0);
                }
#endif
            }
    }
};

#ifndef Y_FP8
#define Y_FP8 1
#endif
constexpr float FP8_YS = 16.0f;
__device__ __forceinline__ float yq(float v) { return __builtin_amdgcn_fmed3f(v * FP8_YS, -440.0f, 440.0f); }
struct EpiBiasBf16 {
    static constexpr bool PERM = true, AFTER_DRAIN = false; static constexpr int NSTORES = 8;
    const float* bdn; bf16_t* y;
    __device__ __forceinline__ void operator()(const f32x4 (&acc)[2][2][4][2], const Unit& u, int wr, int wc, int fr, int fq) const {
        static_assert(Y_FP8 && MOE_FP8, "this epilogue is the e4m3 one");
        const int f16 = u.pn * 256 + wc * 64 + fq * 16;
        const float* bb = bdn + (size_t)u.ex * 1024 + f16;
        const f32x4 b00 = *(const f32x4*)bb, b01 = *(const f32x4*)(bb + 4), b10 = *(const f32x4*)(bb + 8), b11 = *(const f32x4*)(bb + 12);
#pragma unroll
        for (int ai = 0; ai < 2; ++ai)
#pragma unroll
            for (int m = 0; m < 4; ++m) {
                const int row = u.pm * 256 + ai * 128 + wr * 64 + m * 16 + fr;
                const f32x4 v00 = acc[ai][0][m][0] * FP8_INV + b00, v01 = acc[ai][0][m][1] * FP8_INV + b01, v10 = acc[ai][1][m][0] * FP8_INV + b10, v11 = acc[ai][1][m][1] * FP8_INV + b11;
                u32x4 w; w.x = pk4_fp8(yq(v00[0]), yq(v00[1]), yq(v00[2]), yq(v00[3])); w.y = pk4_fp8(yq(v01[0]), yq(v01[1]), yq(v01[2]), yq(v01[3]));
                w.z = pk4_fp8(yq(v10[0]), yq(v10[1]), yq(v10[2]), yq(v10[3])); w.w = pk4_fp8(yq(v11[0]), yq(v11[1]), yq(v11[2]), yq(v11[3]));
                __builtin_nontemporal_store(w, (u32x4*)((unsigned char*)y + (size_t)row * 1024 + f16));
            }
    }
};

template <class Base> struct OneUnit {
    Base base; int which;
    __device__ __forceinline__ bool next(int i, Unit& u) const { return i == 0 && base.next(which, u); }
    __device__ __forceinline__ void a_ready(const Unit&) const {}
    __device__ __forceinline__ void done(const Unit&) const {}
};
template <int MODE>
struct GroupOrderT {
    const int* tstart; int ncol, G, c, ibeg, iend; unsigned* rdy; int lim;
    __device__ __forceinline__ bool next(int i_, Unit& u) const {
        const int i = i_ + ibeg; if (i >= iend) return false;
        int rt, ct;
        if (G == 256) {
            const int rpx = 32 / ncol, y = c >> 3, x = (MODE == 2) ? 7 - (c & 7) : (c & 7); ct = y % ncol; rt = i * (256 / ncol) + x * rpx + y / ncol;
        } else { const int L = i * G + c; rt = L / ncol; ct = L - rt * ncol; }
        if (rt >= tstart[NEXP]) return false;
        int e = 0;
        while (tstart[e + 1] <= rt) ++e;
        u.pm = rt; u.pn = ct; u.pb = e * ncol + ct; u.ex = e; return true;
    }
    __device__ __forceinline__ void a_ready(const Unit& u) const {
        if (MODE == 2) {
            if (u.pm < lim) return;
            unsigned sp = 0;
            while ((unsigned)__builtin_amdgcn_readfirstlane((int)__hip_atomic_load(rdy + u.pm, __ATOMIC_RELAXED, __HIP_MEMORY_SCOPE_AGENT)) < 64u) { __builtin_amdgcn_s_sleep(1); if (++sp > (1u << 22)) break; }
            asm volatile("buffer_inv sc1" ::: "memory");
        }
    }
    __device__ __forceinline__ void done(const Unit& u) const {
        if (MODE == 1) {
            asm volatile("s_waitcnt vmcnt(0)" ::: "memory");
            if ((tid_opaque() & 63) == 0) __hip_atomic_fetch_add(rdy + u.pm, 1u, __ATOMIC_RELAXED, __HIP_MEMORY_SCOPE_AGENT);
        }
    }
};
typedef GroupOrderT<0> GroupOrder;

#ifndef IDX_FP8
#define IDX_FP8 1
#endif
#ifndef IDX_DEEP
#define IDX_DEEP 0
#endif
constexpr float IDX_KS = 8.0f, IDX_QS = 1.0f;
__device__ __forceinline__ float idx_clamp(float v) { return __builtin_amdgcn_fmed3f(v, -440.0f, 440.0f); }
__device__ __forceinline__ unsigned char f2fp8(float v) { return (unsigned char)(__builtin_amdgcn_cvt_pk_fp8_f32(idx_clamp(v), 0.f, 0, false) & 0xff); }
__device__ __forceinline__ void proj_small(const Params& p, int blk, unsigned char* lds) {
    const int tid = tid_opaque(), wid = tid >> 6, lane = tid & 63, fr = lane & 15, fq = lane >> 4;
    const int r0 = blk * 64 + (wid & 3) * 16, kh = wid >> 2;
    const bf16_t* ap = p.xn + (size_t)(r0 + fr) * 1024 + kh * 512 + fq * 8;
    const bf16_t* bp0 = p.wt_in + (size_t)(PP + fr) * 1024 + kh * 512 + fq * 8; const bf16_t* bp1 = bp0 + 16 * 1024; const bf16_t* bp2 = bp0 + 32 * 1024;
    f32x4 c0 = {0.f, 0.f, 0.f, 0.f}, c1 = {0.f, 0.f, 0.f, 0.f}, c2 = {0.f, 0.f, 0.f, 0.f};
#pragma unroll 8
    for (int ks = 0; ks < 16; ++ks) {
        const bf16x8 a = *(const bf16x8*)(ap + ks * 32), b0 = *(const bf16x8*)(bp0 + ks * 32), b1 = *(const bf16x8*)(bp1 + ks * 32), b2 = *(const bf16x8*)(bp2 + ks * 32);
        c0 = mfma16(a, b0, c0); c1 = mfma16(a, b1, c1); c2 = mfma16(a, b2, c2);
    }
    f32x4* red = (f32x4*)lds;
    if (kh == 1) { red[((wid & 3) * 3 + 0) * 64 + lane] = c0; red[((wid & 3) * 3 + 1) * 64 + lane] = c1; red[((wid & 3) * 3 + 2) * 64 + lane] = c2; }
    __syncthreads();
    if (kh == 0) {
        c0 += red[((wid & 3) * 3 + 0) * 64 + lane]; c1 += red[((wid & 3) * 3 + 1) * 64 + lane]; c2 += red[((wid & 3) * 3 + 2) * 64 + lane];
        const float idx_w_scale = 0.35355339059327373f * 0.17677669529663687f;
#pragma unroll
        for (int r = 0; r < 4; ++r) {
            const int row = r0 + 4 * fq + r, pos = row & (SEQ - 1); const float own = c0[r], oth = __shfl_xor(own, 4); float v = own;
            if (fr < 8) { const float2 cs = *(const float2*)(p.ropei + ((size_t)pos * 4 + (fr & 3)) * 2); v = (fr < 4) ? own * cs.x - oth * cs.y : own * cs.x + oth * cs.y; }
#if IDX_FP8
            ((unsigned char*)p.ikb)[(size_t)row * 32 + fr] = f2fp8(v * IDX_KS); ((unsigned char*)p.ikb)[(size_t)row * 32 + 16 + fr] = f2fp8(c1[r] * IDX_KS);
#else
            p.ikb[(size_t)row * 32 + fr] = f2bf(v); p.ikb[(size_t)row * 32 + 16 + fr] = f2bf(c1[r]);
#endif
        }
#pragma unroll
        for (int r = 0; r < 4; ++r) {
            const int row = r0 + 4 * fq + r; const float v = c2[r];
            if (fr < 8) p.iw[(size_t)row * 8 + fr] = v * idx_w_scale;
            else if (fr < 12) p.mi[(size_t)row * 4 + fr - 8] = v + p.igate_b[fr - 8];
            else { const float z = v + p.fgate_b[fr - 12]; p.mf[(size_t)row * 4 + fr - 12] = fminf(z, 0.f) - log1pf(__expf(-fabsf(z))); }
        }
    }
    __syncthreads();
}

__device__ __forceinline__ bf16x8 tr_frag(const bf16_t* T, int ld, int kbase, int c0, int lane) {
    const int q = lane >> 4, qq = (lane & 15) >> 2, pp = lane & 3;
    const v4i16_t t1 = lds_tr16(T + (kbase + 8 * q + qq) * ld + c0 + 4 * pp), t2 = lds_tr16(T + (kbase + 8 * q + 4 + qq) * ld + c0 + 4 * pp);
    return (bf16x8){t1[0], t1[1], t1[2], t1[3], t2[0], t2[1], t2[2], t2[3]};
}
__device__ __forceinline__ void mlstm_local(const Params& p, int item, unsigned char* lds) {
    const int tid = tid_opaque(), wid = tid >> 6, lane = tid & 63, fr = lane & 15, fq = lane >> 4;
    const int bh = item >> 6, c = item & 63, b = bh >> 2, h = bh & 3, t0 = b * SEQ + c * 64;
    bf16_t* kw = (bf16_t*)lds;
    bf16_t* vl = kw + 64 * 136;
    float* wgt = (float*)(lds + 2 * 64 * 136 * 2);
    float* cwl = wgt + 64;
    if (wid == 0) {
        const float lf = p.mf[(size_t)(t0 + lane) * 4 + h], ii = p.mi[(size_t)(t0 + lane) * 4 + h];
        float bs = lf;
#pragma unroll
        for (int d = 1; d < 64; d <<= 1) { const float o = __shfl_up(bs, d); if (lane >= d) bs += o; }
        const float bl = __shfl(bs, 63); const float wl = bl - bs + ii; const float mx = wave_max(wl);
        wgt[lane] = __expf(wl - mx); p.cb[(size_t)(t0 + lane) * 4 + h] = bs;
        if (lane == 0) { p.bl[item] = bl; p.mloc[item] = mx; }
    } else {
        for (int i = tid - 64; i < 1280; i += 448) { const int j = i >> 8, cc = i & 255; const int src = (cc < 128 ? h * 128 + cc : 512 + h * 128 + cc - 128);
            cwl[i] = (j < 4) ? p.conv_w[j * 1024 + src] : p.conv_b[src]; }
    }
    __syncthreads();
    {
        const int tok = tid >> 3, d0 = (tid & 7) * 16, pos = c * 64 + tok; float aq[16], ak[16];
#pragma unroll
        for (int i = 0; i < 16; ++i) { aq[i] = cwl[1024 + d0 + i]; ak[i] = cwl[1024 + 128 + d0 + i]; }
#pragma unroll
        for (int j = 0; j < 4; ++j) {
            const int pp = pos - 3 + j;
            if (pp >= 0) {
                const bf16_t* rq = p.proj + (size_t)(b * SEQ + pp) * PP + C_MQ + h * 128 + d0; const bf16_t* rk = p.proj + (size_t)(b * SEQ + pp) * PP + C_MK + h * 128 + d0;
                float xq[16], xk[16]; unpack8(*(const u32x4*)rq, xq); unpack8(*(const u32x4*)(rq + 8), xq + 8); unpack8(*(const u32x4*)rk, xk); unpack8(*(const u32x4*)(rk + 8), xk + 8);
                const float* wq = cwl + j * 256 + d0; const float* wk = wq + 128;
#pragma unroll
                for (int i = 0; i < 16; ++i) { aq[i] += wq[i] * xq[i]; ak[i] += wk[i] * xk[i]; }
            }
        }
        const float wt = wgt[tok]; const float ksc = 0.08838834764831845f;
        const bf16_t* rv = p.proj + (size_t)(t0 + tok) * PP + C_MV + h * 128 + d0; const u32x4 v0 = *(const u32x4*)rv, v1 = *(const u32x4*)(rv + 8);
#pragma unroll
        for (int i = 0; i < 16; ++i) { aq[i] = aq[i] * sigmoidf_(aq[i]); ak[i] = ak[i] * sigmoidf_(ak[i]) * ksc; }
        bf16_t* oq = p.cq + (size_t)(t0 + tok) * 512 + h * 128 + d0; bf16_t* ok = p.ck + (size_t)(t0 + tok) * 512 + h * 128 + d0;
        *(u32x4*)oq = pack8(aq); *(u32x4*)(oq + 8) = pack8(aq + 8); *(u32x4*)ok = pack8(ak); *(u32x4*)(ok + 8) = pack8(ak + 8);
#pragma unroll
        for (int i = 0; i < 16; ++i) ak[i] *= wt;
        *(u32x4*)(kw + tok * 136 + d0) = pack8(ak); *(u32x4*)(kw + tok * 136 + d0 + 8) = pack8(ak + 8);
        *(u32x4*)(vl + tok * 136 + d0) = v0; *(u32x4*)(vl + tok * 136 + d0 + 8) = v1;
    }
    __syncthreads();
    {
        bf16x8 a[2];
#pragma unroll
        for (int ks = 0; ks < 2; ++ks) a[ks] = tr_frag(vl, 136, 32 * ks, 16 * wid, lane);
#pragma unroll
        for (int db = 0; db < 8; ++db) {
            f32x4 acc = {0.f, 0.f, 0.f, 0.f};
#pragma unroll
            for (int ks = 0; ks < 2; ++ks) { const bf16x8 bb = tr_frag(kw, 136, 32 * ks, 16 * db, lane); acc = mfma16(bb, a[ks], acc); }
            { u32x2 w; w.x = pk2c(acc[0], acc[1]); w.y = pk2c(acc[2], acc[3]); *(u32x2*)(p.ut + ((size_t)item * 128 + 16 * wid + fr) * 128 + 16 * db + 4 * fq) = w; }
        }
    }
    if (tid < 128) { float s = 0.f;
#pragma unroll 8
        for (int i = 0; i < 64; ++i) s += bf2f(kw[i * 136 + tid]);
        p.nu[(size_t)item * 128 + tid] = s; }
    __syncthreads();
}

__device__ __forceinline__ int slotpos(int key) { const int x = key & 15; return (key & 48) | (8 * ((x >> 2) & 1) + 4 * (x >> 3) + (x & 3)); }
__device__ __forceinline__ void vtrans(const Params& p, int item, unsigned char* lds) {
    const int tid = tid_opaque(), wid = tid >> 6, lane = tid & 63;
    const int bg = item >> 6, c = item & 63, b = bg >> 1, g = bg & 1;
    bf16_t* tl = (bf16_t*)lds;
    { const int key = lane, d8 = wid * 8; float v[8]; unpack8(*(const u32x4*)(p.proj + (size_t)(b * SEQ + c * 64 + key) * PP + C_AV + g * 64 + d8), v); const int sp = slotpos(key);
#pragma unroll
      for (int i = 0; i < 8; ++i) tl[(d8 + i) * 72 + sp] = f2bf(v[i]); }
    __syncthreads();
    { const int d = tid >> 3, ch = tid & 7; *(u32x4*)(p.vt + ((size_t)(bg * 64 + d)) * SEQ + c * 64 + ch * 8) = *(const u32x4*)(tl + d * 72 + ch * 8); }
    __syncthreads();
}

__device__ __forceinline__ void lds_add_u32(unsigned* p, unsigned v) { (void)__hip_atomic_fetch_add((__attribute__((address_space(3))) unsigned*)p, v, __ATOMIC_RELAXED, __HIP_MEMORY_SCOPE_WORKGROUP); }
__device__ __forceinline__ void lds_or_u32(unsigned* p, unsigned v) { (void)__hip_atomic_fetch_or((__attribute__((address_space(3))) unsigned*)p, v, __ATOMIC_RELAXED, __HIP_MEMORY_SCOPE_WORKGROUP); }
__device__ __forceinline__ float relu_bits(float x) { const int b = __float_as_int(x); return __int_as_float(b > 0 ? b : 0); }
template <bool FIRST> __device__ __forceinline__ unsigned topk_bin(float s, float lo, float scale) {
    if constexpr (FIRST) return min((unsigned)((s - lo) * scale), 1023u); else return (unsigned)fminf(fmaxf(s - lo, 0.f) * scale, 1023.0f);
}
#if IDX_FP8
typedef long idxfrag_t;
#else
typedef bf16x8 idxfrag_t;
#endif
struct TopkPre { idxfrag_t afr[2][2]; float wv[2][2][4]; idxfrag_t bfr[4]; };
__device__ __forceinline__ void topk_prefetch(const Params& p, int j, TopkPre& q, int wid, int fr, int fq) {
    const int k = j >> 8, w = j & 255; const int cc = (w & 7) * 4 + (k & 3); const int c = (k < 4) ? cc : 63 - cc; const int b = (w >> 3) & 3, sub = w >> 5;
    const int t0 = b * SEQ + c * 64 + sub * 8, nkb = 4 * (c + 1);
#pragma unroll
    for (int pr = 0; pr < 2; ++pr)
#pragma unroll
        for (int hf = 0; hf < 2; ++hf) {
            const int tok = 4 * pr + (fr >> 2), head = 4 * hf + (fr & 3);
#if IDX_FP8
            { const u32x4 qb = *(const u32x4*)(p.proj + (size_t)(t0 + tok) * PP + C_IQ + head * 32 + fq * 8); float qf_[8]; unpack8(qb, qf_);
              const unsigned lo_ = pk4_fp8(qf_[0], qf_[1], qf_[2], qf_[3]), hi_ = pk4_fp8(qf_[4], qf_[5], qf_[6], qf_[7]);
              q.afr[pr][hf] = (long)(((unsigned long long)hi_ << 32) | lo_); }
            const f32x4 w4 = *(const f32x4*)(p.iw + (size_t)(t0 + 4 * pr + fq) * 8 + 4 * hf) * (1.0f / (IDX_KS * IDX_QS));
#else
            q.afr[pr][hf] = *(const bf16x8*)(p.proj + (size_t)(t0 + tok) * PP + C_IQ + head * 32 + fq * 8);
            const f32x4 w4 = *(const f32x4*)(p.iw + (size_t)(t0 + 4 * pr + fq) * 8 + 4 * hf);
#endif
#pragma unroll
            for (int r = 0; r < 4; ++r) q.wv[pr][hf][r] = w4[r];
        }
    const int kb = (wid * 4 < nkb) ? wid * 4 : 0;
#if IDX_FP8
    const unsigned char* kbp = (const unsigned char*)p.ikb + (size_t)(b * SEQ + fr) * 32 + fq * 8;
#pragma unroll
    for (int u = 0; u < 4; ++u) q.bfr[u] = *(const long*)(kbp + (size_t)(kb + u) * 16 * 32);
#else
    const bf16_t* kbp = p.ikb + (size_t)(b * SEQ + fr) * 32 + fq * 8;
#pragma unroll
    for (int u = 0; u < 4; ++u) q.bfr[u] = *(const bf16x8*)(kbp + (size_t)(kb + u) * 16 * 32);
#endif
}
#ifndef CONV_IN_TOPK
#define CONV_IN_TOPK 1
#endif
__device__ __forceinline__ void idx_topk(const Params& p, int j, unsigned char* lds, const TopkPre& pc, TopkPre& pn, int jnext, bool has_next, bool do_b, int& qi) {
    const int tid = tid_opaque(), wid = tid >> 6, lane = tid & 63, fr = lane & 15, fq = lane >> 4;
    const int k = j >> 8, w = j & 255; const int cc = (w & 7) * 4 + (k & 3); const int c = (k < 4) ? cc : 63 - cc; const int b = (w >> 3) & 3, sub = w >> 5;
    const int t0 = b * SEQ + c * 64 + sub * 8; const int nj = c + 1, nkb = 4 * nj;
    constexpr int SCP = 4096 + 16;
    float* sc = (float*)lds;
    unsigned* hist = (unsigned*)(lds + 8 * SCP * 4) + wid * 512;
    unsigned* wsel = (unsigned*)(lds + 8 * SCP * 4 + 16384) + wid * 128;
    float* cval = (float*)(lds + 8 * SCP * 4 + 16384 + 4096) + wid * 64;
    int* cidx = (int*)(lds + 8 * SCP * 4 + 16384 + 4096 + 2048) + wid * 64;
    float* pm = (float*)(lds + 8 * SCP * 4 + 16384 + 4096 + 4096);
    {
        const idxfrag_t (&afr)[2][2] = pc.afr; const float (&wv)[2][2][4] = pc.wv;
        float mn[2] = {INFINITY, INFINITY}, mx[2] = {-INFINITY, -INFINITY};
#if IDX_FP8
        const unsigned char* kbp = (const unsigned char*)p.ikb + (size_t)(b * SEQ + fr) * 32 + fq * 8;
#else
        const bf16_t* kbp = p.ikb + (size_t)(b * SEQ + fr) * 32 + fq * 8;
#endif
#if IDX_DEEP
        auto score_step = [&](const idxfrag_t (&bfr)[4], int kb0) __attribute__((always_inline)) {
#pragma unroll
            for (int u = 0; u < 4; ++u)
#pragma unroll
                for (int pr = 0; pr < 2; ++pr) {
                    f32x4 c0 = {0.f, 0.f, 0.f, 0.f}, c1 = {0.f, 0.f, 0.f, 0.f};
#if IDX_FP8
                    c0 = __builtin_amdgcn_mfma_f32_16x16x32_fp8_fp8(afr[pr][0], bfr[u], c0, 0, 0, 0); c1 = __builtin_amdgcn_mfma_f32_16x16x32_fp8_fp8(afr[pr][1], bfr[u], c1, 0, 0, 0);
#else
                    c0 = mfma16(afr[pr][0], bfr[u], c0); c1 = mfma16(afr[pr][1], bfr[u], c1);
#endif
                    typedef float f32x2_ __attribute__((ext_vector_type(2)));
                    f32x2_ sa = (f32x2_){wv[pr][0][0], wv[pr][0][1]} * (f32x2_){relu_bits(c0[0]), relu_bits(c0[1])};
                    sa = __builtin_elementwise_fma((f32x2_){wv[pr][0][2], wv[pr][0][3]}, (f32x2_){relu_bits(c0[2]), relu_bits(c0[3])}, sa);
                    sa = __builtin_elementwise_fma((f32x2_){wv[pr][1][0], wv[pr][1][1]}, (f32x2_){relu_bits(c1[0]), relu_bits(c1[1])}, sa);
                    sa = __builtin_elementwise_fma((f32x2_){wv[pr][1][2], wv[pr][1][3]}, (f32x2_){relu_bits(c1[2]), relu_bits(c1[3])}, sa);
                    float s = sa.x + sa.y;
                    s += 0.0f;
                    sc[(4 * pr + fq) * SCP + (kb0 + u) * 16 + fr] = s; mn[pr] = fminf(mn[pr], s); mx[pr] = fmaxf(mx[pr], s);
                }
        };
        idxfrag_t f0[4], f1[4], f2[4];
        const int kbw = __builtin_amdgcn_readfirstlane(wid) * 4;
#define IDX_LD(F, KB) do { if ((KB) < nkb) { const unsigned char* lp_ = kbp + (size_t)(KB) * 16 * 32; \
            asm volatile("global_load_dwordx2 %0, %1, off" : "=v"(F[0]) : "v"(lp_) : "memory"); asm volatile("global_load_dwordx2 %0, %1, off offset:512" : "=v"(F[1]) : "v"(lp_) : "memory"); \
            asm volatile("global_load_dwordx2 %0, %1, off offset:1024" : "=v"(F[2]) : "v"(lp_) : "memory"); asm volatile("global_load_dwordx2 %0, %1, off offset:1536" : "=v"(F[3]) : "v"(lp_) : "memory"); } } while (0)
#define IDX_WAIT(F, KB) do { if ((KB) + 64 < nkb) asm volatile("s_waitcnt vmcnt(8)" ::: "memory"); \
            else if ((KB) + 32 < nkb) asm volatile("s_waitcnt vmcnt(4)" ::: "memory"); \
            else asm volatile("s_waitcnt vmcnt(0)" ::: "memory"); __builtin_amdgcn_sched_barrier(0); } while (0)
#pragma unroll
        for (int u = 0; u < 4; ++u) { f0[u] = pc.bfr[u]; f1[u] = pc.bfr[u]; f2[u] = pc.bfr[u]; }
        asm volatile("" : "+v"(f0[0]), "+v"(f0[1]), "+v"(f0[2]), "+v"(f0[3]));
        if (kbw < nkb) {
            IDX_LD(f1, kbw + 32);
            for (int kb0 = kbw; ; kb0 += 96) {
                IDX_LD(f2, kb0 + 64); IDX_WAIT(f0, kb0); score_step(f0, kb0); if (kb0 + 32 >= nkb) break;
                IDX_LD(f0, kb0 + 96); IDX_WAIT(f1, kb0 + 32); score_step(f1, kb0 + 32); if (kb0 + 64 >= nkb) break;
                IDX_LD(f1, kb0 + 128); IDX_WAIT(f2, kb0 + 64); score_step(f2, kb0 + 64); if (kb0 + 96 >= nkb) break;
            }
        }
#else

        idxfrag_t bfr[4], nfr[4];
#pragma unroll
        for (int u = 0; u < 4; ++u) bfr[u] = pc.bfr[u];
        for (int kb0 = wid * 4; kb0 < nkb; kb0 += 32) {
            const int kn = (kb0 + 32 < nkb) ? kb0 + 32 : kb0;
#pragma unroll
            for (int u = 0; u < 4; ++u) nfr[u] = *(const idxfrag_t*)(kbp + (size_t)(kn + u) * 16 * 32);
#pragma unroll
            for (int u = 0; u < 4; ++u)
#pragma unroll
                for (int pr = 0; pr < 2; ++pr) {
                    f32x4 c0 = {0.f, 0.f, 0.f, 0.f}, c1 = {0.f, 0.f, 0.f, 0.f};
#if IDX_FP8
                    c0 = __builtin_amdgcn_mfma_f32_16x16x32_fp8_fp8(afr[pr][0], bfr[u], c0, 0, 0, 0); c1 = __builtin_amdgcn_mfma_f32_16x16x32_fp8_fp8(afr[pr][1], bfr[u], c1, 0, 0, 0);
#else
                    c0 = mfma16(afr[pr][0], bfr[u], c0); c1 = mfma16(afr[pr][1], bfr[u], c1);
#endif
                    typedef float f32x2_ __attribute__((ext_vector_type(2)));
                    f32x2_ sa = (f32x2_){wv[pr][0][0], wv[pr][0][1]} * (f32x2_){relu_bits(c0[0]), relu_bits(c0[1])};
                    sa = __builtin_elementwise_fma((f32x2_){wv[pr][0][2], wv[pr][0][3]}, (f32x2_){relu_bits(c0[2]), relu_bits(c0[3])}, sa);
                    sa = __builtin_elementwise_fma((f32x2_){wv[pr][1][0], wv[pr][1][1]}, (f32x2_){relu_bits(c1[0]), relu_bits(c1[1])}, sa);
                    sa = __builtin_elementwise_fma((f32x2_){wv[pr][1][2], wv[pr][1][3]}, (f32x2_){relu_bits(c1[2]), relu_bits(c1[3])}, sa);
                    float s = sa.x + sa.y;
                    s += 0.0f;
                    sc[(4 * pr + fq) * SCP + (kb0 + u) * 16 + fr] = s; mn[pr] = fminf(mn[pr], s); mx[pr] = fmaxf(mx[pr], s);
                }
#pragma unroll
            for (int u = 0; u < 4; ++u) bfr[u] = nfr[u];
        }
#endif
#pragma unroll
        for (int pr = 0; pr < 2; ++pr) {
#pragma unroll
            for (int o = 1; o < 16; o <<= 1) { mn[pr] = fminf(mn[pr], __shfl_xor(mn[pr], o)); mx[pr] = fmaxf(mx[pr], __shfl_xor(mx[pr], o)); }
            if (fr == 0) { pm[(wid * 8 + 4 * pr + fq) * 2] = mn[pr]; pm[(wid * 8 + 4 * pr + fq) * 2 + 1] = mx[pr]; }
        }
    }
    __syncthreads();
    constexpr bool PRE_EARLY = !(CONV_IN_TOPK && MOE_FP8) || TK_TILES == 0;
    if (has_next && (PRE_EARLY || !do_b)) topk_prefetch(p, jnext, pn, wid, fr, fq);
#ifndef BREP
#define BREP 1
#endif
    if (do_b) for (int brep_ = 0; brep_ < BREP; ++brep_) {
        const float* row = sc + wid * SCP;
        unsigned long long word = 0ull;
#if CONV_IN_TOPK && MOE_FP8
        f32x4 cv[16]; int cid = -1;
        const int cfirst = blockIdx.x * 8 + __builtin_amdgcn_readfirstlane(wid), cstride = gridDim.x * 8, cn = min((cfirst < NT_W8) ? (NT_W8 - cfirst + cstride - 1) / cstride : 0, TK_TILES);
        qi = __builtin_amdgcn_readfirstlane(qi);
        const int slots = (nj >= 48) ? 3 : (nj >= 24) ? 2 : (nj >= 8) ? 1 : 0;
#define TK_SLOT(more) do { if (cid >= 0) { wt8_store(p, cid, lane, cv); cid = -1; } if ((more) && qi < cn) { cid = cfirst + qi * cstride; ++qi; wt8_load(p, cid, lane, cv); } } while (0)
#else
#define TK_SLOT(more) do { } while (0)
#endif
        if (nj <= 4) { if (lane < nj) word = ~0ull; }
        else {
            float lo = INFINITY, hi = -INFINITY;
#pragma unroll
            for (int i = 0; i < 8; ++i) { lo = fminf(lo, pm[(i * 8 + wid) * 2]); hi = fmaxf(hi, pm[(i * 8 + wid) * 2 + 1]); }
            int need = 256; wsel[lane * 2] = 0u; wsel[lane * 2 + 1] = 0u;
            TK_SLOT(slots >= 1);
            auto level_body = [&](auto first_) -> bool {
                constexpr bool FIRST = decltype(first_)::value;
                if (!(hi > lo)) {
                    for (int jj = 0; jj < nj; ++jj) {
                        const float s = row[jj * 64 + lane]; const unsigned long long em = __ballot(s >= lo && s <= hi);
                        const int ce = __popcll(em); unsigned long long take = em;
                        if (ce > need) { const int rank = __popcll(em & ((1ull << lane) - 1ull)); take = __ballot(((em >> lane) & 1ull) && rank < need); }
                        need -= (ce > need) ? need : ce;
                        if (lane == jj) word |= take;
                    }
                    return true;
                }
                const float scale = 1023.5f / (hi - lo);
#pragma unroll
                for (int i = 0; i < 8; ++i) hist[lane * 8 + i] = 0u;
                asm volatile("s_waitcnt lgkmcnt(0)" ::: "memory");
                for (int jj0 = 0; jj0 < nj; jj0 += 8) {
                    float sv[8];
#pragma unroll
                    for (int u = 0; u < 8; ++u) sv[u] = row[min(jj0 + u, nj - 1) * 64 + lane];
#pragma unroll
                    for (int u = 0; u < 8; ++u) {
                        const float s = sv[u]; const bool part = (FIRST || ((s >= lo) && (s <= hi))) && (jj0 + u < nj);
                        const unsigned bn = topk_bin<FIRST>(s, lo, scale);
                        lds_add_u32(&hist[bn >> 1], part ? (1u << (16 * (bn & 1u))) : 0u);
                    }
                }
                asm volatile("s_waitcnt lgkmcnt(0)" ::: "memory");
                if constexpr (FIRST) TK_SLOT(slots >= 2);
                unsigned cw[8]; int cl = 0;
#pragma unroll
                for (int i = 0; i < 8; ++i) { cw[i] = hist[lane * 8 + i]; cl += (int)(cw[i] & 0xffffu) + (int)(cw[i] >> 16); }
                int inc = cl;
#pragma unroll
                for (int d = 1; d < 64; d <<= 1) { const int o = __shfl_down(inc, d); if (lane + d < 64) inc += o; }
                const unsigned long long okm = __ballot(inc >= need);
                const int L = 63 - __builtin_clzll(okm);
                int bstar_v = 0, above_v = 0;
                { int run = inc - cl; bool found = false;
#pragma unroll
                  for (int bq = 15; bq >= 0; --bq) { const int cnt = (int)((cw[bq >> 1] >> (16 * (bq & 1))) & 0xffffu); if (!found && run + cnt >= need) { found = true; bstar_v = lane * 16 + bq; above_v = run; } run += cnt; } }
                const unsigned bstar = (unsigned)__shfl(bstar_v, L); const int above = __shfl(above_v, L);
                need -= above;
                int base = 0; float cmn = INFINITY, cmx = -INFINITY;
                auto classify = [&](const int jj, const float s) {
                    const bool part = FIRST || ((s >= lo) && (s <= hi));
                    const unsigned bn = topk_bin<FIRST>(s, lo, scale);
                    const bool gt = part && bn > bstar, eq = part && bn == bstar;
                    const unsigned long long gm = __builtin_amdgcn_ballot_w64(gt), em = __builtin_amdgcn_ballot_w64(eq);
                    if constexpr (FIRST) { if (lane == jj) word = gm; } else { if (lane == jj) word |= gm; }
                    if (em) {
                        const int pos = base + (int)__builtin_amdgcn_mbcnt_hi((unsigned)(em >> 32), __builtin_amdgcn_mbcnt_lo((unsigned)em, 0u));
                        if (eq) { cmn = fminf(cmn, s); cmx = fmaxf(cmx, s); if (pos < 64) { cval[pos] = s; cidx[pos] = jj * 64 + lane; } }
                        base += __popcll(em);
                    }
                };
                {
                    int jj = 0;
                    for (; jj + 8 <= nj; jj += 8) {
                        float sv[8];
#pragma unroll
                        for (int u = 0; u < 8; ++u) sv[u] = row[(jj + u) * 64 + lane];
#pragma unroll
                        for (int u = 0; u < 8; ++u) classify(jj + u, sv[u]);
                    }
                    for (; jj + 4 <= nj; jj += 4) {
                        float sv[4];
#pragma unroll
                        for (int u = 0; u < 4; ++u) sv[u] = row[(jj + u) * 64 + lane];
#pragma unroll
                        for (int u = 0; u < 4; ++u) classify(jj + u, sv[u]);
                    }
                    for (; jj < nj; ++jj) classify(jj, row[jj * 64 + lane]);
                }
                if constexpr (FIRST) TK_SLOT(slots >= 3);
                if (base <= 64) {
                    asm volatile("s_waitcnt lgkmcnt(0)" ::: "memory");
                    if (lane < base) {
                        const float v = cval[lane]; const int id = cidx[lane]; int rank = 0;
                        for (int q = 0; q < base; ++q) { const float ov = cval[q]; rank += (ov > v || (ov == v && q < lane)) ? 1 : 0; }
                        if (rank < need) lds_or_u32(&wsel[(id >> 6) * 2 + ((id >> 5) & 1)], 1u << (id & 31));
                    }
                    asm volatile("s_waitcnt lgkmcnt(0)" ::: "memory");
                    word |= ((unsigned long long)wsel[lane * 2 + 1] << 32) | (unsigned long long)wsel[lane * 2];
                    return true;
                }
#pragma unroll
                for (int o = 32; o > 0; o >>= 1) { cmn = fminf(cmn, __shfl_xor(cmn, o)); cmx = fmaxf(cmx, __shfl_xor(cmx, o)); }
                lo = cmn; hi = cmx; return false;
            };
            if (!level_body(std::integral_constant<bool, true>{})) for (int level = 1; level < 16; ++level) if (level_body(std::integral_constant<bool, false>{})) break;
        }
#if CONV_IN_TOPK && MOE_FP8
        if (!PRE_EARLY && has_next && brep_ == BREP - 1) topk_prefetch(p, jnext, pn, wid, fr, fq);
#endif
        TK_SLOT(false);
        if (lane < nj) p.mask[(((size_t)((t0 + wid) >> 6) * 64 + lane) * 64) + ((t0 + wid) & 63)] = word;
#undef TK_SLOT
    }
    __syncthreads();
}

__device__ __forceinline__ void mlstm_scan(const Params& p, int item) {
    const int tid = tid_opaque(), bh = item >> 4, sl = item & 15, idx = sl * 1024 + 2 * tid;
    float C0 = 0.f, C1 = 0.f, m = 0.f, nn = 0.f; const bool don = (sl == 0 && tid < 128);
    const bf16_t* __restrict__ utp = p.ut + (size_t)bh * 64 * 16384 + idx; bf16_t* __restrict__ csp = p.cst + (size_t)bh * 64 * 16384 + idx;
    for (int c0 = 0; c0 < 64; c0 += 16) {
        unsigned uu[16]; float nu[16];
#pragma unroll
        for (int i = 0; i < 16; ++i) { uu[i] = *(const unsigned*)(utp + (size_t)(c0 + i) * 16384); nu[i] = don ? p.nu[(bh * 64 + c0 + i) * 128 + tid] : 0.f; }
#pragma unroll
        for (int i = 0; i < 16; ++i) {
            const int it = bh * 64 + c0 + i; const float bl = p.bl[it], ml = p.mloc[it];
            *(unsigned*)(csp + (size_t)(c0 + i) * 16384) = pk2(C0, C1);
            if (don) { p.ns[it * 128 + tid] = nn; if (tid == 0) p.ms[it] = m; }
            const float mnew = fmaxf(bl + m, ml); const float dec = __expf(bl + m - mnew), su = __expf(ml - mnew);
            C0 = dec * C0 + su * __uint_as_float(uu[i] << 16); C1 = dec * C1 + su * __uint_as_float(uu[i] & 0xffff0000u); nn = dec * nn + su * nu[i]; m = mnew;
        }
    }
}

typedef __bf16 bf16x2_v __attribute__((ext_vector_type(2)));
__device__ __forceinline__ float dot2_ones(unsigned pair, float acc) { return __builtin_amdgcn_fdot2_f32_bf16(__builtin_bit_cast(bf16x2_v, pair), __builtin_bit_cast(bf16x2_v, 0x3f803f80u), acc, false); }
__device__ __forceinline__ void attn_unit(const Params& p, int b, int g, int c, unsigned char* lds, HostQ& wq) {
    const int tid = tid_opaque(), wid = tid >> 6, lane = tid & 63, r32 = lane & 31, hi = lane >> 5;
    const int hq = g * 4 + (wid & 3), tq = (wid >> 2) * 32 + r32, t0 = b * SEQ + c * 64, trow = t0 + tq;
    bf16_t* ktl = (bf16_t*)lds;
    bf16_t* vtl = ktl + 2 * 64 * 72;
    const float C2 = 0.125f * 1.4426950408889634f;
    bf16x8 qf[4];
#pragma unroll
    for (int ds = 0; ds < 4; ++ds) qf[ds] = *(const bf16x8*)(p.proj + (size_t)trow * PP + C_AQ + hq * 64 + ds * 16 + hi * 8);
    f32x16 o0, o1;
#pragma unroll
    for (int r = 0; r < 16; ++r) { o0[r] = 0.f; o1[r] = 0.f; }
    float m_run = -INFINITY, lsum = 0.f;
    const int ntiles = c + 1, srow = tid >> 3, sch = tid & 7;
    const bf16_t* kbase = p.proj + (size_t)(b * SEQ + srow) * PP + C_AK + g * 64 + sch * 8;
    const bf16_t* vbase = p.vt + ((size_t)((b * 2 + g) * 64 + srow)) * SEQ + sch * 8;
    u32x4 kreg = *(const u32x4*)kbase, vreg = *(const u32x4*)vbase;
    *(u32x4*)(ktl + srow * 72 + sch * 8) = kreg; *(u32x4*)(vtl + srow * 72 + sch * 8) = vreg;
    if (ntiles > 1) { kreg = *(const u32x4*)(kbase + (size_t)64 * PP); *(u32x4*)(ktl + 64 * 72 + srow * 72 + sch * 8) = kreg; }
    __syncthreads();
    const unsigned long long* mrow = p.mask + (size_t)(trow >> 6) * 4096 + (trow & 63);
    unsigned long long W0 = mrow[0], W1 = (ntiles > 1) ? mrow[64] : 0ull;
    f32x16 p0, p1;
#pragma unroll
    for (int r = 0; r < 16; ++r) { p0[r] = 0.f; p1[r] = 0.f; }
#pragma unroll
    for (int ds = 0; ds < 4; ++ds) {
        const bf16x8 a0 = *(const bf16x8*)(ktl + r32 * 72 + ds * 16 + hi * 8), a1 = *(const bf16x8*)(ktl + (r32 + 32) * 72 + ds * 16 + hi * 8);
        p0 = mfma32(a0, qf[ds], p0); p1 = mfma32(a1, qf[ds], p1);
    }
    f32x16 q0, q1;
    f32x4 cv[8]; (void)cv;
    auto step = [&](f32x16& p0, f32x16& p1, f32x16& n0, f32x16& n1, const int tile, auto mode_, const int hid) {
        constexpr int MODE = decltype(mode_)::value;
        const int cur = tile & 1;
        if (tile + 2 < ntiles) kreg = *(const u32x4*)(kbase + (size_t)(tile + 2) * 64 * PP);
        if (tile + 1 < ntiles) vreg = *(const u32x4*)(vbase + (tile + 1) * 64);
        const unsigned long long W = W0; W0 = W1; if (tile + 2 < ntiles) W1 = mrow[(tile + 2) * 64];
        if constexpr (MODE == 1) wh8_load(p, hid, lane, cv);
        const bf16_t* vt = vtl + cur * 64 * 72;
#pragma unroll
        for (int r = 0; r < 16; ++r) { n0[r] = 0.f; n1[r] = 0.f; }
        if (tile + 1 < ntiles) {
            const bf16_t* kt = ktl + (cur ^ 1) * 64 * 72;
#pragma unroll
            for (int ds = 0; ds < 4; ++ds) {
                const bf16x8 a0 = *(const bf16x8*)(kt + r32 * 72 + ds * 16 + hi * 8), a1 = *(const bf16x8*)(kt + (r32 + 32) * 72 + ds * 16 + hi * 8);
                n0 = mfma32(a0, qf[ds], n0); n1 = mfma32(a1, qf[ds], n1);
            }
        }
#ifdef ATT_X1
        { f32x16 z0, z1;
#pragma unroll
          for (int r = 0; r < 16; ++r) { z0[r] = 0.f; z1[r] = 0.f; }
#pragma unroll
          for (int ds = 0; ds < 4; ++ds) { z0 = mfma32(qf[ds], qf[(ds + 1) & 3], z0); z1 = mfma32(qf[(ds + 2) & 3], qf[ds], z1); }
          asm volatile("" :: "v"(z0), "v"(z1)); }
#endif
#ifdef ATT_X2
        { float d0 = p0[0], d1 = p1[0];
#pragma unroll
          for (int r = 0; r < 32; ++r) { asm volatile("v_max_f32_e32 %0, %0, %1" : "+v"(d0) : "v"(p0[r & 15])); asm volatile("v_add_f32_e32 %0, %0, %1" : "+v"(d1) : "v"(p1[r & 15])); }
          asm volatile("" :: "v"(d0), "v"(d1)); }
#endif
        const unsigned wlo = (unsigned)W >> (4 * hi), whi = (unsigned)(W >> 32) >> (4 * hi);
        float mx = -INFINITY;
#pragma unroll
        for (int r = 0; r < 16; ++r) { const int kl = (r & 3) + 8 * (r >> 2);
            const unsigned m0 = (unsigned)__builtin_amdgcn_sbfe((int)wlo, kl, 1), m1 = (unsigned)__builtin_amdgcn_sbfe((int)whi, kl, 1);
            p0[r] = __uint_as_float((m0 & __float_as_uint(p0[r])) | (~m0 & 0xff800000u)); p1[r] = __uint_as_float((m1 & __float_as_uint(p1[r])) | (~m1 & 0xff800000u));
            asm("v_max3_f32 %0, %0, %1, %2" : "+v"(mx) : "v"(p0[r]), "v"(p1[r])); }
        mx = fmaxf(mx, __shfl_xor(mx, 32));
        const float mnew = fmaxf(m_run, mx); const float muse = (mnew == -INFINITY) ? 0.f : mnew;
        const float alpha = __builtin_amdgcn_exp2f((m_run - muse) * C2); m_run = mnew;
        const float ms = muse * C2; float ps = 0.f;
#pragma unroll
        for (int r = 0; r < 16; ++r) { p0[r] = __builtin_amdgcn_exp2f(p0[r] * C2 - ms); p1[r] = __builtin_amdgcn_exp2f(p1[r] * C2 - ms); ps += p0[r] + p1[r]; }
        if (__any(alpha != 1.0f)) {
#pragma unroll
            for (int r = 0; r < 16; ++r) { o0[r] *= alpha; o1[r] *= alpha; }
        }
#pragma unroll
        for (int ks = 0; ks < 4; ++ks) {
            u32x4 bw;
            if (ks == 0) { bw.x = pk2(p0[0], p0[1]); bw.y = pk2(p0[2], p0[3]); bw.z = pk2(p0[4], p0[5]); bw.w = pk2(p0[6], p0[7]); }
            else if (ks == 1) { bw.x = pk2(p0[8], p0[9]); bw.y = pk2(p0[10], p0[11]); bw.z = pk2(p0[12], p0[13]); bw.w = pk2(p0[14], p0[15]); }
            else if (ks == 2) { bw.x = pk2(p1[0], p1[1]); bw.y = pk2(p1[2], p1[3]); bw.z = pk2(p1[4], p1[5]); bw.w = pk2(p1[6], p1[7]); }
            else { bw.x = pk2(p1[8], p1[9]); bw.y = pk2(p1[10], p1[11]); bw.z = pk2(p1[12], p1[13]); bw.w = pk2(p1[14], p1[15]); }
            const bf16x8 bfrag = __builtin_bit_cast(bf16x8, bw);
            const bf16x8 a0 = *(const bf16x8*)(vt + r32 * 72 + ks * 16 + hi * 8), a1 = *(const bf16x8*)(vt + (r32 + 32) * 72 + ks * 16 + hi * 8);
            o0 = mfma32(a0, bfrag, o0); o1 = mfma32(a1, bfrag, o1);
        }
        lsum = lsum * alpha + ps;
        if constexpr (MODE == 2) { if (hid >= 0) {
            u32x2 w_[4]; wh8_cvt(cv, w_); u32x4* keep = (u32x4*)(lds + 40960 + wid * 2048 + lane * 32);
            if (hid & 1) { const u32x4 e0 = keep[0], e1 = keep[1]; const u32x2 we[4] = {{e0.x, e0.y}, {e0.z, e0.w}, {e1.x, e1.y}, {e1.z, e1.w}}; wh8_store_pair(p, hid, lane, we, w_); }
            else { keep[0] = (u32x4){w_[0].x, w_[0].y, w_[1].x, w_[1].y}; keep[1] = (u32x4){w_[2].x, w_[2].y, w_[3].x, w_[3].y}; } } }
        if (tile + 2 < ntiles) *(u32x4*)(ktl + cur * 64 * 72 + srow * 72 + sch * 8) = kreg;
        if (tile + 1 < ntiles) *(u32x4*)(vtl + (cur ^ 1) * 64 * 72 + srow * 72 + sch * 8) = vreg;
        __syncthreads();
    };
    typedef std::integral_constant<int, 0> M0; typedef std::integral_constant<int, 1> M1; typedef std::integral_constant<int, 2> M2;
    for (int tile = 0; tile < ntiles; tile += 2) {
        if (tile + 1 < ntiles) {
            const bool hv = wq.i < wq.n; const int hid = hostq_id(wq, hv ? wq.i : 0); wq.i += hv ? 1 : 0;
            step(p0, p1, q0, q1, tile, M1{}, hid); step(q0, q1, p0, p1, tile + 1, M2{}, hv ? hid : -1);
        } else step(p0, p1, q0, q1, tile, M0{}, 0);
    }
    lsum += __shfl_xor(lsum, 32);
    const float inv = 1.0f / lsum;
    bf16_t* orow = p.mix + (size_t)trow * 1024 + hq * 64;
#pragma unroll
    for (int r4 = 0; r4 < 4; ++r4) {
        const int d = 8 * r4 + 4 * hi; u32x2 w0, w1;
        w0.x = pk2(o0[4 * r4] * inv, o0[4 * r4 + 1] * inv); w0.y = pk2(o0[4 * r4 + 2] * inv, o0[4 * r4 + 3] * inv);
        w1.x = pk2(o1[4 * r4] * inv, o1[4 * r4 + 1] * inv); w1.y = pk2(o1[4 * r4 + 2] * inv, o1[4 * r4 + 3] * inv);
        *(u32x2*)(orow + d) = w0; *(u32x2*)(orow + 32 + d) = w1;
    }
}


struct MoPre { u32x4 q[2], k[2], c[4], v[2]; };
__device__ __forceinline__ void mout_prefetch(const Params& p, int item, MoPre& m, int tid) {
    const int bh = item >> 6, c = item & 63, b = bh >> 2, h = bh & 3, t0 = b * SEQ + c * 64, row = tid >> 3, ch = tid & 7;
#pragma unroll
    for (int i = 0; i < 2; ++i) { const int cch = ch + 8 * i;
        m.q[i] = *(const u32x4*)(p.cq + (size_t)(t0 + row) * 512 + h * 128 + cch * 8); m.k[i] = *(const u32x4*)(p.ck + (size_t)(t0 + row) * 512 + h * 128 + cch * 8);
        m.v[i] = *(const u32x4*)(p.proj + (size_t)(t0 + row) * PP + C_MV + h * 128 + cch * 8); }
#pragma unroll
    for (int i = 0; i < 4; ++i) { const int q = tid + 512 * i, e = q >> 4, cch = q & 15; m.c[i] = *(const u32x4*)(p.cst + (size_t)item * 16384 + e * 128 + cch * 8); }
}
template <bool HOST>
__device__ __forceinline__ void mlstm_out(const Params& p, int item, unsigned char* lds, int wtile, const MoPre& mc, MoPre& mn, int next_item, bool has_next) {
    const int tid = tid_opaque(), wid = tid >> 6, lane = tid & 63, fr = lane & 15, fq = lane >> 4;
    const int bh = item >> 6, c = item & 63, b = bh >> 2, h = bh & 3, t0 = b * SEQ + c * 64;
    bf16_t* Ql = (bf16_t*)lds;
    bf16_t* Kl = (bf16_t*)(lds + 17408);
    bf16_t* Vl = (bf16_t*)(lds + 34816);
    bf16_t* CT = (bf16_t*)(lds + 53248);
    float* HB = (float*)(lds + 53248);
    bf16_t* SS = (bf16_t*)(lds + 88064);
    float* bsum = (float*)(lds + 97280); float* aa = bsum + 64; float* mt = aa + 64; float* iwt = mt + 64; float* den = iwt + 64; float* nvec = den + 64;
    {
        const int row = tid >> 3, ch = tid & 7;
#pragma unroll
        for (int i = 0; i < 2; ++i) { const int cch = ch + 8 * i;
            *(u32x4*)(Ql + row * 136 + cch * 8) = mc.q[i]; *(u32x4*)(Kl + row * 136 + cch * 8) = mc.k[i]; *(u32x4*)(Vl + row * 136 + cch * 8) = mc.v[i]; }
#pragma unroll
        for (int i = 0; i < 4; ++i) { const int q = tid + 512 * i, e = q >> 4, cch = q & 15; *(u32x4*)(CT + e * 136 + cch * 8) = mc.c[i]; }
        if (wid == 0) {
            const float bs = p.cb[(size_t)(t0 + lane) * 4 + h], ii = p.mi[(size_t)(t0 + lane) * 4 + h]; const float a = ii - bs; float pm = a;
#pragma unroll
            for (int d = 1; d < 64; d <<= 1) { const float o = __shfl_up(pm, d); if (lane >= d) pm = fmaxf(pm, o); }
            const float mprev = p.ms[item]; const float mtv = bs + fmaxf(mprev, pm);
            bsum[lane] = bs; aa[lane] = a; mt[lane] = mtv; iwt[lane] = __expf(bs + mprev - mtv);
        } else if (wid <= 2) { nvec[tid - 64] = p.ns[(size_t)item * 128 + tid - 64]; }
    }
    __syncthreads();
    if (has_next) mout_prefetch(p, next_item, mn, tid);
    f32x4 cv[16]; (void)cv;
    if constexpr (HOST) wt8_load(p, wtile, lane, cv);
    const int tb = wid >> 1;
    {
#pragma unroll
        for (int sbi = 0; sbi < 2; ++sbi) {
            const int sb = (wid & 1) * 2 + sbi; f32x4 acc = {0.f, 0.f, 0.f, 0.f};
#pragma unroll
            for (int ks = 0; ks < 4; ++ks) { const bf16x8 a = *(const bf16x8*)(Ql + (16 * tb + fr) * 136 + ks * 32 + fq * 8), bb = *(const bf16x8*)(Kl + (16 * sb + fr) * 136 + ks * 32 + fq * 8); acc = mfma16(a, bb, acc); }
            const int s = 16 * sb + fr; const float as = aa[s];
#pragma unroll
            for (int r = 0; r < 4; ++r) { const int t = 16 * tb + 4 * fq + r; const float v = (s <= t) ? acc[r] * __expf(bsum[t] + as - mt[t]) : 0.f; SS[t * 72 + s] = f2bf(v); }
        }
    }
    __syncthreads();
    if (wid == 0) {
        const int t = lane; float s1 = 0.f, s2 = 0.f;
        for (int s = 0; s < 64; ++s) s1 += bf2f(SS[t * 72 + s]);
        for (int d = 0; d < 128; ++d) s2 += bf2f(Ql[t * 136 + d]) * nvec[d];
        den[t] = s1 + iwt[t] * s2;
    }
    f32x4 num[4];
#pragma unroll
    for (int ebi = 0; ebi < 4; ++ebi) {
        const int eb = (wid & 1) * 4 + ebi; f32x4 a1 = {0.f, 0.f, 0.f, 0.f}, a2 = {0.f, 0.f, 0.f, 0.f};
#pragma unroll
        for (int ks = 0; ks < 2; ++ks) { const bf16x8 a = *(const bf16x8*)(SS + (16 * tb + fr) * 72 + ks * 32 + fq * 8), bb = tr_frag(Vl, 136, 32 * ks, 16 * eb, lane); a1 = mfma16(a, bb, a1); }
#pragma unroll
        for (int ks = 0; ks < 4; ++ks) { const bf16x8 a = *(const bf16x8*)(Ql + (16 * tb + fr) * 136 + ks * 32 + fq * 8), bb = *(const bf16x8*)(CT + (16 * eb + fr) * 136 + ks * 32 + fq * 8); a2 = mfma16(a, bb, a2); }
#pragma unroll
        for (int r = 0; r < 4; ++r) num[ebi][r] = a1[r] + iwt[16 * tb + 4 * fq + r] * a2[r];
    }
    __syncthreads();
#pragma unroll
    for (int ebi = 0; ebi < 4; ++ebi) {
        const int e = 16 * ((wid & 1) * 4 + ebi) + fr;
#pragma unroll
        for (int r = 0; r < 4; ++r) { const int t = 16 * tb + 4 * fq + r; const float dn = fmaxf(fabsf(den[t]), __expf(-mt[t])); HB[t * 132 + e] = num[ebi][r] * __builtin_amdgcn_rcpf(dn); }
    }
    __syncthreads();
    if constexpr (HOST) wt8_store(p, wtile, lane, cv);
    {
        const int t = tid >> 3, e16 = (tid & 7) * 16; float hv[16]; float ss = 0.f;
#pragma unroll
        for (int i = 0; i < 16; ++i) { hv[i] = HB[t * 132 + e16 + i]; ss += hv[i] * hv[i]; }
        ss += __shfl_xor(ss, 1); ss += __shfl_xor(ss, 2); ss += __shfl_xor(ss, 4);
        const float rs = 1.0f / sqrtf(ss * (1.0f / 128.0f) + NORM_EPS);
        float mo[16]; const bf16_t* rm = p.proj + (size_t)(t0 + t) * PP + C_MO + h * 128 + e16; unpack8(*(const u32x4*)rm, mo); unpack8(*(const u32x4*)(rm + 8), mo + 8);
        const float* nw = p.mlstm_norm_w + h * 128 + e16; float o[16];
#pragma unroll
        for (int i = 0; i < 16; ++i) o[i] = hv[i] * rs * nw[i] * sigmoidf_(mo[i]);
        { const size_t ob = ((size_t)(t0 + t) * 1024 + 512 + h * 128 + e16) * 2; store16_wt(p.mix, ob, pack8(o)); store16_wt(p.mix, ob + 16, pack8(o + 8)); }
    }
    __syncthreads();
}

__device__ __forceinline__ void compute_tstart(const Params& p, int* ts) {
    if (threadIdx.x == 0) { int a = 0; for (int e = 0; e < NEXP; ++e) { ts[e] = a; a += (p.cnt[e] + 255) >> 8; } ts[NEXP] = a; }
    __syncthreads();
}

__device__ __forceinline__ void scatter_tokens(const Params& p, const int* ts, int t_begin, int t_end, int wid, int lane) {
    constexpr int NTK = 4;
    float4 nw[4];
#pragma unroll
    for (int i = 0; i < 4; ++i) nw[i] = *(const float4*)(p.ffn_norm_w + i * 256 + lane * 4);
    for (int t0 = t_begin + wid; t0 < t_end; t0 += 8 * NTK) {
        int tt[NTK]; float rs[NTK]; u32x2 xa[NTK][4]; size_t dst[NTK][4];
#pragma unroll
        for (int j = 0; j < NTK; ++j) { tt[j] = min(t0 + 8 * j, t_end - 1); rs[j] = p.rsv[tt[j]];
#pragma unroll
            for (int i = 0; i < 4; ++i) xa[j][i] = *(const u32x2*)(p.x1 + (size_t)tt[j] * DM + i * 256 + lane * 4);
#pragma unroll
            for (int k = 0; k < 4; ++k) { const int e = p.tope[tt[j] * 4 + k]; dst[j][k] = (size_t)ts[e] * 256 + p.topp[tt[j] * 4 + k]; } }
#pragma unroll
        for (int j = 0; j < NTK; ++j) {
            if (t0 + 8 * j >= t_end) break;
            u32x2 h[4]; unsigned h8[4];
#pragma unroll
            for (int i = 0; i < 4; ++i) { const float4 w = nw[i];
                const float4 a = make_float4(__uint_as_float(xa[j][i].x << 16), __uint_as_float(xa[j][i].x & 0xffff0000u), __uint_as_float(xa[j][i].y << 16), __uint_as_float(xa[j][i].y & 0xffff0000u));
                h[i].x = pk2(a.x * rs[j] * w.x, a.y * rs[j] * w.y); h[i].y = pk2(a.z * rs[j] * w.z, a.w * rs[j] * w.w);
                h8[i] = pk4_fp8(a.x * rs[j] * w.x * FP8_XS, a.y * rs[j] * w.y * FP8_XS, a.z * rs[j] * w.z * FP8_XS, a.w * rs[j] * w.w * FP8_XS); }
#pragma unroll
            for (int k = 0; k < 4; ++k) {
#if MOE_FP8
#pragma unroll
                for (int i = 0; i < 4; ++i) *(unsigned*)((unsigned char*)p.xbuf + dst[j][k] * DM + i * 256 + lane * 4) = h8[i];
#else
#pragma unroll
                for (int i = 0; i < 4; ++i) *(u32x2*)(p.xbuf + dst[j][k] * DM + i * 256 + lane * 4) = h[i];
#endif
            }
        }
    }
}

__device__ __forceinline__ void router_phase(const Params& p, unsigned char* lds) {
    const int tid = tid_opaque(), wid = tid >> 6, lane = tid & 63, fr = lane & 15, fq = lane >> 4;
    constexpr int RWS = 36;
    float* rw = (float*)lds;
    unsigned char* ex = lds + 1024 * RWS * 4;
    float* lg = (float*)ex;
    float* rsq = lg + 64 * 33;
    int* lcnt = (int*)(rsq + 64); int* lbase = lcnt + 32;
    float* selv = (float*)(lbase + 32);
    int* sele = (int*)(selv + 256);
    int* info = sele + 256;
    float* ginfo = (float*)(info + 512);
    {
        float4 rv[16]; float nv[16];
#pragma unroll
        for (int q = 0; q < 16; ++q) { const int i4 = tid + q * NTHREADS; rv[q] = ((const float4*)p.router_w)[i4]; nv[q] = p.ffn_norm_w[i4 >> 3]; }
#pragma unroll
        for (int q = 0; q < 16; ++q) { const int i4 = tid + q * NTHREADS, d = i4 >> 3, e = (i4 & 7) * 4; *(float4*)(rw + d * RWS + e) = make_float4(rv[q].x * nv[q], rv[q].y * nv[q], rv[q].z * nv[q], rv[q].w * nv[q]); }
    }
    __syncthreads();
    for (int grp = blockIdx.x; grp < T_TOK / 64; grp += gridDim.x) {
        if (tid < 32) lcnt[tid] = 0;
        {
            const int tb = (wid & 3) * 16, half = wid >> 2;
            const bf16_t* xr = p.x1 + ((size_t)grp * 64 + tb + fr) * DM + fq * 8; const float* rwp = rw + (fq * 8) * RWS + half * 16 + fr;
            f32x4 acc = {0.f, 0.f, 0.f, 0.f}; float ssq = 0.f;
#pragma unroll 16
            for (int kk = 0; kk < 32; ++kk) {
                const u32x4 xa = *(const u32x4*)(xr + kk * 32); float a[8]; unpack8(xa, a);
                const float* rr = rwp + kk * 32 * RWS;
#pragma unroll
                for (int j = 0; j < 8; ++j) { ssq += a[j] * a[j]; acc = __builtin_amdgcn_mfma_f32_16x16x4f32(a[j], rr[j * RWS], acc, 0, 0, 0); }
            }
            ssq += __shfl_xor(ssq, 16); ssq += __shfl_xor(ssq, 32);
            if (half == 0 && fq == 0) { const float rs = 1.0f / sqrtf(ssq * (1.0f / DM) + NORM_EPS); rsq[tb + fr] = rs; p.rsv[(size_t)grp * 64 + tb + fr] = rs; }
#pragma unroll
            for (int r = 0; r < 4; ++r) lg[(tb + 4 * fq + r) * 33 + half * 16 + fr] = acc[r];
        }
        __syncthreads();
        for (int rd = 0; rd < 4; ++rd) {
            const int tl = wid * 8 + rd * 2 + (lane >> 5), e = lane & 31; float* l = lg + tl * 33;
            const float v = l[e] * rsq[tl] + p.router_b[e];
            l[e] = v;
            int rank = 0;
#pragma unroll
            for (int o = 0; o < 32; ++o) { const float ov = l[o]; rank += (ov > v || (ov == v && o < e)) ? 1 : 0; }
            if (rank < 4) { selv[tl * 4 + rank] = v; sele[tl * 4 + rank] = e; }
            if (e < 4) {
                const float* sv = selv + tl * 4; const float v0 = sv[0]; const float e1 = __expf(sv[1] - v0), e2 = __expf(sv[2] - v0), e3 = __expf(sv[3] - v0); const float sum = 1.0f + e1 + e2 + e3;
                const float mine = (e == 0 ? 1.0f : e == 1 ? e1 : e == 2 ? e2 : e3) / sum; const int ex_ = sele[tl * 4 + e];
                const int lp = atomicAdd(&lcnt[ex_], 1);
                info[(tl * 4 + e) * 2] = ex_; info[(tl * 4 + e) * 2 + 1] = lp; ginfo[tl * 4 + e] = mine;
            }
        }
        __syncthreads();
        if (tid < 32) lbase[tid] = atomicAdd(&p.cnt[tid], lcnt[tid]);
        __syncthreads();
        if (tid < 256) { const int e = info[tid * 2], lp = info[tid * 2 + 1]; const size_t o = (size_t)grp * 256 + tid; p.tope[o] = e; p.topp[o] = lbase[e] + lp; p.topg[o] = ginfo[tid]; }
        __syncthreads();
    }
    asm volatile("s_waitcnt vmcnt(0)" ::: "memory");
    __syncthreads();
    if (tid == 0) {
        const int mine = (T_TOK / 64 - (int)blockIdx.x + (int)gridDim.x - 1) / (int)gridDim.x;
        __builtin_amdgcn_fence(__ATOMIC_RELEASE, "agent"); asm volatile("s_waitcnt vmcnt(0)" ::: "memory");
        __hip_atomic_fetch_add((unsigned*)&p.cnt[32], (unsigned)mine, __ATOMIC_RELAXED, __HIP_MEMORY_SCOPE_AGENT);
        unsigned sp = 0;
        while (__hip_atomic_load((unsigned*)&p.cnt[32], __ATOMIC_RELAXED, __HIP_MEMORY_SCOPE_AGENT) < (unsigned)(T_TOK / 64)) { __builtin_amdgcn_s_sleep(2); if (++sp > (1u << 22)) break; }
        __builtin_amdgcn_fence(__ATOMIC_ACQUIRE, "agent"); asm volatile("s_waitcnt vmcnt(0)" ::: "memory");
    }
    __syncthreads();
    int* ts = (int*)lds;
    compute_tstart(p, ts);
    for (int grp = blockIdx.x; grp < T_TOK / 64; grp += gridDim.x) scatter_tokens(p, ts, grp * 64, grp * 64 + 64, wid, lane);
}

__device__ __forceinline__ void combine_phase(const Params& p, unsigned char* lds) {
    const int tid = tid_opaque(), wid = tid >> 6, lane = tid & 63; int* ts = (int*)lds;
    compute_tstart(p, ts);
    const unsigned char* Y = (const unsigned char*)p.ybuf;
    constexpr int NTK = 4;
    const int tstride = gridDim.x * 8;
    for (int t0 = blockIdx.x * 8 + wid; t0 < T_TOK; t0 += tstride * NTK) {
        int tt[NTK]; size_t src[NTK][4]; float gs[NTK][4];
#pragma unroll
        for (int j = 0; j < NTK; ++j) { tt[j] = min(t0 + j * tstride, T_TOK - 1);
#pragma unroll
            for (int k = 0; k < 4; ++k) { const int e = p.tope[tt[j] * 4 + k]; src[j][k] = (size_t)ts[e] * 256 + p.topp[tt[j] * 4 + k]; gs[j][k] = p.topg[tt[j] * 4 + k] * (Y_FP8 ? 1.0f / FP8_YS : 1.0f); } }
        u32x2 xa[NTK][4];
#if Y_FP8
        unsigned yw[NTK][4][4];
#else
        u32x2 yw[NTK][4][4];
#endif
#pragma unroll
        for (int j = 0; j < NTK; ++j) {
#pragma unroll
            for (int i = 0; i < 4; ++i) xa[j][i] = __builtin_nontemporal_load((const u32x2*)(p.x1 + (size_t)tt[j] * DM + i * 256 + lane * 4));
#pragma unroll
            for (int k = 0; k < 4; ++k)
#pragma unroll
                for (int i = 0; i < 4; ++i) {
#if Y_FP8
                    yw[j][k][i] = __builtin_nontemporal_load((const unsigned*)(Y + src[j][k] * DM + i * 256 + lane * 4));
#else
                    yw[j][k][i] = __builtin_nontemporal_load((const u32x2*)(Y + (src[j][k] * DM + i * 256 + lane * 4) * 2));
#endif
                }
        }
#pragma unroll
        for (int j = 0; j < NTK; ++j) {
            float v[16];
#pragma unroll
            for (int i = 0; i < 4; ++i) { v[4 * i] = __uint_as_float(xa[j][i].x << 16); v[4 * i + 1] = __uint_as_float(xa[j][i].x & 0xffff0000u); v[4 * i + 2] = __uint_as_float(xa[j][i].y << 16); v[4 * i + 3] = __uint_as_float(xa[j][i].y & 0xffff0000u); }
#pragma unroll
            for (int k = 0; k < 4; ++k)
#pragma unroll
                for (int i = 0; i < 4; ++i) {
#if Y_FP8
                    const int w = (int)yw[j][k][i];
                    v[4 * i] += gs[j][k] * __builtin_amdgcn_cvt_f32_fp8(w, 0); v[4 * i + 1] += gs[j][k] * __builtin_amdgcn_cvt_f32_fp8(w, 1); v[4 * i + 2] += gs[j][k] * __builtin_amdgcn_cvt_f32_fp8(w, 2); v[4 * i + 3] += gs[j][k] * __builtin_amdgcn_cvt_f32_fp8(w, 3);
#else
                    const u32x2 w = yw[j][k][i];
                    v[4 * i] += gs[j][k] * __uint_as_float(w.x << 16); v[4 * i + 1] += gs[j][k] * __uint_as_float(w.x & 0xffff0000u); v[4 * i + 2] += gs[j][k] * __uint_as_float(w.y << 16); v[4 * i + 3] += gs[j][k] * __uint_as_float(w.y & 0xffff0000u);
#endif
                }
            float ss = 0.f;
#pragma unroll
            for (int i = 0; i < 16; ++i) ss += v[i] * v[i];
            ss = wave_sum(ss); const float rs = 1.0f / sqrtf(ss * (1.0f / DM) + NORM_EPS);
            if (t0 + j * tstride < T_TOK) {
#pragma unroll
                for (int i = 0; i < 4; ++i) { const float4 w = *(const float4*)(p.final_norm_w + i * 256 + lane * 4);
                    __builtin_nontemporal_store((f32x4){v[4 * i] * rs * w.x, v[4 * i + 1] * rs * w.y, v[4 * i + 2] * rs * w.z, v[4 * i + 3] * rs * w.w}, (f32x4*)(p.out + (size_t)tt[j] * DM + i * 256 + lane * 4)); }
            }
        }
    }
}

#ifndef MK_SPLIT
#define MK_SPLIT 0
#endif
constexpr int N_PHASES = 11;

__device__ __forceinline__ void run_phase(const Params& p, int ph, unsigned char* lds) {
    typedef __attribute__((address_space(3))) unsigned char* las_ptr;
    const int G = gridDim.x, c = blockIdx.x;
    switch (ph) {
    case 0: phase_prologue(p, lds); break;
    case 1: {
        Gemm g{PROJ_FP8 ? (const bf16_t*)p.xn8 : p.xn, PROJ_FP8 ? (const bf16_t*)p.wt_in8 : p.wt_in, T_TOK, PP, 1024}; pg8::StaticOrder S; S.init(T_TOK, PP, G, c);
        EpiProjT<PROJ_FP8 != 0> E{p.proj, p.ikb, p.iw, p.mi, p.mf, p.ropea, p.ropei, p.igate_b, p.fgate_b};
        const bool conv_first = ((c >> 3) & 1) != 0;
#ifdef PROBE_LOADONLY
        if (conv_first) convert_fp8_loadonly(p);
#endif
        if (conv_first) { if (CONV_WAVES && MOE_FP8 && !CONV_IN_TOPK) convert_fp8_waves(p, 0); convert_streamed(p, lds, 0, streamed_tiles_of_wg()); __syncthreads(); }
        pg8::gemm_phase<EpiProjT<PROJ_FP8 != 0>, pg8::StaticOrder, true, true, PROJ_FP8 != 0>((las_ptr)lds, g, S, E);
        for (int blk = c; blk < T_TOK / 64; blk += G) proj_small(p, blk, lds);
        if (!conv_first) { __syncthreads(); convert_streamed(p, lds, 0, streamed_tiles_of_wg()); if (CONV_WAVES && MOE_FP8 && !CONV_IN_TOPK) convert_fp8_waves(p, 0); }
#ifdef PROBE_LOADONLY
        if (!conv_first) convert_fp8_loadonly(p);
#endif
    } break;
    case 2: {
#ifndef P2A_REP
#define P2A_REP 1
#endif
#ifndef P2C_REP
#define P2C_REP 1
#endif
        for (int r_ = 0; r_ < P2A_REP; ++r_) for (int it = c; it < 1024 + 512; it += G) { if (it < 1024) mlstm_local(p, it, lds); else vtrans(p, it - 1024, lds); }
        for (int r_ = 0; r_ < P2C_REP; ++r_) {
            TopkPre tkc, tkn; const int tid_ = tid_opaque();
            if (c < 2048) topk_prefetch(p, c, tkc, tid_ >> 6, tid_ & 15, (tid_ & 63) >> 4);
            int qi = 0;
            for (int it = c; it < 2048; it += G) { idx_topk(p, it, lds, tkc, tkn, it + G, it + G < 2048, r_ == 0, qi); tkc = tkn; }
#if CONV_IN_TOPK && MOE_FP8
            if (r_ == 0) convert_fp8_rest(p, qi, TK_TILES);
#endif
        }
    } break;
    case 3: {
#ifndef ATTN_UNIT
#define ATTN_UNIT attn_unit
#endif
#ifndef P3A_REP
#define P3A_REP 1
#endif
#ifndef P3B_REP
#define P3B_REP 1
#endif
        for (int r_ = 0; r_ < P3A_REP; ++r_) for (int it = c; it < 256; it += G) mlstm_scan(p, it);
        for (int r_ = 0; r_ < P3B_REP; ++r_) {
            HostQ hq; hq.stride = G * 8; hq.first = c * 8 + __builtin_amdgcn_readfirstlane(tid_opaque() >> 6) + TK_TILES * hq.stride; hq.i = 0;
            hq.n = (CONV_IN_TOPK && MOE_FP8 && hq.first < NT_W8) ? 2 * ((NT_W8 - hq.first + hq.stride - 1) / hq.stride) : 0;
            for (int pi = c; pi < 256; pi += G) { const int b = pi >> 6, g = (pi >> 5) & 1, cp = pi & 31; for (int uu = 0; uu < 2; ++uu) ATTN_UNIT(p, b, g, uu ? cp : 63 - cp, lds, hq); }
            hq.i &= ~1;
            for (; hq.i < hq.n; ++hq.i) { f32x4 v[8]; const int lane_ = tid_opaque() & 63; wh8_load(p, hostq_id(hq, hq.i), lane_, v); wh8_store(p, hostq_id(hq, hq.i), lane_, v); }
        }
    } break;
    case 4: {
        MoPre mc, mn; if (c < 1024) mout_prefetch(p, c, mc, tid_opaque());
        for (int it = c; it < 1024; it += G) { mlstm_out<false>(p, it, lds, 0, mc, mn, it + G, it + G < 1024); mc = mn; }
    } break;
    case 5: {
        Gemm g{p.mix, p.wt_out, T_TOK, 1024, 1024}; pg8::StaticOrder S; S.init(T_TOK, 1024, G, c);
        EpiResid E{p.x, p.x1};
        pg8::gemm_phase<EpiResid, pg8::StaticOrder, true, true>((las_ptr)lds, g, S, E);
    } break;
    case 6: router_phase(p, lds); break;
    case 7: break;
    case 8: {
        int* ts = (int*)(lds + 131072); compute_tstart(p, ts);
        const int upr = (G == 256) ? 32 : 1, nfull = (G == 256) ? ts[NEXP] / upr : 1 << 20;
        Gemm g{p.xbuf, p.wt_gu, XROWS, 2048, 1024}; GroupOrderT<0> S{ts, 8, G, c, 0, nfull, p.rdy, 0}; EpiSwigluT<false> E{p.b_gu, p.act};
        pg8::gemm_phase<EpiSwigluT<false>, GroupOrderT<0>, true, true, MOE_FP8 != 0>((las_ptr)lds, g, S, E);
    } break;
    case 9: {
        int* ts = (int*)(lds + 131072); compute_tstart(p, ts);
        const int nfull = (G == 256) ? ts[NEXP] / 32 : 1 << 20, lim = (G == 256) ? nfull * 32 : 1 << 30;
        if (G == 256) {
            Gemm g{p.xbuf, p.wt_gu, XROWS, 2048, 1024}; GroupOrderT<1> S{ts, 8, G, c, nfull, 1 << 20, p.rdy, 0}; EpiSwigluT<true> E{p.b_gu, p.act};
            pg8::gemm_phase<EpiSwigluT<true>, GroupOrderT<1>, true, true, MOE_FP8 != 0>((las_ptr)lds, g, S, E);
        }
        Gemm g{p.act, p.wt_dn, XROWS, 1024, 1024}; GroupOrderT<2> S{ts, 4, G, c, 0, 1 << 20, p.rdy, lim}; EpiBiasBf16 E{p.b_dn, p.ybuf};
        pg8::gemm_phase<EpiBiasBf16, GroupOrderT<2>, true, true, MOE_FP8 != 0>((las_ptr)lds, g, S, E);
    } break;
    case 10: combine_phase(p, lds); break;
    }
}

#if MK_SPLIT
template <int PH> __global__ void __launch_bounds__(NTHREADS) fwd_phase_kernel(Params p) {
    extern __shared__ __attribute__((aligned(16))) unsigned char lds[];
    run_phase(p, PH, lds);
}
template <int PH> static void launch_phase(const Params& p, hipStream_t stream) {
    (void)hipFuncSetAttribute((const void*)fwd_phase_kernel<PH>, hipFuncAttributeMaxDynamicSharedMemorySize, LDS_BYTES);
    hipLaunchKernelGGL(fwd_phase_kernel<PH>, dim3(256), dim3(NTHREADS), LDS_BYTES, stream, p);
}
#else
#ifndef REP0
#define REP0 1
#endif
#ifndef REP1
#define REP1 1
#endif
#ifndef REP2
#define REP2 1
#endif
#ifndef REP3
#define REP3 1
#endif
#ifndef REP4
#define REP4 1
#endif
#ifndef REP5
#define REP5 1
#endif
#ifndef REP7
#define REP7 1
#endif
#ifndef REP8
#define REP8 1
#endif
#ifndef REP9
#define REP9 1
#endif
#ifndef REP10
#define REP10 1
#endif
__global__ void __launch_bounds__(NTHREADS) fwd_megakernel(Params p) {
    extern __shared__ __attribute__((aligned(16))) unsigned char lds[];
    cg::grid_group grid = cg::this_grid();
    volatile LAS unsigned* xbst = (volatile LAS unsigned*)(lds + LDS_BYTES - 16);
    if (tid_opaque() == 0) { xbst[0] = 0u; xbst[1] = 0u; }
    __syncthreads();
#ifdef DBG_PH
#define STAMP(k) do { if (blockIdx.x == 0 && tid_opaque() == 0) ((unsigned long long*)(p.cnt + 64))[k] = __builtin_amdgcn_s_memrealtime(); } while (0)
#else
#define STAMP(k) do { } while (0)
#endif
    const XcdBarrier xb = xcd_barrier_post(p.bar, xbst);
#define XSYNC() xcd_barrier(xb)
    STAMP(0); run_phase(p, 0, lds); __syncthreads();
    if (p.cg_first) grid.sync(); else XSYNC();
    STAMP(1);
#define RUN(ph, rep) do { for (int r_ = 0; r_ < (rep); ++r_) { run_phase(p, ph, lds); if (r_ + 1 < (rep)) XSYNC(); } } while (0)
    RUN(1, REP1); XSYNC(); STAMP(2); RUN(2, REP2); XSYNC(); STAMP(3); RUN(3, REP3); XSYNC(); STAMP(4); RUN(4, REP4); XSYNC(); STAMP(5); RUN(5, REP5); XSYNC(); STAMP(6);
    run_phase(p, 6, lds); XSYNC(); STAMP(7); STAMP(8); RUN(8, REP8); XSYNC(); STAMP(9); RUN(9, REP9); XSYNC(); STAMP(10); RUN(10, REP10);
#undef RUN
#undef XSYNC
}
#endif

extern "C" void kernel_launch(void* const* d_in, const int* in_sizes, int n_in, void* d_out, int out_size, void* d_ws, size_t ws_size, hipStream_t stream) {
    (void)in_sizes; (void)n_in; (void)out_size;
    Params p{};
    p.x = (const float*)d_in[0]; p.mix_norm_w = (const float*)d_in[1]; p.w_in = (const float*)d_in[2]; p.conv_w = (const float*)d_in[3]; p.conv_b = (const float*)d_in[4];
    p.igate_b = (const float*)d_in[5]; p.fgate_b = (const float*)d_in[6]; p.mlstm_norm_w = (const float*)d_in[7]; p.w_out = (const float*)d_in[8]; p.ffn_norm_w = (const float*)d_in[9];
    p.router_w = (const float*)d_in[10]; p.router_b = (const float*)d_in[11]; p.w_gu = (const float*)d_in[12]; p.b_gu = (const float*)d_in[13]; p.w_dn = (const float*)d_in[14];
    p.b_dn = (const float*)d_in[15]; p.final_norm_w = (const float*)d_in[16];
    p.out = (float*)d_out;
    size_t off = 0; unsigned char* base = (unsigned char*)d_ws;
    auto take = [&](size_t bytes) { unsigned char* r = base + off; off += (bytes + 255) & ~(size_t)255; return r; };
    p.bar = (unsigned*)take(XCD_BAR_WORDS * 4); p.cnt = (int*)take(1024); p.rdy = (unsigned*)take(RDY_WORDS * 4);
    p.wt_in = (bf16_t*)take((size_t)NPW * 1024 * 2); p.wt_out = (bf16_t*)take((size_t)1024 * 1024 * 2);
    p.wt_gu = (bf16_t*)take((size_t)32 * 2048 * 1024 * (MOE_FP8 ? 1 : 2)); p.wt_dn = (bf16_t*)take((size_t)32 * 1024 * 1024 * (MOE_FP8 ? 1 : 2));
    p.xn = (bf16_t*)take((size_t)T_TOK * 1024 * 2); p.proj = (bf16_t*)take((size_t)T_TOK * PP * 2); p.ikb = (bf16_t*)take((size_t)T_TOK * 32 * 2);
    p.vt = (bf16_t*)take((size_t)4 * 2 * 64 * SEQ * 2); p.cq = (bf16_t*)take((size_t)T_TOK * 512 * 2); p.ck = (bf16_t*)take((size_t)T_TOK * 512 * 2);
    p.cst = (bf16_t*)take((size_t)1024 * 16384 * 2); p.mix = (bf16_t*)take((size_t)T_TOK * 1024 * 2);
    p.xbuf = (bf16_t*)take((size_t)XROWS * 1024 * (MOE_FP8 ? 1 : 2)); p.act = (bf16_t*)take((size_t)XROWS * 1024 * (MOE_FP8 ? 1 : 2));
    p.ybuf = (MOE_FP8 ? (bf16_t*)take((size_t)XROWS * 1024 * 2) : p.xbuf);
    p.xn8 = take((size_t)T_TOK * 1024); p.wt_in8 = take((size_t)PP * 1024);
    p.iw = (float*)take((size_t)T_TOK * 8 * 4); p.mi = (float*)take((size_t)T_TOK * 4 * 4); p.mf = (float*)take((size_t)T_TOK * 4 * 4); p.cb = (float*)take((size_t)T_TOK * 4 * 4);
    p.ropea = (float*)take((size_t)SEQ * 16 * 4); p.ropei = (float*)take((size_t)SEQ * 8 * 4);
    p.ut = (bf16_t*)take((size_t)1024 * 16384 * 2); p.nu = (float*)take((size_t)1024 * 128 * 4); p.bl = (float*)take(1024 * 4); p.mloc = (float*)take(1024 * 4);
    p.ns = (float*)take((size_t)1024 * 128 * 4); p.ms = (float*)take(1024 * 4); p.x1 = (bf16_t*)take((size_t)T_TOK * 1024 * 2); p.topg = (float*)take((size_t)T_TOK * 4 * 4); p.rsv = (float*)take((size_t)T_TOK * 4);
    p.mask = (unsigned long long*)take((size_t)T_TOK * 64 * 8); p.tope = (int*)take((size_t)T_TOK * 4 * 4); p.topp = (int*)take((size_t)T_TOK * 4 * 4);
    if (off > ws_size) { fprintf(stderr, "workspace too small: need %zu have %zu\n", off, ws_size); return; }
#if MK_SPLIT
    launch_phase<0>(p, stream); launch_phase<1>(p, stream); launch_phase<2>(p, stream); launch_phase<3>(p, stream); launch_phase<4>(p, stream); launch_phase<5>(p, stream);
    launch_phase<6>(p, stream); launch_phase<7>(p, stream); launch_phase<8>(p, stream); launch_phase<9>(p, stream); launch_phase<10>(p, stream);
#else
    static int grid_blocks = 0;
    if (!grid_blocks) {
        int dev = 0, cus = 0, per_cu = 0;
        (void)hipGetDevice(&dev); (void)hipDeviceGetAttribute(&cus, hipDeviceAttributeMultiprocessorCount, dev);
        (void)hipFuncSetAttribute((const void*)fwd_megakernel, hipFuncAttributeMaxDynamicSharedMemorySize, LDS_BYTES);
        (void)hipOccupancyMaxActiveBlocksPerMultiprocessor(&per_cu, fwd_megakernel, NTHREADS, LDS_BYTES);
        if (per_cu < 1) fprintf(stderr, "occupancy query returned %d blocks per CU\n", per_cu);
        grid_blocks = cus;
    }
    void* args[] = {&p};
    (void)hipMemsetAsync(p.bar, 0, XCD_BAR_WORDS * 4, stream);
    hipError_t e = hipLaunchCooperativeKernel((void*)fwd_megakernel, dim3(grid_blocks), dim3(NTHREADS), args, LDS_BYTES, stream);
    if (e != hipSuccess) fprintf(stderr, "cooperative launch failed: %s (grid %d)\n", hipGetErrorString(e), grid_blocks);
#endif
}
```
